# Optimizing an MI355X kernel written in HIP

```python
import jax, jax.numpy as jnp
from jax import lax
import numpy as np

D_MODEL = 2048
BATCH = 4
SEQ = 4096
DEPTH = 1

CHUNK = 64

FOX_HEADS = 8
FOX_HEAD_DIM = 128
FOX_WIDTH = FOX_HEADS * FOX_HEAD_DIM
Q_BLOCK = 128
FORGET_BIAS_INIT = 3.0

POOL_WINDOWS = (2, 4, 8, 16)
POOL_GROUPS = len(POOL_WINDOWS)
POOL_WIDTH = 1024
POOL_GROUP_DIM = POOL_WIDTH // POOL_GROUPS

N_BRANCHES = 2
IN_SPLITS = (
    FOX_WIDTH,
    2 * FOX_WIDTH,
    3 * FOX_WIDTH,
    3 * FOX_WIDTH + FOX_HEADS,
    3 * FOX_WIDTH + FOX_HEADS + POOL_WIDTH,
)
IN_COLS = 3 * FOX_WIDTH + FOX_HEADS + POOL_WIDTH + N_BRANCHES * D_MODEL

PEER_HEADS = 8
PEER_KEYS = 128
PEER_EXPERTS = PEER_KEYS * PEER_KEYS
PEER_QUERY_DIM = 256
PEER_HALF = PEER_QUERY_DIM // 2
PEER_TOPK = 16
PEER_TOKEN_BLOCK = 128

RMS_EPS = 1e-6

kernel_name = "hybrid_fox_pool_peer_block"


def rms_norm(x, g):
    xf = x.astype(jnp.float32)
    y = xf * lax.rsqrt(jnp.mean(xf * xf, axis=-1, keepdims=True) + RMS_EPS)
    return (y * g.astype(jnp.float32)).astype(x.dtype)


def forgetting_attention(q, k, v, log_f):
    seq = q.shape[2]
    c = jnp.cumsum(log_f, axis=-1)
    scale = FOX_HEAD_DIM ** -0.5
    outs = []
    for blk in range(seq // Q_BLOCK):
        q0 = blk * Q_BLOCK
        q1 = q0 + Q_BLOCK
        qb = q[:, :, q0:q1]
        kb = k[:, :, :q1]
        vb = v[:, :, :q1]
        logits = jnp.einsum('bhqd,bhkd->bhqk', qb, kb,
                            preferred_element_type=jnp.float32) * scale
        logits = logits + (c[:, :, q0:q1, None] - c[:, :, None, :q1])
        causal = jnp.arange(q0, q1)[:, None] >= jnp.arange(q1)[None, :]
        logits = jnp.where(causal, logits, -jnp.inf)
        p = jax.nn.softmax(logits, axis=-1)
        outs.append(jnp.einsum('bhqk,bhkd->bhqd', p.astype(v.dtype), vb))
    return jnp.concatenate(outs, axis=2)


def multiscale_pool(p, w_groups, scale):
    b, s, _ = p.shape
    pg = p.reshape(b, s, POOL_GROUPS, POOL_GROUP_DIM).astype(jnp.float32)
    csum = jnp.cumsum(pg, axis=1)
    pos = jnp.arange(s)
    outs = []
    for gi, w in enumerate(POOL_WINDOWS):
        cs = csum[:, :, gi]
        lagged = jnp.pad(cs, ((0, 0), (w, 0), (0, 0)))[:, :s]
        count = jnp.minimum(pos + 1, w).astype(jnp.float32)[None, :, None]
        outs.append((cs - lagged) / count - pg[:, :, gi])
    mixed = jnp.stack(outs, axis=2).astype(p.dtype)
    mixed = jnp.einsum('bsgc,gcd->bsgd', mixed, w_groups)
    return mixed.reshape(b, s, POOL_WIDTH) * scale


def peer(xn, w_query, sub_keys_1, sub_keys_2, expert_u, expert_v):
    b, s, d = xn.shape
    t = b * s
    xt = xn.reshape(t, d)
    q = (xt @ w_query).reshape(t, PEER_HEADS, PEER_QUERY_DIM).astype(jnp.float32)
    q1, q2 = q[..., :PEER_HALF], q[..., PEER_HALF:]
    s1 = jnp.einsum('thd,hkd->thk', q1, sub_keys_1.astype(jnp.float32))
    s2 = jnp.einsum('thd,hkd->thk', q2, sub_keys_2.astype(jnp.float32))
    v1, i1 = lax.top_k(s1, PEER_TOPK)
    v2, i2 = lax.top_k(s2, PEER_TOPK)
    cand = (v1[..., :, None] + v2[..., None, :]).reshape(t, PEER_HEADS, PEER_TOPK * PEER_TOPK)
    cand_idx = (i1[..., :, None] * PEER_KEYS + i2[..., None, :]).reshape(
        t, PEER_HEADS, PEER_TOPK * PEER_TOPK)
    top_s, top_pos = lax.top_k(cand, PEER_TOPK)
    expert_idx = jnp.take_along_axis(cand_idx, top_pos, axis=-1)
    gates = jax.nn.softmax(top_s, axis=-1).astype(xn.dtype)

    def token_block(args):
        xb, idx, g = args
        u = jnp.take(expert_u, idx, axis=0)
        a = jnp.einsum('thkd,td->thk', u, xb)
        hid = jax.nn.gelu(a) * g
        vsel = jnp.take(expert_v, idx, axis=0)
        return jnp.einsum('thk,thkd->td', hid, vsel)

    nb = t // PEER_TOKEN_BLOCK
    out = lax.map(token_block, (
        xt.reshape(nb, PEER_TOKEN_BLOCK, d),
        expert_idx.reshape(nb, PEER_TOKEN_BLOCK, PEER_HEADS, PEER_TOPK),
        gates.reshape(nb, PEER_TOKEN_BLOCK, PEER_HEADS, PEER_TOPK),
    ))
    return out.reshape(b, s, d)


def setup_inputs(seed: int = 0) -> dict:
    key = jax.random.key(seed)
    ks = jax.random.split(key, 20)
    f32 = jnp.float32

    def nrm(k, shape, std):
        return jax.random.normal(k, shape, f32) * std

    return {
        "x": nrm(ks[0], (BATCH, SEQ, D_MODEL), 1.0),
        "norm1_g": 1.0 + nrm(ks[1], (DEPTH, D_MODEL), 0.02),
        "w_in": nrm(ks[2], (DEPTH, D_MODEL, IN_COLS), D_MODEL ** -0.5),
        "forget_bias": FORGET_BIAS_INIT + nrm(ks[3], (DEPTH, FOX_HEADS), 0.5),
        "q_norm_g": 1.0 + nrm(ks[4], (DEPTH, FOX_HEAD_DIM), 0.02),
        "k_norm_g": 1.0 + nrm(ks[5], (DEPTH, FOX_HEAD_DIM), 0.02),
        "pool_group_w": nrm(ks[6], (DEPTH, POOL_GROUPS, POOL_GROUP_DIM, POOL_GROUP_DIM),
                            POOL_GROUP_DIM ** -0.5),
        "pool_scale": 1.0 + nrm(ks[7], (DEPTH, POOL_WIDTH), 0.02),
        "w_branch_attn": nrm(ks[8], (DEPTH, FOX_WIDTH, D_MODEL), FOX_WIDTH ** -0.5),
        "w_branch_pool": nrm(ks[9], (DEPTH, POOL_WIDTH, D_MODEL), POOL_WIDTH ** -0.5),
        "w_out": nrm(ks[10], (DEPTH, D_MODEL, D_MODEL), D_MODEL ** -0.5),
        "norm2_g": 1.0 + nrm(ks[11], (DEPTH, D_MODEL), 0.02),
        "peer_w_query": nrm(ks[12], (DEPTH, D_MODEL, PEER_HEADS * PEER_QUERY_DIM), D_MODEL ** -0.5),
        "peer_sub_keys_1": nrm(ks[13], (DEPTH, PEER_HEADS, PEER_KEYS, PEER_HALF), PEER_HALF ** -0.5),
        "peer_sub_keys_2": nrm(ks[14], (DEPTH, PEER_HEADS, PEER_KEYS, PEER_HALF), PEER_HALF ** -0.5),
        "peer_expert_u": nrm(ks[15], (DEPTH, PEER_EXPERTS, D_MODEL), D_MODEL ** -0.5),
        "peer_expert_v": nrm(ks[16], (DEPTH, PEER_EXPERTS, D_MODEL), PEER_HEADS ** -0.5),
    }


def reference(x, norm1_g, w_in, forget_bias, q_norm_g, k_norm_g, pool_group_w, pool_scale,
              w_branch_attn, w_branch_pool, w_out, norm2_g, peer_w_query, peer_sub_keys_1,
              peer_sub_keys_2, peer_expert_u, peer_expert_v):
    b, s, _ = x.shape
    for l in range(DEPTH):
        h = rms_norm(x, norm1_g[l])
        proj = h @ w_in[l]
        q, k, v, fl, pin, gl = jnp.split(proj, IN_SPLITS, axis=-1)

        q = rms_norm(q.reshape(b, s, FOX_HEADS, FOX_HEAD_DIM), q_norm_g[l]).transpose(0, 2, 1, 3)
        k = rms_norm(k.reshape(b, s, FOX_HEADS, FOX_HEAD_DIM), k_norm_g[l]).transpose(0, 2, 1, 3)
        v = v.reshape(b, s, FOX_HEADS, FOX_HEAD_DIM).transpose(0, 2, 1, 3)
        log_f = jax.nn.log_sigmoid(fl.astype(jnp.float32)
                                   + forget_bias[l].astype(jnp.float32)).transpose(0, 2, 1)
        attn = forgetting_attention(q, k, v, log_f)
        y_attn = attn.transpose(0, 2, 1, 3).reshape(b, s, FOX_WIDTH) @ w_branch_attn[l]

        y_pool = multiscale_pool(pin, pool_group_w[l], pool_scale[l]) @ w_branch_pool[l]

        gates = jax.nn.sigmoid(gl.astype(jnp.float32)).astype(x.dtype).reshape(
            b, s, N_BRANCHES, D_MODEL)
        merged = gates[:, :, 0] * y_attn + gates[:, :, 1] * y_pool
        x = x + merged @ w_out[l]

        x = x + peer(rms_norm(x, norm2_g[l]), peer_w_query[l], peer_sub_keys_1[l],
                     peer_sub_keys_2[l], peer_expert_u[l], peer_expert_v[l])
    return x
```

```cpp
#include <hip/hip_runtime.h>
#include <cstdio>
#include <cstdint>

typedef unsigned short bf16_t;
constexpr int Bn = 4, S = 4096, DM = 2048, T = Bn * S, NH = 8, HD = 128, FW = 1024, PW = 1024;
constexpr int INC = 8200, NPROJ = 8192;
constexpr int PH = 8, PK = 128, PQD = 256, TOPK = 16, NEXP = 16384;
constexpr float EPS = 1e-6f;
constexpr float SCALE = 0.08838834764831845f;
constexpr float INV_SCALE = 11.313708498984761f;
constexpr size_t MiB = 1u << 20;
constexpr size_t WS_WT_PG = 1 * MiB, WS_WT_BA = 2 * MiB, WS_WT_BP = 6 * MiB, WS_WT_OUT = 10 * MiB, WS_WT_Q = 18 * MiB, WS_SK = 26 * MiB, WS_SKB = 27 * MiB,
                 WS_CS = 28 * MiB, WS_LOGF = 29 * MiB, WS_SSQ = 30 * MiB, WS_IDX = 32 * MiB, WS_GATE = 40 * MiB,
                 WS_Q = 48 * MiB, WS_K = 80 * MiB, WS_V = 112 * MiB, WS_PIN = 144 * MiB, WS_G = 176 * MiB, WS_EU = 304 * MiB, WS_EV = 368 * MiB, WS_XG = 432 * MiB,
                 WS_TMP = 48 * MiB, WS_MERGED = 112 * MiB, WS_QP = 48 * MiB, WS_RAWQ = 304 * MiB, WS_RAWK = 368 * MiB, WS_SC = 176 * MiB;
constexpr size_t DO_H1 = 0, DO_WT_IN = 64 * MiB, DO_O = 0, DO_POOLED = 32 * MiB, DO_POOL2 = 64 * MiB;

__device__ __forceinline__ float bf2f(bf16_t v) { return __uint_as_float(((unsigned)v) << 16); }
__device__ __forceinline__ bf16_t f2bf(float f) { unsigned u = __float_as_uint(f); return (bf16_t)((u + 0x7fffu + ((u >> 16) & 1u)) >> 16); }


#define LAS __attribute__((address_space(3)))
#define GAS __attribute__((address_space(1)))
typedef short bf16x8 __attribute__((ext_vector_type(8)));
typedef float f32x4 __attribute__((ext_vector_type(4)));
typedef float f32x2 __attribute__((ext_vector_type(2)));
typedef unsigned u32x4 __attribute__((ext_vector_type(4)));
typedef unsigned u32x2 __attribute__((ext_vector_type(2)));
typedef int v8i_t __attribute__((ext_vector_type(8)));
typedef int i32x4_t __attribute__((ext_vector_type(4)));
constexpr int NWAVES = 8, NTHR = 512;
constexpr int RING_OFF = 0, RING_BYTES = 131072, EPI_OFF = 131072, EPI_BYTES = 16384, MISC_OFF = EPI_OFF + EPI_BYTES, LDS_BYTES = MISC_OFF + 512;
constexpr size_t WS_CTL = 0, CTL_ZERO_BYTES = 65536;
constexpr int CW_BAR = 1024;

__device__ __forceinline__ unsigned cvt_pk_bf16(float lo, float hi) { unsigned r; asm volatile("s_nop 0\n\tv_cvt_pk_bf16_f32 %0, %1, %2" : "=v"(r) : "v"(lo), "v"(hi)); return r; }
__device__ __forceinline__ float wave_sum(float v) {
#pragma unroll
    for (int o = 1; o < 64; o <<= 1) v += __shfl_xor(v, o);
    return v;
}
__device__ __forceinline__ int lane_now() { int l; asm volatile("v_mbcnt_lo_u32_b32 %0, -1, 0\n\tv_mbcnt_hi_u32_b32 %0, -1, %0" : "=v"(l)); return l; }
#define LDS_WAIT() asm volatile("s_waitcnt lgkmcnt(0)" ::: "memory")
#define VM_WAIT() asm volatile("s_waitcnt vmcnt(0)" ::: "memory")

namespace pg8 {
constexpr int BM = 256, BK = 64, HALF = 128, HTB = HALF * BK * 2, STAGE_BYTES = 8 * HTB, NXCD = 8, WGM = 8;
__host__ __device__ __forceinline__ int lds_byte(int r, int c) { const int st = (r >> 4) * 2 + (c >> 5), rr = r & 15, cc = c & 31, ob = rr * 64 + cc * 2; return st * 1024 + (ob ^ (((ob >> 9) & 1) << 5)); }
__host__ __device__ __forceinline__ void stage_rc(int b, int& R, int& C) { const int st = b / 1024, sb = b % 1024, swz = sb ^ (((sb >> 9) & 1) << 5); R = (st >> 1) * 16 + swz / 64; C = (st & 1) * 32 + (swz % 64) / 2; }
__host__ __device__ __forceinline__ int perm32(int rho) { const int n = rho >> 4, i = rho & 15; return 8 * (i >> 2) + 4 * n + (i & 3); }
struct Unit { int pm, pn, aux; };
__device__ __forceinline__ void order_map(int L, int nM, int nN, int nwg, Unit& u) {
    int wgid = L; { const int q = nwg / NXCD, r = nwg % NXCD, xcd = wgid % NXCD, off = wgid / NXCD; wgid = (xcd < r ? xcd * (q + 1) : r * (q + 1) + (xcd - r) * q) + off; }
    const int nig = WGM * nN, gid = wgid / nig, fm = gid * WGM, gsz = (nM - fm) < WGM ? (nM - fm) : WGM;
    u.pm = fm + ((wgid % nig) % gsz); u.pn = (wgid % nig) / gsz; u.aux = 0;
}
struct SchedStd {
    const char* A; const char* Bt; size_t a_tile, b_tile, a_kstride; int nM, nN, nwg, G, c;
    __device__ __forceinline__ bool next(int i, Unit& u) const { const long L = (long)i * G + c; if (L >= nwg) return false; order_map((int)L, nM, nN, nwg, u); return true; }
    __device__ __forceinline__ const char* a_ptr(const Unit& u) const { return A + (size_t)u.pm * a_tile + (size_t)u.pn * a_kstride; }
    __device__ __forceinline__ const char* b_ptr(const Unit& u) const { return Bt + (size_t)u.pn * b_tile; }
};
struct SchedPair {
    const char* A0; const char* A1; const char* B0; const char* B1; size_t a_tile, b_tile; int nM, nN, nwg, G, c;
    __device__ __forceinline__ bool next(int i, Unit& u) const { const long L = (long)(i >> 1) * G + c; if (L >= nwg) return false; order_map((int)L, nM, nN, nwg, u); u.aux = i & 1; return true; }
    __device__ __forceinline__ const char* a_ptr(const Unit& u) const { return (u.aux ? A1 : A0) + (size_t)u.pm * a_tile; }
    __device__ __forceinline__ const char* b_ptr(const Unit& u) const { return (u.aux ? B1 : B0) + (size_t)u.pn * b_tile; }
};
typedef f32x4 Acc[2][2][4][2];

template <bool FP8 = false, class Epi, class Sched>
__device__ __forceinline__ void gemm_phase(LAS unsigned char* lds, const int wid, const int K, const int lda, const int ldb, const Sched& S, const Epi& E) {
    const int lane = lane_now(), tid = wid * 64 + lane, wr = wid >> 2, wc = wid & 3, fr = lane & 15, fq = lane >> 4;
    const int nt = K / BK;
    unsigned voffA[2], voffB[2];
#pragma unroll
    for (int i = 0; i < 2; ++i) { int R, C; stage_rc(tid * 16 + i * 8192, R, C); const int Rb = (R & ~31) + perm32(R & 31);
        voffA[i] = (unsigned)(R * lda + C) * 2u; voffB[i] = (unsigned)(Rb * ldb + C) * 2u; }
    const size_t kstep = (size_t)(BK * 2);
    const size_t hstepA = (size_t)HALF * lda * 2, hstepB = (size_t)HALF * ldb * 2;
    const unsigned ldsw = (unsigned)wid * 1024u;
    const int aoff = lds_byte(wr * 64 + fr, fq * 8), boff = lds_byte(wc * 32 + fr, fq * 8);
#define PG8_SA(b, h) (((b) * 2 + (h)) * HTB)
#define PG8_SB(b, h) ((4 + (b) * 2 + (h)) * HTB)
#define PG8_STAGE(bufoff, gbase, voff) do { _Pragma("unroll") for (int _i = 0; _i < 2; ++_i) \
        __builtin_amdgcn_global_load_lds((const unsigned*)((const char*)(gbase) + (voff)[_i]), (LAS unsigned*)(lds + (bufoff) + ldsw + _i * 8192), 16, 0, 0); } while (0)
#define PG8_LDA(dst, b, h) do { if constexpr (FP8) { _Pragma("unroll") for (int m = 0; m < 4; ++m) dst##8[m] = __builtin_shufflevector(*(const LAS i32x4_t*)(lds + PG8_SA(b, h) + aoff + m * 2048), *(const LAS i32x4_t*)(lds + PG8_SA(b, h) + aoff + m * 2048 + 1024), 0, 1, 2, 3, 4, 5, 6, 7); } \
        else { _Pragma("unroll") for (int m = 0; m < 4; ++m) _Pragma("unroll") for (int k = 0; k < 2; ++k) dst[m][k] = *(const LAS bf16x8*)(lds + PG8_SA(b, h) + aoff + m * 2048 + k * 1024); } } while (0)
#define PG8_LDB(dst, b, h) do { if constexpr (FP8) { _Pragma("unroll") for (int n = 0; n < 2; ++n) dst##8[n] = __builtin_shufflevector(*(const LAS i32x4_t*)(lds + PG8_SB(b, h) + boff + n * 2048), *(const LAS i32x4_t*)(lds + PG8_SB(b, h) + boff + n * 2048 + 1024), 0, 1, 2, 3, 4, 5, 6, 7); } \
        else { _Pragma("unroll") for (int n = 0; n < 2; ++n) _Pragma("unroll") for (int k = 0; k < 2; ++k) dst[n][k] = *(const LAS bf16x8*)(lds + PG8_SB(b, h) + boff + n * 2048 + k * 1024); } } while (0)
#define PG8_MMA(ai, bj, At, Bt) do { if constexpr (!FP8) __builtin_amdgcn_s_setprio(1);     \
        if constexpr (FP8) { _Pragma("unroll") for (int m = 0; m < 4; ++m) _Pragma("unroll") for (int n = 0; n < 2; ++n) \
            acc[ai][bj][m][n] = __builtin_amdgcn_mfma_scale_f32_16x16x128_f8f6f4(Bt##8[n], At##8[m], acc[ai][bj][m][n], 0, 0, 0, 0x7f7f7f7f, 0, 0x7f7f7f7f); } \
        else { _Pragma("unroll") for (int m = 0; m < 4; ++m) _Pragma("unroll") for (int n = 0; n < 2; ++n) _Pragma("unroll") for (int k = 0; k < 2; ++k) \
            acc[ai][bj][m][n] = __builtin_amdgcn_mfma_f32_16x16x32_bf16(Bt[n][k], At[m][k], acc[ai][bj][m][n], 0, 0, 0); } \
        __builtin_amdgcn_s_setprio(0); } while (0)
#define PG8_WAIT_V(n) asm volatile("s_waitcnt vmcnt(" #n ")" ::: "memory")
#define PG8_WAIT_L(n) asm volatile("s_waitcnt lgkmcnt(" #n ")" ::: "memory")
#define PG8_BAR __builtin_amdgcn_s_barrier()
#define PG8_SCHED __builtin_amdgcn_sched_barrier(0)
    Unit cur, nxt; int ui = 0;
    if (!S.next(0, cur)) return;
    Acc acc;
#pragma unroll
    for (int a = 0; a < 2; ++a)
#pragma unroll
        for (int b = 0; b < 2; ++b)
#pragma unroll
            for (int m = 0; m < 4; ++m)
#pragma unroll
                for (int n = 0; n < 2; ++n) acc[a][b][m][n] = (f32x4){0.f, 0.f, 0.f, 0.f};
    bf16x8 At[4][2], B0[2][2], B1[2][2]; v8i_t At8[4], B08[2], B18[2];
    const char* cA = S.a_ptr(cur); const char* cB = S.b_ptr(cur);
    PG8_STAGE(PG8_SB(0, 0), cB, voffB); PG8_STAGE(PG8_SB(0, 1), cB + hstepB, voffB); PG8_STAGE(PG8_SA(0, 0), cA, voffA); PG8_STAGE(PG8_SA(0, 1), cA + hstepA, voffA);
    if (wr == 1) PG8_BAR;
    PG8_WAIT_V(2); PG8_BAR;
    PG8_STAGE(PG8_SB(1, 0), cB + kstep, voffB); PG8_STAGE(PG8_SA(1, 0), cA + kstep, voffA); PG8_STAGE(PG8_SB(1, 1), cB + hstepB + kstep, voffB);
    PG8_WAIT_V(6); PG8_BAR;
#pragma unroll 1
    for (;;) {
        const bool has_next = S.next(ui + 1, nxt);
        const char* nA = has_next ? S.a_ptr(nxt) : cA; const char* nB = has_next ? S.b_ptr(nxt) : cB;
#pragma unroll 1
        for (int t = 0; t < nt; t += 2) {
            const bool last = (t == nt - 2);
            const char* a1 = cA + (size_t)(t + 1) * kstep;
            const char* a2 = last ? nA : cA + (size_t)(t + 2) * kstep; const char* b2 = last ? nB : cB + (size_t)(t + 2) * kstep;
            const char* a3 = a2 + kstep; const char* b3 = b2 + kstep;
            PG8_LDB(B0, 0, 0); PG8_LDB(B1, 0, 1); PG8_SCHED; PG8_LDA(At, 0, 0); PG8_STAGE(PG8_SA(1, 1), a1 + hstepA, voffA);
            PG8_WAIT_V(8); PG8_WAIT_L(0); PG8_BAR; PG8_MMA(0, 0, At, B0); PG8_MMA(0, 1, At, B1); PG8_BAR; PG8_SCHED;
            PG8_LDA(At, 0, 1); PG8_STAGE(PG8_SB(0, 0), b2, voffB); PG8_STAGE(PG8_SB(0, 1), b2 + hstepB, voffB); PG8_STAGE(PG8_SA(0, 0), a2, voffA);
            PG8_WAIT_V(8); PG8_WAIT_L(0); PG8_BAR; PG8_MMA(1, 0, At, B0); PG8_MMA(1, 1, At, B1); PG8_BAR; PG8_SCHED;
            PG8_LDB(B0, 1, 0); PG8_LDB(B1, 1, 1); PG8_SCHED; PG8_LDA(At, 1, 0); PG8_STAGE(PG8_SA(0, 1), a2 + hstepA, voffA);
            PG8_WAIT_V(8); PG8_WAIT_L(0); PG8_BAR; PG8_MMA(0, 0, At, B0); PG8_MMA(0, 1, At, B1); PG8_BAR; PG8_SCHED;
            PG8_LDA(At, 1, 1); PG8_STAGE(PG8_SB(1, 0), b3, voffB); PG8_STAGE(PG8_SB(1, 1), b3 + hstepB, voffB); PG8_STAGE(PG8_SA(1, 0), a3, voffA);
            PG8_WAIT_V(8); PG8_WAIT_L(0); PG8_BAR; PG8_MMA(1, 0, At, B0); PG8_MMA(1, 1, At, B1); PG8_BAR; PG8_SCHED;
        }
        if (wr == 0) PG8_BAR;
        E(acc, cur, ui, wid);
        if (!has_next) break;
#pragma unroll
        for (int a = 0; a < 2; ++a)
#pragma unroll
            for (int b = 0; b < 2; ++b)
#pragma unroll
                for (int m = 0; m < 4; ++m)
#pragma unroll
                    for (int n = 0; n < 2; ++n) acc[a][b][m][n] = (f32x4){0.f, 0.f, 0.f, 0.f};
        cur = nxt; cA = nA; cB = nB; ++ui;
        if (wr == 1) PG8_BAR;
    }
    PG8_WAIT_V(0);
    PG8_BAR;
#undef PG8_SA
#undef PG8_SB
#undef PG8_STAGE
#undef PG8_LDA
#undef PG8_LDB
#undef PG8_MMA
#undef PG8_WAIT_V
#undef PG8_WAIT_L
#undef PG8_BAR
#undef PG8_SCHED
}
}

using pg8::Acc; using pg8::Unit;
__device__ __forceinline__ u32x4 pack8(const f32x4 a, const f32x4 b) { u32x4 w; w.x = cvt_pk_bf16(a[0], a[1]); w.y = cvt_pk_bf16(a[2], a[3]); w.z = cvt_pk_bf16(b[0], b[1]); w.w = cvt_pk_bf16(b[2], b[3]); return w; }
__device__ __forceinline__ void unpack8(const u32x4 w, f32x4& a, f32x4& b) {
    a[0] = __uint_as_float(w.x << 16); a[1] = __uint_as_float(w.x & 0xffff0000u); a[2] = __uint_as_float(w.y << 16); a[3] = __uint_as_float(w.y & 0xffff0000u);
    b[0] = __uint_as_float(w.z << 16); b[1] = __uint_as_float(w.z & 0xffff0000u); b[2] = __uint_as_float(w.w << 16); b[3] = __uint_as_float(w.w & 0xffff0000u);
}
__device__ __forceinline__ float sigmoidf_fast(float v) { return __builtin_amdgcn_rcpf(1.f + __builtin_amdgcn_exp2f(-1.4426950408889634f * v)); }

struct EpiProj {
    bf16_t* Q; bf16_t* Kt; bf16_t* V; bf16_t* PIN; bf16_t* G; const float* gq; const float* gk; LAS float* P;
    __device__ __forceinline__ void operator()(const Acc& acc, const Unit& u, int ui, int wid) const {
        const int lane = lane_now(), wr = wid >> 2, wc = wid & 3, fr = lane & 15, fq = lane >> 4;
        const int pn = u.pn, c8 = wc * 32 + fq * 8;
        if (pn < 8) {
            LAS float* Pb = P + (ui & 1) * 2048;
#pragma unroll
            for (int ai = 0; ai < 2; ++ai)
#pragma unroll
                for (int m = 0; m < 4; ++m)
#pragma unroll
                    for (int bj = 0; bj < 2; ++bj) { const f32x4 a = acc[ai][bj][m][0], b = acc[ai][bj][m][1];
                        float s = (a[0] * a[0] + a[1] * a[1]) + (a[2] * a[2] + a[3] * a[3]) + (b[0] * b[0] + b[1] * b[1]) + (b[2] * b[2] + b[3] * b[3]);
                        s += __shfl_xor(s, 16); s += __shfl_xor(s, 32);
                        if (fq == 0) Pb[((ai * 128 + wr * 64 + m * 16 + fr) * 2 + bj) * 4 + wc] = s; }
            LDS_WAIT(); __builtin_amdgcn_s_barrier(); asm volatile("" ::: "memory");
            const float* g = (pn < 4) ? gq : gk; bf16_t* dst = (pn < 4) ? Q : Kt; const int h0 = (pn & 3) * 2;
            const f32x4 g0 = *(const f32x4*)(g + c8), g1 = *(const f32x4*)(g + c8 + 4);
#pragma unroll
            for (int ai = 0; ai < 2; ++ai)
#pragma unroll
                for (int m = 0; m < 4; ++m) { const int rl = ai * 128 + wr * 64 + m * 16 + fr, row = u.pm * 256 + rl, bb = row >> 12, s = row & 4095;
#pragma unroll
                    for (int bj = 0; bj < 2; ++bj) { const f32x4 p = *(const LAS f32x4*)(Pb + (rl * 2 + bj) * 4);
                        const float rstd = rsqrtf(((p[0] + p[1]) + (p[2] + p[3])) * (1.f / 128.f) + EPS);
                        const f32x4 a = acc[ai][bj][m][0] * rstd * g0, b = acc[ai][bj][m][1] * rstd * g1;
                        *(u32x4*)(dst + (((size_t)bb * NH + h0 + bj) * S + s) * HD + c8) = pack8(a, b); } }
        } else if (pn < 12) {
            const int h0 = (pn - 8) * 2;
#pragma unroll
            for (int ai = 0; ai < 2; ++ai)
#pragma unroll
                for (int m = 0; m < 4; ++m) { const int row = u.pm * 256 + ai * 128 + wr * 64 + m * 16 + fr, bb = row >> 12, s = row & 4095;
#pragma unroll
                    for (int bj = 0; bj < 2; ++bj) *(u32x4*)(V + (((size_t)bb * NH + h0 + bj) * S + s) * HD + c8) = pack8(acc[ai][bj][m][0], acc[ai][bj][m][1]); }
        } else if (pn < 16) {
#pragma unroll
            for (int ai = 0; ai < 2; ++ai)
#pragma unroll
                for (int m = 0; m < 4; ++m) { const int row = u.pm * 256 + ai * 128 + wr * 64 + m * 16 + fr;
#pragma unroll
                    for (int bj = 0; bj < 2; ++bj) *(u32x4*)(PIN + (size_t)row * PW + (pn - 12) * 256 + bj * 128 + c8) = pack8(acc[ai][bj][m][0], acc[ai][bj][m][1]); }
        } else {
#pragma unroll
            for (int ai = 0; ai < 2; ++ai)
#pragma unroll
                for (int m = 0; m < 4; ++m) { const int row = u.pm * 256 + ai * 128 + wr * 64 + m * 16 + fr;
#pragma unroll
                    for (int bj = 0; bj < 2; ++bj) { f32x4 a = acc[ai][bj][m][0], b = acc[ai][bj][m][1];
#pragma unroll
                        for (int e = 0; e < 4; ++e) { a[e] = sigmoidf_fast(a[e]); b[e] = sigmoidf_fast(b[e]); }
                        *(u32x4*)(G + (size_t)row * 4096 + (pn - 16) * 256 + bj * 128 + c8) = pack8(a, b); } }
        }
    }
};
struct EpiGate {
    bf16_t* G; float inv;
    __device__ __forceinline__ void operator()(const Acc& acc, const Unit& u, int ui, int wid) const {
        const int lane = lane_now(), wr = wid >> 2, wc = wid & 3, fr = lane & 15, fq = lane >> 4;
        const int c8 = wc * 32 + fq * 8;
#pragma unroll
        for (int ai = 0; ai < 2; ++ai)
#pragma unroll
            for (int m = 0; m < 4; ++m) { const int row = u.pm * 256 + ai * 128 + wr * 64 + m * 16 + fr;
#pragma unroll
                for (int bj = 0; bj < 2; ++bj) { f32x4 a = acc[ai][bj][m][0] * inv, b = acc[ai][bj][m][1] * inv;
#pragma unroll
                    for (int e = 0; e < 4; ++e) { a[e] = sigmoidf_fast(a[e]); b[e] = sigmoidf_fast(b[e]); }
                    *(u32x4*)(G + (size_t)row * 4096 + u.pn * 256 + bj * 128 + c8) = pack8(a, b); } }
    }
};
struct EpiPool2 {
    bf16_t* O; const float* scale;
    __device__ __forceinline__ void operator()(const Acc& acc, const Unit& u, int ui, int wid) const {
        const int lane = lane_now(), wr = wid >> 2, wc = wid & 3, fr = lane & 15, fq = lane >> 4;
        const int c8 = wc * 32 + fq * 8;
#pragma unroll
        for (int bj = 0; bj < 2; ++bj) { const int col = u.pn * 256 + bj * 128 + c8; const f32x4 s0 = *(const f32x4*)(scale + col), s1 = *(const f32x4*)(scale + col + 4);
#pragma unroll
            for (int ai = 0; ai < 2; ++ai)
#pragma unroll
                for (int m = 0; m < 4; ++m) { const int row = u.pm * 256 + ai * 128 + wr * 64 + m * 16 + fr;
                    *(u32x4*)(O + (size_t)row * PW + col) = pack8(acc[ai][bj][m][0] * s0, acc[ai][bj][m][1] * s1); } }
    }
};
struct EpiBranch {
    bf16_t* TMP; bf16_t* MERGED; const bf16_t* G;
    __device__ __forceinline__ void operator()(const Acc& acc, const Unit& u, int ui, int wid) const {
        const int lane = lane_now(), wr = wid >> 2, wc = wid & 3, fr = lane & 15, fq = lane >> 4;
        const int c8 = wc * 32 + fq * 8;
#pragma unroll
        for (int ai = 0; ai < 2; ++ai)
#pragma unroll
            for (int m = 0; m < 4; ++m) { const int row = u.pm * 256 + ai * 128 + wr * 64 + m * 16 + fr;
#pragma unroll
                for (int bj = 0; bj < 2; ++bj) { const int col = u.pn * 256 + bj * 128 + c8;
                    f32x4 ga, gb; unpack8(*(const u32x4*)(G + (size_t)row * 4096 + u.aux * 2048 + col), ga, gb);
                    f32x4 a = acc[ai][bj][m][0] * ga, b = acc[ai][bj][m][1] * gb;
                    if (u.aux == 0) { *(u32x4*)(TMP + (size_t)row * DM + col) = pack8(a, b); }
                    else { f32x4 ta, tb; unpack8(*(const u32x4*)(TMP + (size_t)row * DM + col), ta, tb); *(u32x4*)(MERGED + (size_t)row * DM + col) = pack8(a + ta, b + tb); } } }
    }
};
struct EpiOut {
    const float* x; bf16_t* XG; float* SSQ;
    __device__ __forceinline__ void operator()(const Acc& acc, const Unit& u, int ui, int wid) const {
        const int lane = lane_now(), wr = wid >> 2, wc = wid & 3, fr = lane & 15, fq = lane >> 4;
        const int c8 = wc * 32 + fq * 8;
#pragma unroll
        for (int ai = 0; ai < 2; ++ai)
#pragma unroll
            for (int m = 0; m < 4; ++m) { const int row = u.pm * 256 + ai * 128 + wr * 64 + m * 16 + fr; float ss = 0.f;
#pragma unroll
                for (int bj = 0; bj < 2; ++bj) { const size_t off = (size_t)row * DM + u.pn * 256 + bj * 128 + c8;
                    const f32x4 a = acc[ai][bj][m][0] + *(const f32x4*)(x + off), b = acc[ai][bj][m][1] + *(const f32x4*)(x + off + 4);
                    ss += (a[0] * a[0] + a[1] * a[1]) + (a[2] * a[2] + a[3] * a[3]) + (b[0] * b[0] + b[1] * b[1]) + (b[2] * b[2] + b[3] * b[3]);
                    *(u32x4*)(XG + off) = pack8(a, b); }
                ss += __shfl_xor(ss, 16); ss += __shfl_xor(ss, 32);
                if (fq == 0) SSQ[(size_t)row * 32 + u.pn * 4 + wc] = ss; }
    }
};
struct EpiBf16 {
    bf16_t* O; int ldc;
    __device__ __forceinline__ void operator()(const Acc& acc, const Unit& u, int ui, int wid) const {
        const int lane = lane_now(), wr = wid >> 2, wc = wid & 3, fr = lane & 15, fq = lane >> 4;
        const int c8 = wc * 32 + fq * 8;
#pragma unroll
        for (int ai = 0; ai < 2; ++ai)
#pragma unroll
            for (int m = 0; m < 4; ++m) { const int row = u.pm * 256 + ai * 128 + wr * 64 + m * 16 + fr;
#pragma unroll
                for (int bj = 0; bj < 2; ++bj) *(u32x4*)(O + (size_t)row * ldc + u.pn * 256 + bj * 128 + c8) = pack8(acc[ai][bj][m][0], acc[ai][bj][m][1]); }
    }
};

#define XB_TMO      128
#define XB_XCNT(j)  (256  + 64 * (j))
#define XB_XSUB(j)  (1280 + 64 * (j))
#define XB_XGEN(j)  (2304 + 64 * (j))
#define XB_TOP      3328
#define XB_TOPGEN   3392
#define XCD_BAR_WORDS 3456
#define XB_SPIN_CAP (1u << 18)
__device__ __forceinline__ unsigned xb_ld(unsigned* p)              { return __hip_atomic_load(p, __ATOMIC_RELAXED, __HIP_MEMORY_SCOPE_AGENT); }
__device__ __forceinline__ unsigned xb_add(unsigned* p, unsigned v) { return __hip_atomic_fetch_add(p, v, __ATOMIC_RELAXED, __HIP_MEMORY_SCOPE_AGENT); }
__device__ __forceinline__ unsigned xb_xcc_id() { return (unsigned)__builtin_amdgcn_s_getreg((3 << 11) | 20) & 0xFu; }
#define XB_SPIN(cond, bar) do { unsigned _sp = 0; while (cond) { __builtin_amdgcn_s_sleep(1); \
    if ((++_sp & 255u) == 0u) { if (xb_ld(&(bar)[XB_TMO])) break; if (_sp > XB_SPIN_CAP) { atomicAdd(&(bar)[XB_TMO], 1u); break; } } } } while (0)
struct XcdBarrier { unsigned* bar; unsigned x; volatile LAS unsigned* st; };
__device__ __forceinline__ XcdBarrier xcd_barrier_post(unsigned* bar, volatile LAS unsigned* st) {
    XcdBarrier b; b.bar = bar; b.x = xb_xcc_id(); b.st = st;
    if (threadIdx.x == 0) (void)xb_add(&bar[XB_XCNT(b.x)], 1u);
    return b;
}
__device__ __forceinline__ void xcd_barrier_complete(unsigned* bar, unsigned x, unsigned& nloc, unsigned& nx) {
    const unsigned G = gridDim.x * gridDim.y * gridDim.z;
    unsigned sum, cnt, mine, sp = 0u;
    for (;;) {
        sum = 0u; cnt = 0u; mine = 0u;
#pragma unroll
        for (unsigned j = 0; j < 16; ++j) { const unsigned c = xb_ld(&bar[XB_XCNT(j)]); sum += c; cnt += (c > 0u) ? 1u : 0u; mine = (j == x) ? c : mine; }
        if (sum == G) break;
        __builtin_amdgcn_s_sleep(1);
        if ((++sp & 255u) == 0u) { if (xb_ld(&bar[XB_TMO])) break; if (sp > XB_SPIN_CAP) { atomicAdd(&bar[XB_TMO], 1u); break; } }
    }
    nloc = mine > 0u ? mine : 1u; nx = cnt > 0u ? cnt : 1u;
}
__device__ __forceinline__ void xcd_barrier(const XcdBarrier& b) {
    asm volatile("s_waitcnt vmcnt(0)" ::: "memory");
    __syncthreads();
    if (threadIdx.x == 0) {
        unsigned* bar = b.bar;
        __builtin_amdgcn_s_waitcnt(0);
        unsigned nloc = b.st[0], nx = b.st[1];
        if (nloc == 0u) { xcd_barrier_complete(bar, b.x, nloc, nx); b.st[0] = nloc; b.st[1] = nx; }
        const unsigned old = xb_add(&bar[XB_XSUB(b.x)], 1u);
        const unsigned gen = old / nloc;
        if (old + 1u == (gen + 1u) * nloc) {
            __builtin_amdgcn_fence(__ATOMIC_RELEASE, "agent");
            asm volatile("s_waitcnt vmcnt(0)" ::: "memory");
            const unsigned og = xb_add(&bar[XB_TOP], 1u);
            const unsigned tg = og / nx;
            if (og + 1u == (tg + 1u) * nx) xb_add(&bar[XB_TOPGEN], 1u);
            else XB_SPIN(xb_ld(&bar[XB_TOPGEN]) == tg, bar);
            __builtin_amdgcn_fence(__ATOMIC_ACQUIRE, "agent");
            xb_add(&bar[XB_XGEN(b.x)], 1u);
            asm volatile("s_waitcnt vmcnt(0)" ::: "memory");
        } else {
            XB_SPIN(xb_ld(&bar[XB_XGEN(b.x)]) == gen, bar);
            __builtin_amdgcn_fence(__ATOMIC_ACQUIRE, "agent");
            asm volatile("s_waitcnt vmcnt(0)" ::: "memory");
        }
    }
    __syncthreads();
}

__device__ __forceinline__ unsigned pk2(float lo, float hi) { return (unsigned)f2bf(lo) | ((unsigned)f2bf(hi) << 16); }
__device__ __forceinline__ void p0_transpose_item(const float* W, int K, int N, bf16_t* WT, int row0, int src_col0, int k0, LAS float* scr, int lane, const float* kscale = nullptr) {
#pragma unroll 8
    for (int i = 0; i < 32; ++i) { const int kk = 2 * i + (lane >> 5); scr[kk * 33 + (lane & 31)] = W[(size_t)(k0 + kk) * N + src_col0 + (lane & 31)] * (kscale ? kscale[k0 + kk] : 1.f); }
    LDS_WAIT(); asm volatile("" ::: "memory");
    const int c = lane & 7;
#pragma unroll
    for (int j = 0; j < 4; ++j) { const int n = (lane >> 3) + 8 * j; const LAS float* s = scr + (8 * c) * 33 + n;
        u32x4 o; o.x = pk2(s[0 * 33], s[1 * 33]); o.y = pk2(s[2 * 33], s[3 * 33]); o.z = pk2(s[4 * 33], s[5 * 33]); o.w = pk2(s[6 * 33], s[7 * 33]);
        *(u32x4*)(WT + (size_t)(row0 + n) * K + k0 + 8 * c) = o; }
    LDS_WAIT(); asm volatile("" ::: "memory");
}


namespace att {
typedef short s16x4 __attribute__((ext_vector_type(4)));
typedef float f32x16 __attribute__((ext_vector_type(16)));
constexpr int D = 128, NW = 8, QBLK = 32, KVBLK = 64, QB = NW * QBLK;
constexpr int SHM_V = KVBLK * D * 2, SHM_K = KVBLK * D * 2;
constexpr int LDS_WS = 2 * SHM_V + 2 * SHM_K, LDS_CB = LDS_WS + NW * 64 * 4, LDS_ATT_BYTES = LDS_CB + 2 * 64 * 4;
constexpr float THR = 8.f;
constexpr int OSTR = FW;
#define KSWZ(row, colB) ((row) * 256 + ((colB) ^ (((row) & 7) << 4)))
#define SBAR() __builtin_amdgcn_sched_barrier(0)
__device__ __forceinline__ int v_st(int k, int c) { const int kk = (k & ~0xC) | ((k & 4) << 1) | ((k & 8) >> 1); return ((kk >> 3) * 4 + (c >> 5)) * 512 + ((kk & 7) * 32 + (c & 31)) * 2; }
__device__ __forceinline__ int v_rd_base(int lane) { return ((lane & 3) << 3) | (((lane >> 2) & 3) << 6) | (((lane >> 4) & 1) << 5) | (((lane >> 5) & 1) << 8); }
constexpr int v_rd_off(int d0, int ks, int half) { return d0 * 512 + ks * 4096 + half * 2048; }
__device__ __forceinline__ int crow(int r, int hi) { return (r & 3) + 8 * (r >> 2) + 4 * hi; }
__device__ __forceinline__ unsigned cvtpk(float lo, float hi) { unsigned r; asm volatile("s_nop 0\n\tv_cvt_pk_bf16_f32 %0, %1, %2" : "=v"(r) : "v"(lo), "v"(hi)); return r; }
__device__ __forceinline__ bf16x8 load8(const bf16_t* p) { return *reinterpret_cast<const bf16x8*>(p); }
__device__ __forceinline__ void mask_tile(f32x16& p0, f32x16& p1, int dq) {
    const float NEG = -__builtin_inff();
#pragma unroll
    for (int r = 0; r < 16; ++r) { const int c = (r & 3) + 8 * (r >> 2);
        if (dq - c < 0) p0[r] = NEG;
        if (dq - c - 32 < 0) p1[r] = NEG; }
}
__device__ __forceinline__ void partialSM(f32x16& p0, f32x16& p1, float& m_reg, float& mn, float& alpha) {
    float pmax = p0[0];
#pragma unroll
    for (int r = 1; r < 16; ++r) pmax = fmaxf(pmax, p0[r]);
#pragma unroll
    for (int r = 0; r < 16; ++r) pmax = fmaxf(pmax, p1[r]);
    { auto rr = __builtin_amdgcn_permlane32_swap(__float_as_uint(pmax), __float_as_uint(pmax), false, false);
      pmax = fmaxf(__uint_as_float(rr[0]), __uint_as_float(rr[1])); }
    constexpr float C2 = 1.4426950408889634f * SCALE;
    if (__builtin_expect(__all((pmax - m_reg) * SCALE <= THR), 1)) { mn = m_reg; alpha = 1.f; }
    else { mn = fmaxf(m_reg, pmax); alpha = __builtin_amdgcn_exp2f((m_reg - mn) * C2); m_reg = mn; }
    const float mnL = -mn * C2;
#pragma unroll
    for (int r = 0; r < 16; ++r) p0[r] = fmaf(p0[r], C2, mnL);
#pragma unroll
    for (int r = 0; r < 16; ++r) p1[r] = fmaf(p1[r], C2, mnL);
#pragma unroll
    for (int r = 0; r < 16; ++r) p0[r] = __builtin_amdgcn_exp2f(p0[r]);
}
__device__ __forceinline__ void finishSM(f32x16& p0, f32x16& p1, float alpha, float& l_reg, bf16x8& pa0, bf16x8& pa1, bf16x8& pa2, bf16x8& pa3) {
#pragma unroll
    for (int r = 0; r < 16; ++r) p1[r] = __builtin_amdgcn_exp2f(p1[r]);
    float ps = 0;
#pragma unroll
    for (int r = 0; r < 16; ++r) ps += p0[r];
#pragma unroll
    for (int r = 0; r < 16; ++r) ps += p1[r];
    { auto rr = __builtin_amdgcn_permlane32_swap(__float_as_uint(ps), __float_as_uint(ps), false, false);
      ps = __uint_as_float(rr[0]) + __uint_as_float(rr[1]); }
    l_reg = l_reg * alpha + ps;
#define PK4(P, B_, OUT) do { unsigned a0 = cvtpk(P[B_+0], P[B_+1]), a1 = cvtpk(P[B_+2], P[B_+3]);                          \
        unsigned b0 = cvtpk(P[B_+4], P[B_+5]), b1 = cvtpk(P[B_+6], P[B_+7]);                                             \
        auto r0 = __builtin_amdgcn_permlane32_swap(a0, b0, false, false); auto r1 = __builtin_amdgcn_permlane32_swap(a1, b1, false, false); \
        u32x4 w = {r0[0], r1[0], r0[1], r1[1]}; OUT = *reinterpret_cast<bf16x8*>(&w); } while (0)
    PK4(p0, 0, pa0); PK4(p0, 8, pa1); PK4(p1, 0, pa2); PK4(p1, 8, pa3);
#undef PK4
}
template <int KB>
__device__ __forceinline__ void qkt(f32x16& p0, f32x16& p1, const char* K_lds, const float* CB, int r32, int hi, const bf16x8* qr, float cq) {
    const float* cb = CB + KB * 64 + 4 * hi;
#pragma unroll
    for (int g = 0; g < 4; ++g) { const f32x4 c0 = *(const f32x4*)(cb + 8 * g), c1 = *(const f32x4*)(cb + 32 + 8 * g);
#pragma unroll
        for (int e = 0; e < 4; ++e) { p0[4 * g + e] = cq - c0[e]; p1[4 * g + e] = cq - c1[e]; } }
    const char* kb[4];
#pragma unroll
    for (int dd = 0; dd < 4; ++dd) kb[dd] = K_lds + KB * SHM_K + KSWZ(r32, (dd * 16 + hi * 8) * 2);
#pragma unroll
    for (int d0 = 0; d0 < 8; ++d0) { const char* a = kb[d0 & 3] + (d0 >> 2) * 128;
        bf16x8 b0 = *reinterpret_cast<const bf16x8*>(a);
        bf16x8 b1 = *reinterpret_cast<const bf16x8*>(a + 32 * 256);
        p0 = __builtin_amdgcn_mfma_f32_32x32x16_bf16(b0, qr[d0], p0, 0, 0, 0);
        p1 = __builtin_amdgcn_mfma_f32_32x32x16_bf16(b1, qr[d0], p1, 0, 0, 0); }
}
template <int VB>
__device__ __forceinline__ void pv_tile(f32x16* o, int vb0, bf16x8 pa0, bf16x8 pa1, bf16x8 pa2, bf16x8 pa3) {
#define TRRD(dst, off) asm volatile("ds_read_b64_tr_b16 %0, %1 offset:%2" : "=&v"(dst) : "v"(vb0), "i"(off) : "memory")
#define PV_D0(d0) do { s16x4 l0, l1, l2, l3, h0, h1, h2, h3; constexpr int b_ = VB * SHM_V + v_rd_off(d0, 0, 0); \
        TRRD(l0, b_); TRRD(h0, b_ + 2048); TRRD(l1, b_ + 4096); TRRD(h1, b_ + 6144); TRRD(l2, b_ + 8192); TRRD(h2, b_ + 10240); TRRD(l3, b_ + 12288); TRRD(h3, b_ + 14336); \
        asm volatile("s_waitcnt lgkmcnt(0)" ::: "memory"); SBAR();   \
        o[d0] = __builtin_amdgcn_mfma_f32_32x32x16_bf16(pa0, (bf16x8){l0[0], l0[1], l0[2], l0[3], h0[0], h0[1], h0[2], h0[3]}, o[d0], 0, 0, 0);   \
        o[d0] = __builtin_amdgcn_mfma_f32_32x32x16_bf16(pa1, (bf16x8){l1[0], l1[1], l1[2], l1[3], h1[0], h1[1], h1[2], h1[3]}, o[d0], 0, 0, 0);   \
        o[d0] = __builtin_amdgcn_mfma_f32_32x32x16_bf16(pa2, (bf16x8){l2[0], l2[1], l2[2], l2[3], h2[0], h2[1], h2[2], h2[3]}, o[d0], 0, 0, 0);   \
        o[d0] = __builtin_amdgcn_mfma_f32_32x32x16_bf16(pa3, (bf16x8){l3[0], l3[1], l3[2], l3[3], h3[0], h3[1], h3[2], h3[3]}, o[d0], 0, 0, 0); } while (0)
    PV_D0(0); PV_D0(1); PV_D0(2); PV_D0(3);
#undef PV_D0
#undef TRRD
}
struct BlockRef { const bf16_t* Q; const bf16_t* K; const bf16_t* V; const float* C; bf16_t* O; int P0; int jlo; };
struct Seam { bf16x8 qr[8]; bf16x8 st_v0, st_v1, st_k0, st_k1; float st_c; float cq; };
#define ROW(p, k0, rr) ((p) + (size_t)((k0) + (rr)) * D + sc)
#define VMW() asm volatile("s_waitcnt vmcnt(0)" ::: "memory")
#define VMWN(n) asm volatile("s_waitcnt vmcnt(%0)" :: "i"(n) : "memory")
#define SLOAD_H(Kp, Vp, Cp, k0) do { S.st_v0 = load8(ROW(Vp, k0, sr)); S.st_v1 = load8(ROW(Vp, k0, 32 + sr));              \
                         S.st_k0 = load8(ROW(Kp, k0, sr)); S.st_k1 = load8(ROW(Kp, k0, 32 + sr)); S.st_c = (Cp)[(k0) + (tid & 63)]; } while (0)
#define SWRITE_HK(bf) do { *(bf16x8*)(K_lds + (bf) * SHM_K + kws) = S.st_k0; *(bf16x8*)(K_lds + (bf) * SHM_K + kws + 32 * 256) = S.st_k1; if (wid == 0) CB[(bf) * 64 + lane] = S.st_c; } while (0)
#define SWRITE_HV(bf) do { *(bf16x8*)(V_lds + (bf) * SHM_V + vst0) = S.st_v0; *(bf16x8*)(V_lds + (bf) * SHM_V + vst1) = S.st_v1; } while (0)
#define SWRITE_H(bf) do { SWRITE_HV(bf); SWRITE_HK(bf); } while (0)
__device__ __forceinline__ void attn_prime(const BlockRef& cur, char* lds, Seam& S, int wid) {
    const int lane = lane_now(), tid = wid * 64 + lane, r32 = lane & 31, hi = lane >> 5;
    const int sr = tid >> 4, sc = (tid & 15) * 8, kws = KSWZ(sr, sc * 2); char* K_lds = lds + 2 * SHM_V; float* CB = (float*)(lds + LDS_CB);
#pragma unroll
    for (int d0 = 0; d0 < 8; ++d0) S.qr[d0] = load8(cur.Q + (size_t)(wid * QBLK + r32) * D + d0 * 16 + hi * 8);
    S.cq = cur.C[cur.P0 + wid * QBLK + r32];
    SLOAD_H(cur.K, cur.V, cur.C, cur.jlo * KVBLK); VMW(); SWRITE_HK(0);
    __syncthreads();
}
__device__ __forceinline__ void attn_block(const BlockRef& cur, const BlockRef& nxt, char* lds, Seam& S, int wid) {
    const int lane = lane_now(), tid = wid * 64 + lane, r32 = lane & 31, hi = lane >> 5;
    const int NT = (cur.P0 + QB) / KVBLK - cur.jlo;
    const int qlo = cur.P0 + wid * QBLK, qm = qlo + r32 - 4 * hi;
    char* V_lds = lds; char* K_lds = lds + 2 * SHM_V; float* CB = (float*)(lds + LDS_CB);
    float* ws = (float*)(lds + LDS_WS) + wid * 64; float* li_l = ws, * al_l = ws + 32;
    float m_reg = -1e30f, l_reg = 0; f32x16 o[4] = {};
    const int sr = tid >> 4, sc = (tid & 15) * 8, vst0 = v_st(sr, sc), vst1 = v_st(32 + sr, sc), kws = KSWZ(sr, sc * 2);
    const int vb0 = (int)(uintptr_t)V_lds + v_rd_base(lane);
    const bf16_t* Kh = cur.K; const bf16_t* Vh = cur.V; const float* Ch = cur.C; const float cq = S.cq;
#define RESC(a) do { if (__any((a) < 1.f)) { if (hi == 0) al_l[r32] = (a); asm volatile("s_waitcnt lgkmcnt(0)" ::: "memory");              \
                     for (int d_ = 0; d_ < 4; ++d_) for (int r = 0; r < 16; ++r) o[d_][r] *= al_l[crow(r, hi)]; } } while (0)
#define KBASE(t) ((cur.jlo + (t)) * KVBLK)
#define MASKT(P0_, P1_, t) do { const int kb_ = KBASE(t); if (kb_ + KVBLK - 1 > qlo) mask_tile(P0_, P1_, qm - kb_); } while (0)
    constexpr int NQL = 9;
#define SEAM_K0() do { VMWN(NQL); SWRITE_HK(0); SBAR(); } while (0)
    f32x16 pA0, pA1, pB0, pB1; float mnA, mnB, alA, alB; bf16x8 pa0, pa1, pa2, pa3;
    SWRITE_HV(0); SBAR();
    if (NT > 1) { SLOAD_H(Kh, Vh, Ch, KBASE(1)); }
    SBAR(); qkt<0>(pA0, pA1, K_lds, CB, r32, hi, S.qr, cq);
    MASKT(pA0, pA1, 0); partialSM(pA0, pA1, m_reg, mnA, alA);
    if (NT > 1) { VMW(); SWRITE_H(1); }
    __syncthreads();
#define HALF_STEP(PX0, PX1, mnX, alX, PY0, PY1, alY, t, KB, VB, SB) do {                                                      \
        SBAR(); qkt<KB>(PX0, PX1, K_lds, CB, r32, hi, S.qr, cq);                                             \
        finishSM(PY0, PY1, alY, l_reg, pa0, pa1, pa2, pa3); SBAR();                                                           \
        if ((t) + 1 < NT) { SLOAD_H(Kh, Vh, Ch, KBASE((t) + 1)); SBAR(); }                                               \
        pv_tile<VB>(o, vb0, pa0, pa1, pa2, pa3); MASKT(PX0, PX1, (t)); partialSM(PX0, PX1, m_reg, mnX, alX);                                        \
        __syncthreads();                                                                                                      \
        if ((t) + 1 < NT) { VMW(); SWRITE_H(SB); }                                                                          \
        RESC(alX); __syncthreads(); } while (0)
    for (int t = 1; t + 1 < NT; t += 2) {
        HALF_STEP(pB0, pB1, mnB, alB, pA0, pA1, alA, t, 1, 0, 0);
        HALF_STEP(pA0, pA1, mnA, alA, pB0, pB1, alB, t + 1, 0, 1, 1);
    }
    const bool even = (NT & 1) == 0;
    if (even) { SBAR(); qkt<1>(pB0, pB1, K_lds, CB, r32, hi, S.qr, cq); SBAR(); }
    { SLOAD_H(nxt.K, nxt.V, nxt.C, nxt.jlo * KVBLK); SBAR();
#pragma unroll
      for (int d0 = 0; d0 < 8; ++d0) S.qr[d0] = load8(nxt.Q + (size_t)(wid * QBLK + r32) * D + d0 * 16 + hi * 8);
      S.cq = nxt.C[nxt.P0 + wid * QBLK + r32]; }
    SBAR();
    finishSM(pA0, pA1, alA, l_reg, pa0, pa1, pa2, pa3); SBAR();
    pv_tile<0>(o, vb0, pa0, pa1, pa2, pa3);
    if (even) { MASKT(pB0, pB1, NT - 1); partialSM(pB0, pB1, m_reg, mnB, alB); __syncthreads(); RESC(alB);
        finishSM(pB0, pB1, alB, l_reg, pa0, pa1, pa2, pa3); SBAR(); pv_tile<1>(o, vb0, pa0, pa1, pa2, pa3); }
    SBAR(); SEAM_K0();
    if (hi == 0) li_l[r32] = l_reg; asm volatile("s_waitcnt lgkmcnt(0)" ::: "memory");
    float rli[16];
#pragma unroll
    for (int r = 0; r < 16; ++r) rli[r] = __builtin_amdgcn_rcpf(li_l[crow(r, hi)]);
    bf16_t* Ow = cur.O + (size_t)(wid * QBLK) * OSTR;
#pragma unroll
    for (int r = 0; r < 16; ++r) { const int orow = crow(r, hi);
#pragma unroll
        for (int d0 = 0; d0 < 4; ++d0) { const float v = o[d0][r] * rli[r];
            const float vn = __shfl_xor(v, 1);
            if ((r32 & 1) == 0) *(unsigned*)(Ow + (size_t)orow * OSTR + d0 * 32 + r32) = cvtpk(v, vn); } }
    __syncthreads();
#undef RESC
#undef KBASE
#undef MASKT
#undef SEAM_K0
#undef HALF_STEP
}
#undef ROW
#undef VMW
#undef VMWN
#undef SLOAD_H
#undef SWRITE_HK
#undef SWRITE_HV
#undef SWRITE_H
#undef SBAR
}

typedef __bf16 bf16x2_t __attribute__((ext_vector_type(2)));

__device__ __forceinline__ float dot2bf(unsigned a, unsigned b, float c) {
    bf16x2_t av, bv; __builtin_memcpy(&av, &a, 4); __builtin_memcpy(&bv, &b, 4); return __builtin_amdgcn_fdot2_f32_bf16(av, bv, c, false); }
__device__ __forceinline__ float dot2bf_s(unsigned s_uniform, unsigned b, float c) { return dot2bf(s_uniform, b, c); }
namespace peer {
typedef float f32x16 __attribute__((ext_vector_type(16)));
__device__ __forceinline__ float fmaxs(float a, float b) { float r; asm("v_max_f32_e32 %0, %1, %2" : "=v"(r) : "v"(a), "v"(b)); return r; }
__device__ __forceinline__ float fmins(float a, float b) { float r; asm("v_min_f32_e32 %0, %1, %2" : "=v"(r) : "v"(a), "v"(b)); return r; }
#define CE(a, b) do { const float _h = fmaxs(a, b), _l = fmins(a, b); a = _h; b = _l; } while (0)
__device__ __forceinline__ void insert16(float (&L)[16], float x) {
#pragma unroll
    for (int i = 0; i < 16; ++i) { const float h = fmaxs(L[i], x); x = fmins(L[i], x); L[i] = h; }
}
__device__ __forceinline__ void sort16_desc(float (&v)[16]) {
#pragma unroll
    for (int k = 2; k <= 16; k <<= 1)
#pragma unroll
        for (int j = k >> 1; j >= 1; j >>= 1)
#pragma unroll
            for (int i = 0; i < 16; ++i) { const int l = i ^ j; if (l > i) { const bool desc = (i & k) == 0; const float hi_ = fmaxs(v[i], v[l]), lo_ = fmins(v[i], v[l]); v[i] = desc ? hi_ : lo_; v[l] = desc ? lo_ : hi_; } }
}
__device__ __forceinline__ void merge16(float (&L)[16], const float (&S)[16]) {
#pragma unroll
    for (int i = 0; i < 16; ++i) L[i] = fmaxs(L[i], S[15 - i]);
#pragma unroll
    for (int d = 8; d >= 1; d >>= 1)
#pragma unroll
        for (int i = 0; i < 16; ++i) if ((i & d) == 0) CE(L[i], L[i + d]);
}
__device__ __forceinline__ void merge_partner(float (&L)[16], const bool lo_half) {
    float B[16];
#pragma unroll
    for (int i = 0; i < 16; ++i) { auto r = __builtin_amdgcn_permlane32_swap(__float_as_uint(L[i]), __float_as_uint(L[i]), false, false);
        B[i] = __uint_as_float(lo_half ? r[1] : r[0]); }
#pragma unroll
    for (int i = 0; i < 16; ++i) L[i] = fmaxs(L[i], B[15 - i]);
#pragma unroll
    for (int d = 8; d >= 1; d >>= 1)
#pragma unroll
        for (int i = 0; i < 16; ++i) if ((i & d) == 0) CE(L[i], L[i + d]);
}
constexpr int KEYS_BYTES = 65536, SCR_OFF = 65536;
}

__device__ __forceinline__ void p0_transpose_item_fp8(const float* W, int K, int N, unsigned char* WT8, int row0, int src_col0, int k0, LAS float* scr, int lane, float sc) {
#pragma unroll 8
    for (int i = 0; i < 32; ++i) { const int kk = 2 * i + (lane >> 5); scr[kk * 33 + (lane & 31)] = W[(size_t)(k0 + kk) * N + src_col0 + (lane & 31)]; }
    LDS_WAIT(); asm volatile("" ::: "memory");
    const int c = lane & 3;
#pragma unroll
    for (int j = 0; j < 2; ++j) { const int n = (lane >> 2) + 16 * j; const LAS float* sp = scr + (16 * c) * 33 + n; u32x4 o;
#pragma unroll
        for (int q = 0; q < 4; ++q) { int p = 0; p = __builtin_amdgcn_cvt_pk_fp8_f32(sp[(4 * q) * 33] * sc, sp[(4 * q + 1) * 33] * sc, p, false); p = __builtin_amdgcn_cvt_pk_fp8_f32(sp[(4 * q + 2) * 33] * sc, sp[(4 * q + 3) * 33] * sc, p, true); o[q] = (unsigned)p; }
        *(u32x4*)(WT8 + (size_t)(row0 + n) * K + k0 + 16 * c) = o; }
    LDS_WAIT(); asm volatile("" ::: "memory");
}
constexpr float H8_SCALE = 16.f, W8_SCALE = 512.f;
constexpr size_t DO_W8 = 80 * MiB, DO_H8 = 96 * MiB;

struct Args { const float* in[17]; float* out; unsigned char* ws; int ph_lo, ph_hi; };
constexpr int N_PHASES = 11;

__global__ void __launch_bounds__(NTHR, 2) mega(Args args) {
    extern __shared__ __attribute__((aligned(16))) unsigned char lds_raw[];
    LAS unsigned char* lds = (LAS unsigned char*)lds_raw;
    volatile LAS unsigned* MISC = (volatile LAS unsigned*)(lds + MISC_OFF);
    const int wave = __builtin_amdgcn_readfirstlane((int)threadIdx.x >> 6);
    const int G = gridDim.x, bx = blockIdx.x, vcu = (G % 8 == 0) ? (bx % 8) * (G / 8) + bx / 8 : bx;
    unsigned char* ws = args.ws; char* dob = (char*)args.out;
    const float* x = args.in[0]; const float* g1 = args.in[1]; const float* w_in = args.in[2]; const float* fbias = args.in[3];
    const float* gq = args.in[4]; const float* gk = args.in[5]; const float* pgw = args.in[6]; const float* pscale = args.in[7];
    const float* wba = args.in[8]; const float* wbp = args.in[9]; const float* wout = args.in[10]; const float* g2 = args.in[11];
    const float* wq = args.in[12]; const float* sk1 = args.in[13]; const float* sk2 = args.in[14]; const float* eu = args.in[15]; const float* ev = args.in[16];
    bf16_t* WT_IN = (bf16_t*)(dob + DO_WT_IN); unsigned char* W8 = (unsigned char*)(dob + DO_W8); unsigned char* H8 = (unsigned char*)(dob + DO_H8); bf16_t* H1 = (bf16_t*)(dob + DO_H1); bf16_t* Ob = (bf16_t*)(dob + DO_O); bf16_t* POOLED = (bf16_t*)(dob + DO_POOLED); bf16_t* POOL2 = (bf16_t*)(dob + DO_POOL2);
    bf16_t* WT_PG = (bf16_t*)(ws + WS_WT_PG); bf16_t* WT_BA = (bf16_t*)(ws + WS_WT_BA); bf16_t* WT_BP = (bf16_t*)(ws + WS_WT_BP); bf16_t* WT_OUT = (bf16_t*)(ws + WS_WT_OUT); bf16_t* WT_Q = (bf16_t*)(ws + WS_WT_Q);
    bf16_t* SK = (bf16_t*)(ws + WS_SK); float* CS = (float*)(ws + WS_CS); float* LOGF = (float*)(ws + WS_LOGF); float* SSQ = (float*)(ws + WS_SSQ);
    bf16_t* Qb = (bf16_t*)(ws + WS_Q); bf16_t* Kb = (bf16_t*)(ws + WS_K); bf16_t* Vb = (bf16_t*)(ws + WS_V); bf16_t* PIN = (bf16_t*)(ws + WS_PIN); bf16_t* Gt = (bf16_t*)(ws + WS_G);
    bf16_t* EU = (bf16_t*)(ws + WS_EU); bf16_t* EV = (bf16_t*)(ws + WS_EV); bf16_t* XG = (bf16_t*)(ws + WS_XG); bf16_t* TMP = (bf16_t*)(ws + WS_TMP); bf16_t* MERGED = (bf16_t*)(ws + WS_MERGED); bf16_t* QP = (bf16_t*)(ws + WS_QP);
    for (int u = threadIdx.x; u < 128; u += NTHR) MISC[u] = 0u;
    __syncthreads();
    const int lo = args.ph_lo, hi = args.ph_hi;
    XcdBarrier bar; bar.bar = (unsigned*)(ws + WS_CTL) + CW_BAR + lo * XCD_BAR_WORDS; bar.x = 0; bar.st = MISC + 8;
    if (hi - lo > 1) bar = xcd_barrier_post(bar.bar, MISC + 8);
#define IN(k) (lo <= (k) && (k) < hi)
#define SEAM(k) do { if (IN(k) && IN((k) + 1)) xcd_barrier(bar); } while (0)
    const int gw = vcu * NWAVES + wave, NGW = G * NWAVES;

    if (IN(0)) {
        const int lane = lane_now(), tid = wave * 64 + lane;
        LAS float* scr = (LAS float*)(lds + RING_OFF + wave * 16384);
        constexpr int I_IN = (DM / 64) * (NPROJ / 32),     I_BA = (FW / 64) * (DM / 32), I_OUT = (DM / 64) * (DM / 32), I_PG = 4 * (256 / 64) * (256 / 32);
        constexpr int NITEMS = I_IN + 2 * I_BA + 2 * I_OUT + I_PG;
        for (int it = gw; it < NITEMS; it += NGW) {
            int r = it;
            if (r < I_IN) { const int nblk = NPROJ / 32, kb = r / nblk, nb = r % nblk, n0 = nb * 32;
                if (n0 < 4096) p0_transpose_item(w_in, DM, INC, WT_IN, n0, n0 + (n0 >= 3072 ? 8 : 0), kb * 64, scr, lane);
                else p0_transpose_item_fp8(w_in, DM, INC, W8, n0 - 4096, n0 + 8, kb * 64, scr, lane, W8_SCALE);
                continue; } r -= I_IN;
            if (r < I_BA) { const int nblk = DM / 32, kb = r / nblk, nb = r % nblk; p0_transpose_item(wba, FW, DM, WT_BA, nb * 32, nb * 32, kb * 64, scr, lane); continue; } r -= I_BA;
            if (r < I_BA) { const int nblk = DM / 32, kb = r / nblk, nb = r % nblk; p0_transpose_item(wbp, PW, DM, WT_BP, nb * 32, nb * 32, kb * 64, scr, lane); continue; } r -= I_BA;
            if (r < I_OUT) { const int nblk = DM / 32, kb = r / nblk, nb = r % nblk; p0_transpose_item(wout, DM, DM, WT_OUT, nb * 32, nb * 32, kb * 64, scr, lane); continue; } r -= I_OUT;
            if (r < I_OUT) { const int nblk = DM / 32, kb = r / nblk, nb = r % nblk; p0_transpose_item(wq, DM, DM, WT_Q, nb * 32, nb * 32, kb * 64, scr, lane, g2); continue; } r -= I_OUT;
            { const int g = r / 32, rr = r % 32, kb = rr / 8, nb = rr % 8; p0_transpose_item(pgw + (size_t)g * 65536, 256, 256, WT_PG, g * 256 + nb * 32, nb * 32, kb * 64, scr, lane); }
        }
        for (int i = gw * 64 + lane; i < 2048 * 128 / 4; i += NGW * 64) { const int e = i * 4, d = e & 127, n = e >> 7, key = n & 127, f = (n >> 7) & 1, h = n >> 8;
            const f32x4 v = *(const f32x4*)((f ? sk2 : sk1) + ((size_t)h * 128 + key) * 128 + d); u32x2 o; o.x = pk2(v[0], v[1]); o.y = pk2(v[2], v[3]); *(u32x2*)(SK + e) = o; }
        { unsigned char* E8 = (unsigned char*)(ws + WS_EU); float* ESC = (float*)(ws + WS_EV);
          for (int r0 = gw; r0 < 2 * NEXP; r0 += 2 * NGW) {
            f32x4 v[2][8];
#pragma unroll
            for (int u = 0; u < 2; ++u) { const int r = r0 + u * NGW; const float* src = (r < NEXP ? eu : ev - (size_t)NEXP * DM) + (size_t)r * DM;
#pragma unroll
                for (int i = 0; i < 2; ++i)
#pragma unroll
                    for (int c = 0; c < 4; ++c) v[u][i * 4 + c] = *(const f32x4*)(src + 1024 * i + 16 * lane + 4 * c); }
#pragma unroll
            for (int u = 0; u < 2; ++u) { const int r = r0 + u * NGW; float am = 0.f;
                if (r < NEXP) {
#pragma unroll
                    for (int i = 0; i < 2; ++i)
#pragma unroll
                        for (int c = 0; c < 4; ++c) v[u][i * 4 + c] = v[u][i * 4 + c] * *(const f32x4*)(g2 + 1024 * i + 16 * lane + 4 * c); }
#pragma unroll
                for (int q = 0; q < 8; ++q) am = fmaxf(am, fmaxf(fmaxf(fabsf(v[u][q][0]), fabsf(v[u][q][1])), fmaxf(fabsf(v[u][q][2]), fabsf(v[u][q][3]))));
#pragma unroll
                for (int o = 1; o < 64; o <<= 1) am = fmaxf(am, __shfl_xor(am, o));
                int ex = (int)((__float_as_uint(am) >> 23) & 0xffu); if (ex < 16) ex = 134;
                const float sc = __uint_as_float((unsigned)(261 - ex) << 23), inv = __uint_as_float((unsigned)(ex - 7) << 23);
#pragma unroll
                for (int i = 0; i < 2; ++i) { u32x4 w;
#pragma unroll
                    for (int c = 0; c < 4; ++c) { const f32x4 t = v[u][i * 4 + c] * sc; int p = 0;
                        p = __builtin_amdgcn_cvt_pk_fp8_f32(t[0], t[1], p, false); p = __builtin_amdgcn_cvt_pk_fp8_f32(t[2], t[3], p, true); w[c] = (unsigned)p; }
                    *(u32x4*)(E8 + (size_t)(r >= NEXP) * NEXP * DM + ((size_t)(8 * i + (lane >> 3)) * NEXP + (r & (NEXP - 1))) * 128 + 16 * (lane & 7)) = w; }
                if (lane == 0) ESC[r] = inv; }
          } }
        __syncthreads();
        LAS f32x4* WfL = (LAS f32x4*)(lds + RING_OFF);
        for (int i = tid; i < 4096; i += NTHR) { const int l = i & 63, half = (i >> 6) & 1, e = (i >> 7) & 3, j = i >> 9, k = 256 * j + 4 * l + e;
            WfL[i] = *(const f32x4*)(w_in + (size_t)k * INC + 3072 + 4 * half); }
        __syncthreads();
        f32x4 gv[8];
#pragma unroll
        for (int j = 0; j < 8; ++j) gv[j] = ((const f32x4*)g1)[64 * j + lane];
        for (int row0 = gw; row0 < T; row0 += 2 * NGW) {
            f32x4 v[2][8];
#pragma unroll
            for (int u = 0; u < 2; ++u) { const f32x4* xr = (const f32x4*)(x + (size_t)(row0 + u * NGW) * DM) + lane;
#pragma unroll
                for (int j = 0; j < 8; ++j) v[u][j] = xr[64 * j]; }
#pragma unroll
            for (int u = 0; u < 2; ++u) { const int row = row0 + u * NGW; float ss = 0.f;
#pragma unroll
                for (int j = 0; j < 8; ++j) ss += (v[u][j][0] * v[u][j][0] + v[u][j][1] * v[u][j][1]) + (v[u][j][2] * v[u][j][2] + v[u][j][3] * v[u][j][3]);
                const float rstd = rsqrtf(wave_sum(ss) * (1.f / DM) + EPS);
                f32x4 a0 = {0.f, 0.f, 0.f, 0.f}, a1 = {0.f, 0.f, 0.f, 0.f};
                unsigned long long* o8 = (unsigned long long*)(H1 + (size_t)row * DM) + lane;
#pragma unroll
                for (int j = 0; j < 8; ++j) { const f32x4 hv = v[u][j] * rstd * gv[j];
                    o8[64 * j] = (unsigned long long)cvt_pk_bf16(hv[0], hv[1]) | ((unsigned long long)cvt_pk_bf16(hv[2], hv[3]) << 32);
                    { int p8 = 0; p8 = __builtin_amdgcn_cvt_pk_fp8_f32(hv[0] * H8_SCALE, hv[1] * H8_SCALE, p8, false); p8 = __builtin_amdgcn_cvt_pk_fp8_f32(hv[2] * H8_SCALE, hv[3] * H8_SCALE, p8, true);
                      ((unsigned*)(H8 + (size_t)row * DM))[64 * j + lane] = (unsigned)p8; }
#pragma unroll
                    for (int e = 0; e < 4; ++e) { a0 += WfL[((j * 4 + e) * 2 + 0) * 64 + lane] * hv[e]; a1 += WfL[((j * 4 + e) * 2 + 1) * 64 + lane] * hv[e]; } }
                float z = 0.f;
#pragma unroll
                for (int c = 0; c < 8; ++c) { const float t = wave_sum(c < 4 ? a0[c & 3] : a1[c & 3]); if (lane == c) z = t; }
                if (lane < 8) { z += fbias[lane]; LOGF[(size_t)row * 8 + lane] = fminf(z, 0.f) - log1pf(expf(-fabsf(z))); } }
        }
    }
    SEAM(0);
    if (IN(1)) {
        if (bx < 32) {   const int lane = lane_now(), tid = wave * 64 + lane;
            LAS float* wsum = (LAS float*)(lds + EPI_OFF);
            const int b = bx >> 3, h = bx & 7; float v[8]; float run = 0.f;
#pragma unroll
            for (int i = 0; i < 8; ++i) { run += LOGF[((size_t)(b * S + tid * 8 + i)) * 8 + h]; v[i] = run; }
            float inc = run;
#pragma unroll
            for (int o = 1; o < 64; o <<= 1) { const float t = __shfl_up(inc, o); if (lane >= o) inc += t; }
            if (lane == 63) wsum[wave] = inc;
            __syncthreads();
            float base = inc - run;
            for (int w = 0; w < wave; ++w) base += wsum[w];
#pragma unroll
            for (int i = 0; i < 8; ++i) CS[(size_t)bx * S + tid * 8 + i] = (base + v[i]) * INV_SCALE;
            __syncthreads();
        }
        { pg8::SchedStd Sc{(const char*)H1, (const char*)WT_IN, (size_t)256 * DM * 2, (size_t)256 * DM * 2, 0, T / 256, 4096 / 256, (T / 256) * (4096 / 256), G, bx};
          EpiProj E{Qb, Kb, Vb, PIN, Gt, gq, gk, (LAS float*)(lds + EPI_OFF)};
          pg8::gemm_phase(lds + RING_OFF, wave, DM, DM, DM, Sc, E); }
        { pg8::SchedStd Sc{(const char*)H8, (const char*)W8, (size_t)256 * DM, (size_t)256 * DM, 0, T / 256, 4096 / 256, (T / 256) * (4096 / 256), G, bx};
          EpiGate E{Gt, 1.f / (H8_SCALE * W8_SCALE)};
          pg8::gemm_phase<true>(lds + RING_OFF, wave, DM / 2, DM / 2, DM / 2, Sc, E); }
    }
    SEAM(1);
    if (IN(2)) {
        const int lane = lane_now(), sub = lane >> 4, l16 = lane & 15;
#define POOL_BODY(W) do { \
            const int s0 = rb * 8, sq = s0 & (S - 1); const bf16_t* pp = PIN + (size_t)s0 * PW + ch; \
            f32x4 Pa[W + 7], Pb[W + 7]; \
            _Pragma("unroll") for (int r = 0; r < W + 7; ++r) { const int rel = r - (W - 1); \
                if (sq + rel >= 0) unpack8(*(const u32x4*)(pp + (long)rel * PW), Pa[r], Pb[r]); else { Pa[r] = (f32x4){0.f, 0.f, 0.f, 0.f}; Pb[r] = Pa[r]; } } \
            f32x4 Sa = {0.f, 0.f, 0.f, 0.f}, Sb = Sa; \
            _Pragma("unroll") for (int r = 0; r < W - 1; ++r) { Sa += Pa[r]; Sb += Pb[r]; } \
            _Pragma("unroll") for (int r = 0; r < 8; ++r) { Sa += Pa[r + W - 1]; Sb += Pb[r + W - 1]; \
                const int cnt = (sq + r + 1 < W) ? sq + r + 1 : W; const float inv = 1.f / (float)cnt; \
                *(u32x4*)(POOLED + (size_t)(s0 + r) * PW + ch) = pack8(Sa * inv - Pa[r + W - 1], Sb * inv - Pb[r + W - 1]); \
                Sa -= Pa[r]; Sb -= Pb[r]; } } while (0)
        for (int itp = gw; itp < 4 * (T / 16); itp += NGW) {
            const int g = itp & 3, rb = (itp >> 2) * 2 + (lane >> 5), ch = g * 256 + (lane & 31) * 8;
            if (g == 0) POOL_BODY(2); else if (g == 1) POOL_BODY(4); else if (g == 2) POOL_BODY(8); else POOL_BODY(16);
        }
#undef POOL_BODY
    }
    SEAM(2);
    if (IN(3)) {
        float bq;
        { const int lane = lane_now(); float a = fmaxf(fabsf(gq[lane]), fabsf(gq[64 + lane])), b2 = fmaxf(fabsf(gk[lane]), fabsf(gk[64 + lane]));
#pragma unroll
          for (int o = 1; o < 64; o <<= 1) { a = fmaxf(a, __shfl_xor(a, o)); b2 = fmaxf(b2, __shfl_xor(b2, o)); }
          bq = 128.f * SCALE * a * b2 + EPS; }
        const float cmargin = (30.f + 2.f * bq) * INV_SCALE;
#define ATT_JLO(Chp, qb) ({ const int lane_ = lane_now(), nte_ = 4 * ((qb) + 1); const float thr_ = (Chp)[(qb) * 256] + cmargin; \
            const float v_ = (lane_ < nte_) ? (Chp)[64 * lane_ + 63] : -3.0e38f; const int n_ = (int)__builtin_popcountll(__ballot(v_ > thr_)); \
            __builtin_amdgcn_readfirstlane(n_ < nte_ - 4 ? n_ : nte_ - 4); })
        for (int L = vcu; L < Bn * NH * 8; L += G) {
            const int bh = L >> 3, xq = L & 7, b = bh >> 3, h = bh & 7;
            const bf16_t* Kh = Kb + (size_t)bh * S * HD; const bf16_t* Vh = Vb + (size_t)bh * S * HD; const float* Ch = CS + (size_t)bh * S;
            const int j0 = ATT_JLO(Ch, xq), j1 = ATT_JLO(Ch, 15 - xq);
            att::BlockRef r0{Qb + ((size_t)bh * S + xq * 256) * HD, Kh, Vh, Ch, Ob + ((size_t)(b * S + xq * 256)) * FW + h * HD, xq * 256, j0};
            att::BlockRef r1{Qb + ((size_t)bh * S + (15 - xq) * 256) * HD, Kh, Vh, Ch, Ob + ((size_t)(b * S + (15 - xq) * 256)) * FW + h * HD, (15 - xq) * 256, j1};
            att::Seam Sm;
            att::attn_prime(r0, (char*)lds_raw, Sm, wave);
            att::attn_block(r0, r1, (char*)lds_raw, Sm, wave);
            att::attn_block(r1, r1, (char*)lds_raw, Sm, wave);
        }
#undef ATT_JLO
        VM_WAIT(); __syncthreads();
        pg8::SchedStd Sc{(const char*)POOLED, (const char*)WT_PG, (size_t)256 * PW * 2, (size_t)256 * 256 * 2, (size_t)256 * 2, T / 256, PW / 256, (T / 256) * (PW / 256), G, bx};
        EpiPool2 E{POOL2, pscale};
        pg8::gemm_phase(lds + RING_OFF, wave, 256, PW, 256, Sc, E);
    }
    SEAM(3);
    if (IN(4)) {
        pg8::SchedPair Sc{(const char*)Ob, (const char*)POOL2, (const char*)WT_BA, (const char*)WT_BP, (size_t)256 * FW * 2, (size_t)256 * FW * 2, T / 256, DM / 256, (T / 256) * (DM / 256), G, bx};
        EpiBranch E{TMP, MERGED, Gt};
        pg8::gemm_phase(lds + RING_OFF, wave, FW, FW, FW, Sc, E);
    }
    SEAM(4);
    if (IN(5)) {
        pg8::SchedStd Sc{(const char*)MERGED, (const char*)WT_OUT, (size_t)256 * DM * 2, (size_t)256 * DM * 2, 0, T / 256, DM / 256, (T / 256) * (DM / 256), G, bx};
        EpiOut E{x, XG, SSQ};
        pg8::gemm_phase(lds + RING_OFF, wave, DM, DM, DM, Sc, E);
    }
    SEAM(5);
    if (IN(6)) {
        pg8::SchedStd Sc{(const char*)XG, (const char*)WT_Q, (size_t)256 * DM * 2, (size_t)256 * DM * 2, 0, T / 256, DM / 256, (T / 256) * (DM / 256), G, bx};
        EpiBf16 E{QP, DM};
        pg8::gemm_phase(lds + RING_OFF, wave, DM, DM, DM, Sc, E);
    }
    SEAM(6);

    if (IN(7)) {
        const int lane = lane_now(), tid = wave * 64 + lane, r32 = lane & 31, hi = lane >> 5, h = vcu & 7;
#pragma unroll
        for (int i = 0; i < 8; ++i) { const int idx = tid + 512 * i, le = idx & 63, ks = (idx >> 6) & 7, tile = (idx >> 9) & 3, f = idx >> 11;
            const u32x4 v = *(const u32x4*)(SK + ((size_t)(h * 256 + f * 128 + 32 * tile + (le & 31)) * 128 + 16 * ks + 8 * (le >> 5)));
            *(LAS u32x4*)(lds + idx * 16) = v; }
        __syncthreads();
        LAS unsigned* scr = (LAS unsigned*)(lds + peer::SCR_OFF + wave * 8192) + lane;
        const unsigned nh4 = (unsigned)(1 - hi) << 2; const float NEGINF = -__builtin_inff();
        int* IDX = (int*)(ws + WS_IDX); float* GATE = (float*)(ws + WS_GATE);
        for (int tl = vcu >> 3; tl < T / 256; tl += G >> 3) {
            const int tok = tl * 256 + wave * 32 + r32;
            bf16x8 qf[2][8];
#pragma unroll
            for (int f = 0; f < 2; ++f)
#pragma unroll
                for (int ks = 0; ks < 8; ++ks) qf[f][ks] = *(const bf16x8*)(QP + (size_t)tok * DM + h * 256 + f * 128 + 16 * ks + 8 * hi);
            float tot = 0.f;
#pragma unroll
            for (int i = 0; i < 8; ++i) { const f32x4 v = *(const f32x4*)(SSQ + (size_t)tok * 32 + 4 * i); tot += (v[0] + v[1]) + (v[2] + v[3]); }
            const float rstd = rsqrtf(tot * (1.f / DM) + EPS);
            float KL[2][16];
#pragma unroll
            for (int f = 0; f < 2; ++f) {
                float L[16];
#pragma unroll
                for (int i = 0; i < 16; ++i) L[i] = NEGINF;
#pragma unroll
                for (int tile = 0; tile < 4; ++tile) {
                    peer::f32x16 acc = {};
#pragma unroll
                    for (int ks = 0; ks < 8; ++ks) acc = __builtin_amdgcn_mfma_f32_32x32x16_bf16(*(const LAS bf16x8*)(lds + (((f * 4 + tile) * 8 + ks) * 64 + lane) * 16), qf[f][ks], acc, 0, 0, 0);
                    float Sk[16];
#pragma unroll
                    for (int r = 0; r < 16; ++r) { const unsigned cp = (unsigned)(127 - 32 * tile - (r & 3) - 8 * (r >> 2) - 4);
                        Sk[r] = __uint_as_float(((__float_as_uint(acc[r]) & 0xffffff80u) | nh4) | cp); }
                    peer::sort16_desc(Sk);
                    if (tile == 0) {
#pragma unroll
                        for (int i = 0; i < 16; ++i) L[i] = Sk[i]; }
                    else peer::merge16(L, Sk);
                }
                peer::merge_partner(L, hi == 0);
#pragma unroll
                for (int i = 0; i < 16; ++i) KL[f][i] = L[i];
            }
            float Tt[16];
#pragma unroll
            for (int i = 0; i < 16; ++i) Tt[i] = NEGINF;
#pragma unroll
            for (int i = 0; i < 16; ++i)
#pragma unroll
                for (int j = 0; j < 16; ++j) if ((i + 1) * (j + 1) <= 16) {
                    const float sm = __uint_as_float(__float_as_uint(KL[0][i]) & 0xffffff80u) + __uint_as_float(__float_as_uint(KL[1][j]) & 0xffffff80u);
                    peer::insert16(Tt, __uint_as_float((__float_as_uint(sm) & 0xffffff00u) | (unsigned)(255 - (16 * i + j)))); }
#pragma unroll
            for (int k = 0; k < 16; ++k) { scr[k * 64] = __float_as_uint(KL[0][k]); scr[(16 + k) * 64] = __float_as_uint(KL[1][k]); }
            LDS_WAIT();
            int ex[16]; float gt[16]; float gs = 0.f;
            const float s0 = __uint_as_float(__float_as_uint(Tt[0]) & 0xffffff00u) * rstd;
#pragma unroll
            for (int r = 0; r < 16; ++r) { const unsigned tb = __float_as_uint(Tt[r]), pos = 255u - (tb & 255u), ci = pos >> 4, cj = pos & 15u;
                const unsigned a = scr[ci * 64], b = scr[(16 + cj) * 64];
                ex[r] = (int)((127u - (a & 127u)) * 128u + (127u - (b & 127u)));
                gt[r] = __expf(__uint_as_float(tb & 0xffffff00u) * rstd - s0); gs += gt[r]; }
            const float ginv = 1.f / gs;
            if (hi == 0) { int* o = IDX + (size_t)tok * 128 + h * 16;
#pragma unroll
                for (int q4 = 0; q4 < 4; ++q4) *(int4*)(o + 4 * q4) = make_int4(ex[4 * q4], ex[4 * q4 + 1], ex[4 * q4 + 2], ex[4 * q4 + 3]); }
            else { float* o = GATE + (size_t)tok * 128 + h * 16;
#pragma unroll
                for (int q4 = 0; q4 < 4; ++q4) *(f32x4*)(o + 4 * q4) = (f32x4){gt[4 * q4] * ginv, gt[4 * q4 + 1] * ginv, gt[4 * q4 + 2] * ginv, gt[4 * q4 + 3] * ginv}; }
            LDS_WAIT();
        }
    }
    SEAM(7);
    float* PA = (float*)(ws + WS_MERGED); float* HS = (float*)(ws + WS_QP);
    if (IN(8)) {
        const int lane = lane_now(), l8 = lane & 7, lg = lane >> 3, grp = bx & 7, nwv = (G >> 3) * NWAVES, wg = (bx >> 3) * NWAVES + wave;
        const int* IDX = (const int*)(ws + WS_IDX); const unsigned char* EU8 = (const unsigned char*)(ws + WS_EU);
#define P8_IDX(E, tk) do { const int* ip_ = IDX + (size_t)((tk) < T ? (tk) : T - 1) * 128 + lane; E[0] = ip_[0]; E[1] = ip_[64]; } while (0)
#define P8_ROWS(R, E, XA, XB, tk) do { _Pragma("unroll") for (int i = 0; i < 16; ++i) { const int e_ = __shfl(E[i >> 3], ((8 * i) & 63) + lg); R[i] = *(const u32x4*)(EU8 + (unsigned)(e_ * 128 + coffT)); } \
            const bf16_t* xp_ = XG + (size_t)((tk) < T ? (tk) : T - 1) * DM + coff; XA = *(const u32x4*)xp_; XB = *(const u32x4*)(xp_ + 8); } while (0)
#define P8_DPP(x, ctrl) __uint_as_float(__builtin_amdgcn_update_dpp(0u, __float_as_uint(x), ctrl, 0xf, 0xf, false))
#define P8_COMP(R, XA, XB, tk) do { f32x2 xf[8]; \
            _Pragma("unroll") for (int d = 0; d < 4; ++d) { xf[d] = (f32x2){__uint_as_float(XA[d] << 16), __uint_as_float(XA[d] & 0xffff0000u)}; xf[4 + d] = (f32x2){__uint_as_float(XB[d] << 16), __uint_as_float(XB[d] & 0xffff0000u)}; } \
            float sd[16]; \
            _Pragma("unroll") for (int i = 0; i < 16; ++i) { f32x2 a2 = {0.f, 0.f}; \
                _Pragma("unroll") for (int d = 0; d < 4; ++d) { a2 += __builtin_amdgcn_cvt_pk_f32_fp8((int)R[i][d], false) * xf[2 * d]; a2 += __builtin_amdgcn_cvt_pk_f32_fp8((int)R[i][d], true) * xf[2 * d + 1]; } \
                sd[i] = a2[0] + a2[1]; } \
              \
            float s8[8], s4[4], s2_[2]; \
            _Pragma("unroll") for (int k = 0; k < 8; ++k) { const float keep = q2 ? sd[k + 8] : sd[k], give = q2 ? sd[k] : sd[k + 8]; s8[k] = keep + P8_DPP(give, 0x141); }     \
            _Pragma("unroll") for (int k = 0; k < 4; ++k) { const float keep = q1 ? s8[k + 4] : s8[k], give = q1 ? s8[k] : s8[k + 4]; s4[k] = keep + P8_DPP(give, 0x4E); }      \
            _Pragma("unroll") for (int k = 0; k < 2; ++k) { const float keep = q0 ? s4[k + 2] : s4[k], give = q0 ? s4[k] : s4[k + 2]; s2_[k] = keep + P8_DPP(give, 0xB1); }     \
            if ((tk) < T) *(f32x2*)(PA + ((size_t)(tk) * 16 + c) * 128 + 2 * lane) = (f32x2){s2_[0], s2_[1]}; } while (0)
        const bool q2 = (lane & 4) != 0, q1 = (lane & 2) != 0, q0 = (lane & 1) != 0;
        LAS unsigned* wq = (LAS unsigned*)(lds + MISC_OFF + 128);
        if (lane == 0 && wave == 0) { wq[0] = 0u; wq[1] = 0u; }
        __syncthreads();
        const int tok0 = (bx >> 3) * NWAVES, npair = (T / nwv) * NWAVES / 2;
#define WQ_NEXT(slot) __builtin_amdgcn_readfirstlane((int)(lane == 0 ? __hip_atomic_fetch_add(wq + (slot), 1u, __ATOMIC_RELAXED, __HIP_MEMORY_SCOPE_WORKGROUP) : 0u))
#define WQ_TOK(p, k) ((p) < npair ? tok0 + ((2 * (p) + (k)) & 7) + nwv * ((2 * (p) + (k)) >> 3) : T)
        for (int c = grp, pass = 0; c < 16; c += 8, ++pass) {
            const int coff = 128 * c + 16 * l8, coffT = c * NEXP * 128 + 16 * l8;
            int eA[2], eB[2]; u32x4 rA[16], rB[16]; u32x4 xA0, xA1, xB0, xB1;
            int p = WQ_NEXT(pass); int ta = WQ_TOK(p, 0), tb = WQ_TOK(p, 1);
            P8_IDX(eA, ta); P8_ROWS(rA, eA, xA0, xA1, ta); P8_IDX(eB, tb);
#pragma unroll 1
            while (p < npair) {
                const int pn = WQ_NEXT(pass); const int na = WQ_TOK(pn, 0), nb = WQ_TOK(pn, 1);
                P8_ROWS(rB, eB, xB0, xB1, tb); P8_IDX(eA, na);
                P8_COMP(rA, xA0, xA1, ta);
                P8_ROWS(rA, eA, xA0, xA1, na); P8_IDX(eB, nb);
                P8_COMP(rB, xB0, xB1, tb);
                p = pn; ta = na; tb = nb;
            }
        }
#undef P8_IDX
#undef P8_ROWS
#undef P8_COMP
#undef P8_DPP
    }
    SEAM(8);
    if (IN(9)) {
        const int lane = lane_now();
        const int* IDX = (const int*)(ws + WS_IDX); const float* GATE = (const float*)(ws + WS_GATE); const float* ESC = (const float*)(ws + WS_EV);
        for (int t = gw; t < T; t += NGW) {
            const float pss = lane < 32 ? SSQ[(size_t)t * 32 + lane] : 0.f;
            const float rstd = rsqrtf(wave_sum(pss) * (1.f / DM) + EPS);
#pragma unroll
            for (int hh = 0; hh < 2; ++hh) { const int j = 64 * hh + lane; float a = 0.f;
#pragma unroll
                for (int c = 0; c < 16; ++c) a += PA[((size_t)t * 16 + c) * 128 + (j & 7) * 16 + (j >> 3)];
                const int e = IDX[(size_t)t * 128 + j];
                a *= ESC[e] * rstd;
                const float ge = 0.5f * a * (1.f + tanhf(0.7978845608028654f * (a + 0.044715f * a * a * a)));
                HS[(size_t)t * 128 + j] = ge * GATE[(size_t)t * 128 + j] * ESC[NEXP + e]; }
        }
    }
    SEAM(9);
    if (IN(10)) {
        const int lane = lane_now(), l8 = lane & 7, lg = lane >> 3, grp = bx & 7, nwv = (G >> 3) * NWAVES, wg = (bx >> 3) * NWAVES + wave;
        const int* IDX = (const int*)(ws + WS_IDX); const unsigned char* EV8 = (const unsigned char*)(ws + WS_EU) + (size_t)NEXP * DM;
        float* outp = args.out;
        const bool b16 = (lane & 16) != 0, b8 = (lane & 8) != 0;
#define P10_LOADE(E, tk) do { const int* ip_ = IDX + (size_t)((tk) < T ? (tk) : T - 1) * 128 + lane; E[0] = ip_[0]; E[1] = ip_[64]; } while (0)
#define P10_LOADH(H, tk) do { const float* hp_ = HS + (size_t)((tk) < T ? (tk) : T - 1) * 128 + lane; H[0] = hp_[0]; H[1] = hp_[64]; } while (0)
#define P10_ROWS(R, E, O, tk) do { _Pragma("unroll") for (int i = 0; i < 16; ++i) { const int e_ = __shfl(E[i >> 3], ((8 * i) & 63) + lg); R[i] = *(const u32x4*)(EV8 + (unsigned)(e_ * 128 + coffT)); } \
            { const unsigned w_ = *(const unsigned*)(XG + (size_t)((tk) < T ? (tk) : T - 1) * DM + coff + 2 * lg); O = (f32x2){__uint_as_float(w_ << 16), __uint_as_float(w_ & 0xffff0000u)}; } } while (0)
#define P10_COMP(R, H, O, tk) do { f32x2 acc[8]; \
            _Pragma("unroll") for (int d = 0; d < 8; ++d) acc[d] = (f32x2){0.f, 0.f}; \
            _Pragma("unroll") for (int i = 0; i < 16; ++i) { const float h_ = __shfl(H[i >> 3], ((8 * i) & 63) + lg); _Pragma("unroll") for (int d = 0; d < 4; ++d) { \
                acc[2 * d] += __builtin_amdgcn_cvt_pk_f32_fp8((int)R[i][d], false) * h_; acc[2 * d + 1] += __builtin_amdgcn_cvt_pk_f32_fp8((int)R[i][d], true) * h_; } } \
              \
            float f8[8], f4[4], f2[2]; \
            _Pragma("unroll") for (int k = 0; k < 8; ++k) { auto r_ = __builtin_amdgcn_permlane32_swap(__float_as_uint(acc[k >> 1][k & 1]), __float_as_uint(acc[(k + 8) >> 1][k & 1]), false, false); f8[k] = __uint_as_float(r_[0]) + __uint_as_float(r_[1]); } \
            _Pragma("unroll") for (int k = 0; k < 4; ++k) { const float keep = b16 ? f8[k + 4] : f8[k], give = b16 ? f8[k] : f8[k + 4]; f4[k] = keep + __shfl_xor(give, 16); } \
            _Pragma("unroll") for (int k = 0; k < 2; ++k) { const float keep = b8 ? f4[k + 2] : f4[k], give = b8 ? f4[k] : f4[k + 2]; f2[k] = keep + __shfl_xor(give, 8); } \
            if ((tk) < T) { f32x2 v_ = O; v_[0] += f2[0]; v_[1] += f2[1]; *(f32x2*)(outp + (size_t)(tk) * DM + coff + 2 * lg) = v_; } } while (0)
        LAS unsigned* wq = (LAS unsigned*)(lds + MISC_OFF + 128);
        if (lane == 0 && wave == 0) { wq[2] = 0u; wq[3] = 0u; }
        __syncthreads();
        const int tok0 = (bx >> 3) * NWAVES, npair = (T / nwv) * NWAVES / 2;
        for (int c = grp, pass = 0; c < 16; c += 8, ++pass) {
            const int coff = 128 * c + 16 * l8, coffT = c * NEXP * 128 + 16 * l8;
            int e[2]; float hA[2], hB[2]; u32x4 rA[16], rB[16]; f32x2 oA, oB;
            int p = WQ_NEXT(2 + pass); int ta = WQ_TOK(p, 0), tb = WQ_TOK(p, 1);
            P10_LOADE(e, ta); P10_ROWS(rA, e, oA, ta); P10_LOADH(hA, ta); P10_LOADE(e, tb);
#pragma unroll 1
            while (p < npair) {
                const int pn = WQ_NEXT(2 + pass); const int na = WQ_TOK(pn, 0), nb = WQ_TOK(pn, 1);
                P10_ROWS(rB, e, oB, tb); P10_LOADH(hB, tb); P10_LOADE(e, na);
                P10_COMP(rA, hA, oA, ta);
                P10_ROWS(rA, e, oA, na); P10_LOADH(hA, na); P10_LOADE(e, nb);
                P10_COMP(rB, hB, oB, tb);
                p = pn; ta = na; tb = nb;
            }
        }
#undef WQ_NEXT
#undef WQ_TOK
#undef P10_LOADE
#undef P10_LOADH
#undef P10_ROWS
#undef P10_COMP
    }
#undef IN
#undef SEAM
}

static int g_grid = 0;
static void launch_mega(const Args& a0, int lo, int hi, hipStream_t stream) {
    Args a = a0; a.ph_lo = lo; a.ph_hi = hi;
    hipLaunchKernelGGL(mega, dim3(g_grid), dim3(NTHR), LDS_BYTES, stream, a);
}

extern "C" void kernel_launch(void* const* d_in, const int* in_sizes, int n_in, void* d_out, int out_size, void* d_ws, size_t ws_size, hipStream_t stream) {
    if (n_in != 17 || out_size != T * DM || ws_size < 512 * MiB) { fprintf(stderr, "kernel_launch: unexpected shapes n_in=%d out=%d ws=%zu\n", n_in, out_size, ws_size); return; }
    if (g_grid == 0) {
        int dev = 0, cus = 0;
        if (hipGetDevice(&dev) != hipSuccess || hipDeviceGetAttribute(&cus, hipDeviceAttributeMultiprocessorCount, dev) != hipSuccess) { fprintf(stderr, "kernel_launch: device query failed\n"); g_grid = -1; return; }
        if (hipFuncSetAttribute((const void*)mega, hipFuncAttributeMaxDynamicSharedMemorySize, LDS_BYTES) != hipSuccess) { fprintf(stderr, "kernel_launch: hipFuncSetAttribute failed\n"); g_grid = -1; return; }
        if (cus < 256) { fprintf(stderr, "kernel_launch: this kernel needs 256 co-resident workgroups (one per CU); the device has %d CUs\n", cus); g_grid = -1; return; }
        g_grid = 256;
    }
    if (g_grid < 0) return;
    char* ws = (char*)d_ws; float* out = (float*)d_out;
    (void)hipMemsetAsync(ws + WS_CTL + CW_BAR * 4, 0, XCD_BAR_WORDS * 4, stream);
    Args a{}; for (int i = 0; i < 17; ++i) a.in[i] = (const float*)d_in[i]; a.out = out; a.ws = (unsigned char*)d_ws;
    launch_mega(a, 0, N_PHASES, stream);
}
```

```cpp
#include <hip/hip_runtime.h>
#include <cstdio>
#include <cstdint>

typedef unsigned short bf16_t;
constexpr int Bn = 4, S = 4096, DM = 2048, T = Bn * S, NH = 8, HD = 128, FW = 1024, PW = 1024;
constexpr int INC = 8200, NPROJ = 8192;
constexpr int PH = 8, PK = 128, PQD = 256, TOPK = 16, NEXP = 16384;
constexpr float EPS = 1e-6f;
constexpr float SCALE = 0.08838834764831845f;
constexpr float INV_SCALE = 11.313708498984761f;
constexpr size_t MiB = 1u << 20;
constexpr size_t WS_WT_PG = 1 * MiB, WS_WT_BA = 2 * MiB, WS_WT_BP = 6 * MiB, WS_WT_OUT = 10 * MiB, WS_WT_Q = 18 * MiB, WS_SK = 26 * MiB, WS_SKB = 27 * MiB,
                 WS_CS = 28 * MiB, WS_LOGF = 29 * MiB, WS_SSQ = 30 * MiB, WS_IDX = 32 * MiB, WS_GATE = 40 * MiB,
                 WS_Q = 48 * MiB, WS_K = 80 * MiB, WS_V = 112 * MiB, WS_PIN = 144 * MiB, WS_G = 176 * MiB, WS_EU = 304 * MiB, WS_EV = 368 * MiB, WS_XG = 432 * MiB,
                 WS_TMP = 48 * MiB, WS_MERGED = 112 * MiB, WS_QP = 48 * MiB, WS_RAWQ = 304 * MiB, WS_RAWK = 368 * MiB, WS_SC = 176 * MiB;
constexpr size_t DO_H1 = 0, DO_WT_IN = 64 * MiB, DO_O = 0, DO_POOLED = 32 * MiB, DO_POOL2 = 64 * MiB;

__device__ __forceinline__ float bf2f(bf16_t v) { return __uint_as_float(((unsigned)v) << 16); }
__device__ __forceinline__ bf16_t f2bf(float f) { unsigned u = __float_as_uint(f); return (bf16_t)((u + 0x7fffu + ((u >> 16) & 1u)) >> 16); }


#define LAS __attribute__((address_space(3)))
#define GAS __attribute__((address_space(1)))
typedef short bf16x8 __attribute__((ext_vector_type(8)));
typedef float f32x4 __attribute__((ext_vector_type(4)));
typedef float f32x2 __attribute__((ext_vector_type(2)));
typedef unsigned u32x4 __attribute__((ext_vector_type(4)));
typedef unsigned u32x2 __attribute__((ext_vector_type(2)));
typedef int v8i_t __attribute__((ext_vector_type(8)));
typedef int i32x4_t __attribute__((ext_vector_type(4)));
constexpr int NWAVES = 8, NTHR = 512;
constexpr int RING_OFF = 0, RING_BYTES = 131072, EPI_OFF = 131072, EPI_BYTES = 16384, MISC_OFF = EPI_OFF + EPI_BYTES, LDS_BYTES = MISC_OFF + 512;
constexpr size_t WS_CTL = 0, CTL_ZERO_BYTES = 65536;
constexpr int CW_BAR = 1024;

__device__ __forceinline__ unsigned cvt_pk_bf16(float lo, float hi) { unsigned r; asm volatile("s_nop 0\n\tv_cvt_pk_bf16_f32 %0, %1, %2" : "=v"(r) : "v"(lo), "v"(hi)); return r; }
__device__ __forceinline__ float wave_sum(float v) {
#pragma unroll
    for (int o = 1; o < 64; o <<= 1) v += __shfl_xor(v, o);
    return v;
}
__device__ __forceinline__ int lane_now() { int l; asm volatile("v_mbcnt_lo_u32_b32 %0, -1, 0\n\tv_mbcnt_hi_u32_b32 %0, -1, %0" : "=v"(l)); return l; }
#define LDS_WAIT() asm volatile("s_waitcnt lgkmcnt(0)" ::: "memory")
#define VM_WAIT() asm volatile("s_waitcnt vmcnt(0)" ::: "memory")

namespace pg8 {
constexpr int BM = 256, BK = 64, HALF = 128, HTB = HALF * BK * 2, STAGE_BYTES = 8 * HTB, NXCD = 8, WGM = 8;
__host__ __device__ __forceinline__ int lds_byte(int r, int c) { const int st = (r >> 4) * 2 + (c >> 5), rr = r & 15, cc = c & 31, ob = rr * 64 + cc * 2; return st * 1024 + (ob ^ (((ob >> 9) & 1) << 5)); }
__host__ __device__ __forceinline__ void stage_rc(int b, int& R, int& C) { const int st = b / 1024, sb = b % 1024, swz = sb ^ (((sb >> 9) & 1) << 5); R = (st >> 1) * 16 + swz / 64; C = (st & 1) * 32 + (swz % 64) / 2; }
__host__ __device__ __forceinline__ int perm32(int rho) { const int n = rho >> 4, i = rho & 15; return 8 * (i >> 2) + 4 * n + (i & 3); }
struct Unit { int pm, pn, aux; };
__device__ __forceinline__ void order_map(int L, int nM, int nN, int nwg, Unit& u) {
    int wgid = L; { const int q = nwg / NXCD, r = nwg % NXCD, xcd = wgid % NXCD, off = wgid / NXCD; wgid = (xcd < r ? xcd * (q + 1) : r * (q + 1) + (xcd - r) * q) + off; }
    const int nig = WGM * nN, gid = wgid / nig, fm = gid * WGM, gsz = (nM - fm) < WGM ? (nM - fm) : WGM;
    u.pm = fm + ((wgid % nig) % gsz); u.pn = (wgid % nig) / gsz; u.aux = 0;
}
struct SchedStd {
    const char* A; const char* Bt; size_t a_tile, b_tile, a_kstride; int nM, nN, nwg, G, c;
    __device__ __forceinline__ bool next(int i, Unit& u) const { const long L = (long)i * G + c; if (L >= nwg) return false; order_map((int)L, nM, nN, nwg, u); return true; }
    __device__ __forceinline__ const char* a_ptr(const Unit& u) const { return A + (size_t)u.pm * a_tile + (size_t)u.pn * a_kstride; }
    __device__ __forceinline__ const char* b_ptr(const Unit& u) const { return Bt + (size_t)u.pn * b_tile; }
};
struct SchedPair {
    const char* A0; const char* A1; const char* B0; const char* B1; size_t a_tile, b_tile; int nM, nN, nwg, G, c;
    __device__ __forceinline__ bool next(int i, Unit& u) const { const long L = (long)(i >> 1) * G + c; if (L >= nwg) return false; order_map((int)L, nM, nN, nwg, u); u.aux = i & 1; return true; }
    __device__ __forceinline__ const char* a_ptr(const Unit& u) const { return (u.aux ? A1 : A0) + (size_t)u.pm * a_tile; }
    __device__ __forceinline__ const char* b_ptr(const Unit& u) const { return (u.aux ? B1 : B0) + (size_t)u.pn * b_tile; }
};
typedef f32x4 Acc[2][2][4][2];

template <bool FP8 = false, class Epi, class Sched>
__device__ __forceinline__ void gemm_phase(LAS unsigned char* lds, const int wid, const int K, const int lda, const int ldb, const Sched& S, const Epi& E) {
    const int lane = lane_now(), tid = wid * 64 + lane, wr = wid >> 2, wc = wid & 3, fr = lane & 15, fq = lane >> 4;
    const int nt = K / BK;
    unsigned voffA[2], voffB[2];
#pragma unroll
    for (int i = 0; i < 2; ++i) { int R, C; stage_rc(tid * 16 + i * 8192, R, C); const int Rb = (R & ~31) + perm32(R & 31);
        voffA[i] = (unsigned)(R * lda + C) * 2u; voffB[i] = (unsigned)(Rb * ldb + C) * 2u; }
    const size_t kstep = (size_t)(BK * 2);
    const size_t hstepA = (size_t)HALF * lda * 2, hstepB = (size_t)HALF * ldb * 2;
    const unsigned ldsw = (unsigned)wid * 1024u;
    const int aoff = lds_byte(wr * 64 + fr, fq * 8), boff = lds_byte(wc * 32 + fr, fq * 8);
#define PG8_SA(b, h) (((b) * 2 + (h)) * HTB)
#define PG8_SB(b, h) ((4 + (b) * 2 + (h)) * HTB)
#define PG8_STAGE(bufoff, gbase, voff) do { _Pragma("unroll") for (int _i = 0; _i < 2; ++_i) \
        __builtin_amdgcn_global_load_lds((const unsigned*)((const char*)(gbase) + (voff)[_i]), (LAS unsigned*)(lds + (bufoff) + ldsw + _i * 8192), 16, 0, 0); } while (0)
#define PG8_LDA(dst, b, h) do { if constexpr (FP8) { _Pragma("unroll") for (int m = 0; m < 4; ++m) dst##8[m] = __builtin_shufflevector(*(const LAS i32x4_t*)(lds + PG8_SA(b, h) + aoff + m * 2048), *(const LAS i32x4_t*)(lds + PG8_SA(b, h) + aoff + m * 2048 + 1024), 0, 1, 2, 3, 4, 5, 6, 7); } \
        else { _Pragma("unroll") for (int m = 0; m < 4; ++m) _Pragma("unroll") for (int k = 0; k < 2; ++k) dst[m][k] = *(const LAS bf16x8*)(lds + PG8_SA(b, h) + aoff + m * 2048 + k * 1024); } } while (0)
#define PG8_LDB(dst, b, h) do { if constexpr (FP8) { _Pragma("unroll") for (int n = 0; n < 2; ++n) dst##8[n] = __builtin_shufflevector(*(const LAS i32x4_t*)(lds + PG8_SB(b, h) + boff + n * 2048), *(const LAS i32x4_t*)(lds + PG8_SB(b, h) + boff + n * 2048 + 1024), 0, 1, 2, 3, 4, 5, 6, 7); } \
        else { _Pragma("unroll") for (int n = 0; n < 2; ++n) _Pragma("unroll") for (int k = 0; k < 2; ++k) dst[n][k] = *(const LAS bf16x8*)(lds + PG8_SB(b, h) + boff + n * 2048 + k * 1024); } } while (0)
#define PG8_MMA(ai, bj, At, Bt) do { if constexpr (!FP8) __builtin_amdgcn_s_setprio(1);     \
        if constexpr (FP8) { _Pragma("unroll") for (int m = 0; m < 4; ++m) _Pragma("unroll") for (int n = 0; n < 2; ++n) \
            acc[ai][bj][m][n] = __builtin_amdgcn_mfma_scale_f32_16x16x128_f8f6f4(Bt##8[n], At##8[m], acc[ai][bj][m][n], 0, 0, 0, 0x7f7f7f7f, 0, 0x7f7f7f7f); } \
        else { _Pragma("unroll") for (int m = 0; m < 4; ++m) _Pragma("unroll") for (int n = 0; n < 2; ++n) _Pragma("unroll") for (int k = 0; k < 2; ++k) \
            acc[ai][bj][m][n] = __builtin_amdgcn_mfma_f32_16x16x32_bf16(Bt[n][k], At[m][k], acc[ai][bj][m][n], 0, 0, 0); } \
        __builtin_amdgcn_s_setprio(0); } while (0)
#define PG8_WAIT_V(n) asm volatile("s_waitcnt vmcnt(" #n ")" ::: "memory")
#define PG8_WAIT_L(n) asm volatile("s_waitcnt lgkmcnt(" #n ")" ::: "memory")
#define PG8_BAR __builtin_amdgcn_s_barrier()
#define PG8_SCHED __builtin_amdgcn_sched_barrier(0)
    Unit cur, nxt; int ui = 0;
    if (!S.next(0, cur)) return;
    Acc acc;
#pragma unroll
    for (int a = 0; a < 2; ++a)
#pragma unroll
        for (int b = 0; b < 2; ++b)
#pragma unroll
            for (int m = 0; m < 4; ++m)
#pragma unroll
                for (int n = 0; n < 2; ++n) acc[a][b][m][n] = (f32x4){0.f, 0.f, 0.f, 0.f};
    bf16x8 At[4][2], B0[2][2], B1[2][2]; v8i_t At8[4], B08[2], B18[2];
    const char* cA = S.a_ptr(cur); const char* cB = S.b_ptr(cur);
    PG8_STAGE(PG8_SB(0, 0), cB, voffB); PG8_STAGE(PG8_SB(0, 1), cB + hstepB, voffB); PG8_STAGE(PG8_SA(0, 0), cA, voffA); PG8_STAGE(PG8_SA(0, 1), cA + hstepA, voffA);
    if (wr == 1) PG8_BAR;
    PG8_WAIT_V(2); PG8_BAR;
    PG8_STAGE(PG8_SB(1, 0), cB + kstep, voffB); PG8_STAGE(PG8_SA(1, 0), cA + kstep, voffA); PG8_STAGE(PG8_SB(1, 1), cB + hstepB + kstep, voffB);
    PG8_WAIT_V(6); PG8_BAR;
#pragma unroll 1
    for (;;) {
        const bool has_next = S.next(ui + 1, nxt);
        const char* nA = has_next ? S.a_ptr(nxt) : cA; const char* nB = has_next ? S.b_ptr(nxt) : cB;
#pragma unroll 1
        for (int t = 0; t < nt; t += 2) {
            const bool last = (t == nt - 2);
            const char* a1 = cA + (size_t)(t + 1) * kstep;
            const char* a2 = last ? nA : cA + (size_t)(t + 2) * kstep; const char* b2 = last ? nB : cB + (size_t)(t + 2) * kstep;
            const char* a3 = a2 + kstep; const char* b3 = b2 + kstep;
            PG8_LDB(B0, 0, 0); PG8_LDB(B1, 0, 1); PG8_SCHED; PG8_LDA(At, 0, 0); PG8_STAGE(PG8_SA(1, 1), a1 + hstepA, voffA);
            PG8_WAIT_V(8); PG8_WAIT_L(0); PG8_BAR; PG8_MMA(0, 0, At, B0); PG8_MMA(0, 1, At, B1); PG8_BAR; PG8_SCHED;
            PG8_LDA(At, 0, 1); PG8_STAGE(PG8_SB(0, 0), b2, voffB); PG8_STAGE(PG8_SB(0, 1), b2 + hstepB, voffB); PG8_STAGE(PG8_SA(0, 0), a2, voffA);
            PG8_WAIT_V(8); PG8_WAIT_L(0); PG8_BAR; PG8_MMA(1, 0, At, B0); PG8_MMA(1, 1, At, B1); PG8_BAR; PG8_SCHED;
            PG8_LDB(B0, 1, 0); PG8_LDB(B1, 1, 1); PG8_SCHED; PG8_LDA(At, 1, 0); PG8_STAGE(PG8_SA(0, 1), a2 + hstepA, voffA);
            PG8_WAIT_V(8); PG8_WAIT_L(0); PG8_BAR; PG8_MMA(0, 0, At, B0); PG8_MMA(0, 1, At, B1); PG8_BAR; PG8_SCHED;
            PG8_LDA(At, 1, 1); PG8_STAGE(PG8_SB(1, 0), b3, voffB); PG8_STAGE(PG8_SB(1, 1), b3 + hstepB, voffB); PG8_STAGE(PG8_SA(1, 0), a3, voffA);
            PG8_WAIT_V(8); PG8_WAIT_L(0); PG8_BAR; PG8_MMA(1, 0, At, B0); PG8_MMA(1, 1, At, B1); PG8_BAR; PG8_SCHED;
        }
        if (wr == 0) PG8_BAR;
        E(acc, cur, ui, wid);
        if (!has_next) break;
#pragma unroll
        for (int a = 0; a < 2; ++a)
#pragma unroll
            for (int b = 0; b < 2; ++b)
#pragma unroll
                for (int m = 0; m < 4; ++m)
#pragma unroll
                    for (int n = 0; n < 2; ++n) acc[a][b][m][n] = (f32x4){0.f, 0.f, 0.f, 0.f};
        cur = nxt; cA = nA; cB = nB; ++ui;
        if (wr == 1) PG8_BAR;
    }
    PG8_WAIT_V(0);
    PG8_BAR;
#undef PG8_SA
#undef PG8_SB
#undef PG8_STAGE
#undef PG8_LDA
#undef PG8_LDB
#undef PG8_MMA
#undef PG8_WAIT_V
#undef PG8_WAIT_L
#undef PG8_BAR
#undef PG8_SCHED
}
}

using pg8::Acc; using pg8::Unit;
__device__ __forceinline__ u32x4 pack8(const f32x4 a, const f32x4 b) { u32x4 w; w.x = cvt_pk_bf16(a[0], a[1]); w.y = cvt_pk_bf16(a[2], a[3]); w.z = cvt_pk_bf16(b[0], b[1]); w.w = cvt_pk_bf16(b[2], b[3]); return w; }
__device__ __forceinline__ void unpack8(const u32x4 w, f32x4& a, f32x4& b) {
    a[0] = __uint_as_float(w.x << 16); a[1] = __uint_as_float(w.x & 0xffff0000u); a[2] = __uint_as_float(w.y << 16); a[3] = __uint_as_float(w.y & 0xffff0000u);
    b[0] = __uint_as_float(w.z << 16); b[1] = __uint_as_float(w.z & 0xffff0000u); b[2] = __uint_as_float(w.w << 16); b[3] = __uint_as_float(w.w & 0xffff0000u);
}
__device__ __forceinline__ float sigmoidf_fast(float v) { return __builtin_amdgcn_rcpf(1.f + __builtin_amdgcn_exp2f(-1.4426950408889634f * v)); }

struct EpiProj {
    bf16_t* Q; bf16_t* Kt; bf16_t* V; bf16_t* PIN; bf16_t* G; const float* gq; const float* gk; LAS float* P; float inv;
    __device__ __forceinline__ void operator()(const Acc& acc, const Unit& u, int ui, int wid) const {
        const int lane = lane_now(), wr = wid >> 2, wc = wid & 3, fr = lane & 15, fq = lane >> 4;
        const int pn = u.pn, c8 = wc * 32 + fq * 8;
        if (pn < 8) {
            LAS float* Pb = P + (ui & 1) * 2048;
#pragma unroll
            for (int ai = 0; ai < 2; ++ai)
#pragma unroll
                for (int m = 0; m < 4; ++m)
#pragma unroll
                    for (int bj = 0; bj < 2; ++bj) { const f32x4 a = acc[ai][bj][m][0] * inv, b = acc[ai][bj][m][1] * inv;
                        float s = (a[0] * a[0] + a[1] * a[1]) + (a[2] * a[2] + a[3] * a[3]) + (b[0] * b[0] + b[1] * b[1]) + (b[2] * b[2] + b[3] * b[3]);
                        s += __shfl_xor(s, 16); s += __shfl_xor(s, 32);
                        if (fq == 0) Pb[((ai * 128 + wr * 64 + m * 16 + fr) * 2 + bj) * 4 + wc] = s; }
            LDS_WAIT(); __builtin_amdgcn_s_barrier(); asm volatile("" ::: "memory");
            const float* g = (pn < 4) ? gq : gk; bf16_t* dst = (pn < 4) ? Q : Kt; const int h0 = (pn & 3) * 2;
            const f32x4 g0 = *(const f32x4*)(g + c8), g1 = *(const f32x4*)(g + c8 + 4);
#pragma unroll
            for (int ai = 0; ai < 2; ++ai)
#pragma unroll
                for (int m = 0; m < 4; ++m) { const int rl = ai * 128 + wr * 64 + m * 16 + fr, row = u.pm * 256 + rl, bb = row >> 12, s = row & 4095;
#pragma unroll
                    for (int bj = 0; bj < 2; ++bj) { const f32x4 p = *(const LAS f32x4*)(Pb + (rl * 2 + bj) * 4);
                        const float rstd = rsqrtf(((p[0] + p[1]) + (p[2] + p[3])) * (1.f / 128.f) + EPS);
                        const f32x4 a = acc[ai][bj][m][0] * inv * rstd * g0, b = acc[ai][bj][m][1] * inv * rstd * g1;
                        *(u32x4*)(dst + (((size_t)bb * NH + h0 + bj) * S + s) * HD + c8) = pack8(a, b); } }
        } else if (pn < 12) {
            const int h0 = (pn - 8) * 2;
#pragma unroll
            for (int ai = 0; ai < 2; ++ai)
#pragma unroll
                for (int m = 0; m < 4; ++m) { const int row = u.pm * 256 + ai * 128 + wr * 64 + m * 16 + fr, bb = row >> 12, s = row & 4095;
#pragma unroll
                    for (int bj = 0; bj < 2; ++bj) *(u32x4*)(V + (((size_t)bb * NH + h0 + bj) * S + s) * HD + c8) = pack8(acc[ai][bj][m][0] * inv, acc[ai][bj][m][1] * inv); }
        } else if (pn < 16) {
#pragma unroll
            for (int ai = 0; ai < 2; ++ai)
#pragma unroll
                for (int m = 0; m < 4; ++m) { const int row = u.pm * 256 + ai * 128 + wr * 64 + m * 16 + fr;
#pragma unroll
                    for (int bj = 0; bj < 2; ++bj) *(u32x4*)(PIN + (size_t)row * PW + (pn - 12) * 256 + bj * 128 + c8) = pack8(acc[ai][bj][m][0] * inv, acc[ai][bj][m][1] * inv); }
        } else {
#pragma unroll
            for (int ai = 0; ai < 2; ++ai)
#pragma unroll
                for (int m = 0; m < 4; ++m) { const int row = u.pm * 256 + ai * 128 + wr * 64 + m * 16 + fr;
#pragma unroll
                    for (int bj = 0; bj < 2; ++bj) { f32x4 a = acc[ai][bj][m][0] * inv, b = acc[ai][bj][m][1] * inv;
#pragma unroll
                        for (int e = 0; e < 4; ++e) { a[e] = sigmoidf_fast(a[e]); b[e] = sigmoidf_fast(b[e]); }
                        *(u32x4*)(G + (size_t)row * 4096 + (pn - 16) * 256 + bj * 128 + c8) = pack8(a, b); } }
        }
    }
};
struct EpiGate {
    bf16_t* G; float inv;
    __device__ __forceinline__ void operator()(const Acc& acc, const Unit& u, int ui, int wid) const {
        const int lane = lane_now(), wr = wid >> 2, wc = wid & 3, fr = lane & 15, fq = lane >> 4;
        const int c8 = wc * 32 + fq * 8;
#pragma unroll
        for (int ai = 0; ai < 2; ++ai)
#pragma unroll
            for (int m = 0; m < 4; ++m) { const int row = u.pm * 256 + ai * 128 + wr * 64 + m * 16 + fr;
#pragma unroll
                for (int bj = 0; bj < 2; ++bj) { f32x4 a = acc[ai][bj][m][0] * inv, b = acc[ai][bj][m][1] * inv;
#pragma unroll
                    for (int e = 0; e < 4; ++e) { a[e] = sigmoidf_fast(a[e]); b[e] = sigmoidf_fast(b[e]); }
                    *(u32x4*)(G + (size_t)row * 4096 + u.pn * 256 + bj * 128 + c8) = pack8(a, b); } }
    }
};
struct EpiPool2 {
    bf16_t* O; const float* scale;
    __device__ __forceinline__ void operator()(const Acc& acc, const Unit& u, int ui, int wid) const {
        const int lane = lane_now(), wr = wid >> 2, wc = wid & 3, fr = lane & 15, fq = lane >> 4;
        const int c8 = wc * 32 + fq * 8;
#pragma unroll
        for (int bj = 0; bj < 2; ++bj) { const int col = u.pn * 256 + bj * 128 + c8; const f32x4 s0 = *(const f32x4*)(scale + col), s1 = *(const f32x4*)(scale + col + 4);
#pragma unroll
            for (int ai = 0; ai < 2; ++ai)
#pragma unroll
                for (int m = 0; m < 4; ++m) { const int row = u.pm * 256 + ai * 128 + wr * 64 + m * 16 + fr;
                    *(u32x4*)(O + (size_t)row * PW + col) = pack8(acc[ai][bj][m][0] * s0, acc[ai][bj][m][1] * s1); } }
    }
};
struct EpiBranch {
    bf16_t* TMP; bf16_t* MERGED; const bf16_t* G;
    __device__ __forceinline__ void operator()(const Acc& acc, const Unit& u, int ui, int wid) const {
        const int lane = lane_now(), wr = wid >> 2, wc = wid & 3, fr = lane & 15, fq = lane >> 4;
        const int c8 = wc * 32 + fq * 8;
#pragma unroll
        for (int ai = 0; ai < 2; ++ai)
#pragma unroll
            for (int m = 0; m < 4; ++m) { const int row = u.pm * 256 + ai * 128 + wr * 64 + m * 16 + fr;
#pragma unroll
                for (int bj = 0; bj < 2; ++bj) { const int col = u.pn * 256 + bj * 128 + c8;
                    f32x4 ga, gb; unpack8(*(const u32x4*)(G + (size_t)row * 4096 + u.aux * 2048 + col), ga, gb);
                    f32x4 a = acc[ai][bj][m][0] * ga, b = acc[ai][bj][m][1] * gb;
                    if (u.aux == 0) { *(u32x4*)(TMP + (size_t)row * DM + col) = pack8(a, b); }
                    else { f32x4 ta, tb; unpack8(*(const u32x4*)(TMP + (size_t)row * DM + col), ta, tb); *(u32x4*)(MERGED + (size_t)row * DM + col) = pack8(a + ta, b + tb); } } }
    }
};
struct EpiOut {
    const float* x; bf16_t* XG; float* SSQ;
    __device__ __forceinline__ void operator()(const Acc& acc, const Unit& u, int ui, int wid) const {
        const int lane = lane_now(), wr = wid >> 2, wc = wid & 3, fr = lane & 15, fq = lane >> 4;
        const int c8 = wc * 32 + fq * 8;
#pragma unroll
        for (int ai = 0; ai < 2; ++ai)
#pragma unroll
            for (int m = 0; m < 4; ++m) { const int row = u.pm * 256 + ai * 128 + wr * 64 + m * 16 + fr; float ss = 0.f;
#pragma unroll
                for (int bj = 0; bj < 2; ++bj) { const size_t off = (size_t)row * DM + u.pn * 256 + bj * 128 + c8;
                    const f32x4 a = acc[ai][bj][m][0] + *(const f32x4*)(x + off), b = acc[ai][bj][m][1] + *(const f32x4*)(x + off + 4);
                    ss += (a[0] * a[0] + a[1] * a[1]) + (a[2] * a[2] + a[3] * a[3]) + (b[0] * b[0] + b[1] * b[1]) + (b[2] * b[2] + b[3] * b[3]);
                    *(u32x4*)(XG + off) = pack8(a, b); }
                ss += __shfl_xor(ss, 16); ss += __shfl_xor(ss, 32);
                if (fq == 0) SSQ[(size_t)row * 32 + u.pn * 4 + wc] = ss; }
    }
};
struct EpiBf16 {
    bf16_t* O; int ldc;
    __device__ __forceinline__ void operator()(const Acc& acc, const Unit& u, int ui, int wid) const {
        const int lane = lane_now(), wr = wid >> 2, wc = wid & 3, fr = lane & 15, fq = lane >> 4;
        const int c8 = wc * 32 + fq * 8;
#pragma unroll
        for (int ai = 0; ai < 2; ++ai)
#pragma unroll
            for (int m = 0; m < 4; ++m) { const int row = u.pm * 256 + ai * 128 + wr * 64 + m * 16 + fr;
#pragma unroll
                for (int bj = 0; bj < 2; ++bj) *(u32x4*)(O + (size_t)row * ldc + u.pn * 256 + bj * 128 + c8) = pack8(acc[ai][bj][m][0], acc[ai][bj][m][1]); }
    }
};

#define XB_TMO      128
#define XB_XCNT(j)  (256  + 64 * (j))
#define XB_XSUB(j)  (1280 + 64 * (j))
#define XB_XGEN(j)  (2304 + 64 * (j))
#define XB_TOP      3328
#define XB_TOPGEN   3392
#define XCD_BAR_WORDS 3456
#define XB_SPIN_CAP (1u << 18)
__device__ __forceinline__ unsigned xb_ld(unsigned* p)              { return __hip_atomic_load(p, __ATOMIC_RELAXED, __HIP_MEMORY_SCOPE_AGENT); }
__device__ __forceinline__ unsigned xb_add(unsigned* p, unsigned v) { return __hip_atomic_fetch_add(p, v, __ATOMIC_RELAXED, __HIP_MEMORY_SCOPE_AGENT); }
__device__ __forceinline__ unsigned xb_xcc_id() { return (unsigned)__builtin_amdgcn_s_getreg((3 << 11) | 20) & 0xFu; }
#define XB_SPIN(cond, bar) do { unsigned _sp = 0; while (cond) { __builtin_amdgcn_s_sleep(1); \
    if ((++_sp & 255u) == 0u) { if (xb_ld(&(bar)[XB_TMO])) break; if (_sp > XB_SPIN_CAP) { atomicAdd(&(bar)[XB_TMO], 1u); break; } } } } while (0)
struct XcdBarrier { unsigned* bar; unsigned x; volatile LAS unsigned* st; };
__device__ __forceinline__ XcdBarrier xcd_barrier_post(unsigned* bar, volatile LAS unsigned* st) {
    XcdBarrier b; b.bar = bar; b.x = xb_xcc_id(); b.st = st;
    if (threadIdx.x == 0) (void)xb_add(&bar[XB_XCNT(b.x)], 1u);
    return b;
}
__device__ __forceinline__ void xcd_barrier_complete(unsigned* bar, unsigned x, unsigned& nloc, unsigned& nx) {
    const unsigned G = gridDim.x * gridDim.y * gridDim.z;
    unsigned sum, cnt, mine, sp = 0u;
    for (;;) {
        sum = 0u; cnt = 0u; mine = 0u;
#pragma unroll
        for (unsigned j = 0; j < 16; ++j) { const unsigned c = xb_ld(&bar[XB_XCNT(j)]); sum += c; cnt += (c > 0u) ? 1u : 0u; mine = (j == x) ? c : mine; }
        if (sum == G) break;
        __builtin_amdgcn_s_sleep(1);
        if ((++sp & 255u) == 0u) { if (xb_ld(&bar[XB_TMO])) break; if (sp > XB_SPIN_CAP) { atomicAdd(&bar[XB_TMO], 1u); break; } }
    }
    nloc = mine > 0u ? mine : 1u; nx = cnt > 0u ? cnt : 1u;
}
__device__ __forceinline__ void xcd_barrier(const XcdBarrier& b) {
    asm volatile("s_waitcnt vmcnt(0)" ::: "memory");
    __syncthreads();
    if (threadIdx.x == 0) {
        unsigned* bar = b.bar;
        __builtin_amdgcn_s_waitcnt(0);
        unsigned nloc = b.st[0], nx = b.st[1];
        if (nloc == 0u) { xcd_barrier_complete(bar, b.x, nloc, nx); b.st[0] = nloc; b.st[1] = nx; }
        const unsigned old = xb_add(&bar[XB_XSUB(b.x)], 1u);
        const unsigned gen = old / nloc;
        if (old + 1u == (gen + 1u) * nloc) {
            __builtin_amdgcn_fence(__ATOMIC_RELEASE, "agent");
            asm volatile("s_waitcnt vmcnt(0)" ::: "memory");
            const unsigned og = xb_add(&bar[XB_TOP], 1u);
            const unsigned tg = og / nx;
            if (og + 1u == (tg + 1u) * nx) xb_add(&bar[XB_TOPGEN], 1u);
            else XB_SPIN(xb_ld(&bar[XB_TOPGEN]) == tg, bar);
            __builtin_amdgcn_fence(__ATOMIC_ACQUIRE, "agent");
            xb_add(&bar[XB_XGEN(b.x)], 1u);
            asm volatile("s_waitcnt vmcnt(0)" ::: "memory");
        } else {
            XB_SPIN(xb_ld(&bar[XB_XGEN(b.x)]) == gen, bar);
            __builtin_amdgcn_fence(__ATOMIC_ACQUIRE, "agent");
            asm volatile("s_waitcnt vmcnt(0)" ::: "memory");
        }
    }
    __syncthreads();
}

__device__ __forceinline__ unsigned pk2(float lo, float hi) { return (unsigned)f2bf(lo) | ((unsigned)f2bf(hi) << 16); }
__device__ __forceinline__ void p0_transpose_item(const float* W, int K, int N, bf16_t* WT, int row0, int src_col0, int k0, LAS float* scr, int lane, const float* kscale = nullptr) {
#pragma unroll 8
    for (int i = 0; i < 32; ++i) { const int kk = 2 * i + (lane >> 5); scr[kk * 33 + (lane & 31)] = W[(size_t)(k0 + kk) * N + src_col0 + (lane & 31)] * (kscale ? kscale[k0 + kk] : 1.f); }
    LDS_WAIT(); asm volatile("" ::: "memory");
    const int c = lane & 7;
#pragma unroll
    for (int j = 0; j < 4; ++j) { const int n = (lane >> 3) + 8 * j; const LAS float* s = scr + (8 * c) * 33 + n;
        u32x4 o; o.x = pk2(s[0 * 33], s[1 * 33]); o.y = pk2(s[2 * 33], s[3 * 33]); o.z = pk2(s[4 * 33], s[5 * 33]); o.w = pk2(s[6 * 33], s[7 * 33]);
        *(u32x4*)(WT + (size_t)(row0 + n) * K + k0 + 8 * c) = o; }
    LDS_WAIT(); asm volatile("" ::: "memory");
}


namespace att {
typedef short s16x4 __attribute__((ext_vector_type(4)));
typedef float f32x16 __attribute__((ext_vector_type(16)));
constexpr int D = 128, NW = 8, QBLK = 32, KVBLK = 64, QB = NW * QBLK;
constexpr int SHM_V = KVBLK * D * 2, SHM_K = KVBLK * D * 2;
constexpr int LDS_WS = 2 * SHM_V + 2 * SHM_K, LDS_CB = LDS_WS + NW * 64 * 4, LDS_ATT_BYTES = LDS_CB + 2 * 64 * 4;
constexpr float THR = 8.f;
constexpr int OSTR = FW;
#define KSWZ(row, colB) ((row) * 256 + ((colB) ^ (((row) & 7) << 4)))
#define SBAR() __builtin_amdgcn_sched_barrier(0)
__device__ __forceinline__ int v_st(int k, int c) { const int kk = (k & ~0xC) | ((k & 4) << 1) | ((k & 8) >> 1); return ((kk >> 3) * 4 + (c >> 5)) * 512 + ((kk & 7) * 32 + (c & 31)) * 2; }
__device__ __forceinline__ int v_rd_base(int lane) { return ((lane & 3) << 3) | (((lane >> 2) & 3) << 6) | (((lane >> 4) & 1) << 5) | (((lane >> 5) & 1) << 8); }
constexpr int v_rd_off(int d0, int ks, int half) { return d0 * 512 + ks * 4096 + half * 2048; }
__device__ __forceinline__ int crow(int r, int hi) { return (r & 3) + 8 * (r >> 2) + 4 * hi; }
__device__ __forceinline__ unsigned cvtpk(float lo, float hi) { unsigned r; asm volatile("s_nop 0\n\tv_cvt_pk_bf16_f32 %0, %1, %2" : "=v"(r) : "v"(lo), "v"(hi)); return r; }
__device__ __forceinline__ bf16x8 load8(const bf16_t* p) { return *reinterpret_cast<const bf16x8*>(p); }
__device__ __forceinline__ void mask_tile(f32x16& p0, f32x16& p1, int dq) {
    const float NEG = -__builtin_inff();
#pragma unroll
    for (int r = 0; r < 16; ++r) { const int c = (r & 3) + 8 * (r >> 2);
        if (dq - c < 0) p0[r] = NEG;
        if (dq - c - 32 < 0) p1[r] = NEG; }
}
__device__ __forceinline__ void partialSM(f32x16& p0, f32x16& p1, float& m_reg, float& mn, float& alpha) {
    float pmax = p0[0];
#pragma unroll
    for (int r = 1; r < 16; ++r) pmax = fmaxf(pmax, p0[r]);
#pragma unroll
    for (int r = 0; r < 16; ++r) pmax = fmaxf(pmax, p1[r]);
    { auto rr = __builtin_amdgcn_permlane32_swap(__float_as_uint(pmax), __float_as_uint(pmax), false, false);
      pmax = fmaxf(__uint_as_float(rr[0]), __uint_as_float(rr[1])); }
    constexpr float C2 = 1.4426950408889634f * SCALE;
    if (__builtin_expect(__all((pmax - m_reg) * SCALE <= THR), 1)) { mn = m_reg; alpha = 1.f; }
    else { mn = fmaxf(m_reg, pmax); alpha = __builtin_amdgcn_exp2f((m_reg - mn) * C2); m_reg = mn; }
    const float mnL = -mn * C2;
#pragma unroll
    for (int r = 0; r < 16; ++r) p0[r] = fmaf(p0[r], C2, mnL);
#pragma unroll
    for (int r = 0; r < 16; ++r) p1[r] = fmaf(p1[r], C2, mnL);
#pragma unroll
    for (int r = 0; r < 16; ++r) p0[r] = __builtin_amdgcn_exp2f(p0[r]);
}
__device__ __forceinline__ void finishSM(f32x16& p0, f32x16& p1, float alpha, float& l_reg, bf16x8& pa0, bf16x8& pa1, bf16x8& pa2, bf16x8& pa3) {
#pragma unroll
    for (int r = 0; r < 16; ++r) p1[r] = __builtin_amdgcn_exp2f(p1[r]);
    float ps = 0;
#pragma unroll
    for (int r = 0; r < 16; ++r) ps += p0[r];
#pragma unroll
    for (int r = 0; r < 16; ++r) ps += p1[r];
    { auto rr = __builtin_amdgcn_permlane32_swap(__float_as_uint(ps), __float_as_uint(ps), false, false);
      ps = __uint_as_float(rr[0]) + __uint_as_float(rr[1]); }
    l_reg = l_reg * alpha + ps;
#define PK4(P, B_, OUT) do { unsigned a0 = cvtpk(P[B_+0], P[B_+1]), a1 = cvtpk(P[B_+2], P[B_+3]);                          \
        unsigned b0 = cvtpk(P[B_+4], P[B_+5]), b1 = cvtpk(P[B_+6], P[B_+7]);                                             \
        auto r0 = __builtin_amdgcn_permlane32_swap(a0, b0, false, false); auto r1 = __builtin_amdgcn_permlane32_swap(a1, b1, false, false); \
        u32x4 w = {r0[0], r1[0], r0[1], r1[1]}; OUT = *reinterpret_cast<bf16x8*>(&w); } while (0)
    PK4(p0, 0, pa0); PK4(p0, 8, pa1); PK4(p1, 0, pa2); PK4(p1, 8, pa3);
#undef PK4
}
template <int KB>
__device__ __forceinline__ void qkt(f32x16& p0, f32x16& p1, const char* K_lds, const float* CB, int r32, int hi, const bf16x8* qr, float cq) {
    const float* cb = CB + KB * 64 + 4 * hi;
#pragma unroll
    for (int g = 0; g < 4; ++g) { const f32x4 c0 = *(const f32x4*)(cb + 8 * g), c1 = *(const f32x4*)(cb + 32 + 8 * g);
#pragma unroll
        for (int e = 0; e < 4; ++e) { p0[4 * g + e] = cq - c0[e]; p1[4 * g + e] = cq - c1[e]; } }
    const char* kb[4];
#pragma unroll
    for (int dd = 0; dd < 4; ++dd) kb[dd] = K_lds + KB * SHM_K + KSWZ(r32, (dd * 16 + hi * 8) * 2);
#pragma unroll
    for (int d0 = 0; d0 < 8; ++d0) { const char* a = kb[d0 & 3] + (d0 >> 2) * 128;
        bf16x8 b0 = *reinterpret_cast<const bf16x8*>(a);
        bf16x8 b1 = *reinterpret_cast<const bf16x8*>(a + 32 * 256);
        p0 = __builtin_amdgcn_mfma_f32_32x32x16_bf16(b0, qr[d0], p0, 0, 0, 0);
        p1 = __builtin_amdgcn_mfma_f32_32x32x16_bf16(b1, qr[d0], p1, 0, 0, 0); }
}
template <int VB>
__device__ __forceinline__ void pv_tile(f32x16* o, int vb0, bf16x8 pa0, bf16x8 pa1, bf16x8 pa2, bf16x8 pa3) {
#define TRRD(dst, off) asm volatile("ds_read_b64_tr_b16 %0, %1 offset:%2" : "=&v"(dst) : "v"(vb0), "i"(off) : "memory")
#define PV_D0(d0) do { s16x4 l0, l1, l2, l3, h0, h1, h2, h3; constexpr int b_ = VB * SHM_V + v_rd_off(d0, 0, 0); \
        TRRD(l0, b_); TRRD(h0, b_ + 2048); TRRD(l1, b_ + 4096); TRRD(h1, b_ + 6144); TRRD(l2, b_ + 8192); TRRD(h2, b_ + 10240); TRRD(l3, b_ + 12288); TRRD(h3, b_ + 14336); \
        asm volatile("s_waitcnt lgkmcnt(0)" ::: "memory"); SBAR();   \
        o[d0] = __builtin_amdgcn_mfma_f32_32x32x16_bf16(pa0, (bf16x8){l0[0], l0[1], l0[2], l0[3], h0[0], h0[1], h0[2], h0[3]}, o[d0], 0, 0, 0);   \
        o[d0] = __builtin_amdgcn_mfma_f32_32x32x16_bf16(pa1, (bf16x8){l1[0], l1[1], l1[2], l1[3], h1[0], h1[1], h1[2], h1[3]}, o[d0], 0, 0, 0);   \
        o[d0] = __builtin_amdgcn_mfma_f32_32x32x16_bf16(pa2, (bf16x8){l2[0], l2[1], l2[2], l2[3], h2[0], h2[1], h2[2], h2[3]}, o[d0], 0, 0, 0);   \
        o[d0] = __builtin_amdgcn_mfma_f32_32x32x16_bf16(pa3, (bf16x8){l3[0], l3[1], l3[2], l3[3], h3[0], h3[1], h3[2], h3[3]}, o[d0], 0, 0, 0); } while (0)
    PV_D0(0); PV_D0(1); PV_D0(2); PV_D0(3);
#undef PV_D0
#undef TRRD
}
struct BlockRef { const bf16_t* Q; const bf16_t* K; const bf16_t* V; const float* C; bf16_t* O; int P0; int jlo; };
struct Seam { bf16x8 qr[8]; bf16x8 st_v0, st_v1, st_k0, st_k1; float st_c; float cq; };
#define ROW(p, k0, rr) ((p) + (size_t)((k0) + (rr)) * D + sc)
#define VMW() asm volatile("s_waitcnt vmcnt(0)" ::: "memory")
#define VMWN(n) asm volatile("s_waitcnt vmcnt(%0)" :: "i"(n) : "memory")
#define SLOAD_H(Kp, Vp, Cp, k0) do { S.st_v0 = load8(ROW(Vp, k0, sr)); S.st_v1 = load8(ROW(Vp, k0, 32 + sr));              \
                         S.st_k0 = load8(ROW(Kp, k0, sr)); S.st_k1 = load8(ROW(Kp, k0, 32 + sr)); S.st_c = (Cp)[(k0) + (tid & 63)]; } while (0)
#define SWRITE_HK(bf) do { *(bf16x8*)(K_lds + (bf) * SHM_K + kws) = S.st_k0; *(bf16x8*)(K_lds + (bf) * SHM_K + kws + 32 * 256) = S.st_k1; if (wid == 0) CB[(bf) * 64 + lane] = S.st_c; } while (0)
#define SWRITE_HV(bf) do { *(bf16x8*)(V_lds + (bf) * SHM_V + vst0) = S.st_v0; *(bf16x8*)(V_lds + (bf) * SHM_V + vst1) = S.st_v1; } while (0)
#define SWRITE_H(bf) do { SWRITE_HV(bf); SWRITE_HK(bf); } while (0)
__device__ __forceinline__ void attn_prime(const BlockRef& cur, char* lds, Seam& S, int wid) {
    const int lane = lane_now(), tid = wid * 64 + lane, r32 = lane & 31, hi = lane >> 5;
    const int sr = tid >> 4, sc = (tid & 15) * 8, kws = KSWZ(sr, sc * 2); char* K_lds = lds + 2 * SHM_V; float* CB = (float*)(lds + LDS_CB);
#pragma unroll
    for (int d0 = 0; d0 < 8; ++d0) S.qr[d0] = load8(cur.Q + (size_t)(wid * QBLK + r32) * D + d0 * 16 + hi * 8);
    S.cq = cur.C[cur.P0 + wid * QBLK + r32];
    SLOAD_H(cur.K, cur.V, cur.C, cur.jlo * KVBLK); VMW(); SWRITE_HK(0);
    __syncthreads();
}
__device__ __forceinline__ void attn_block(const BlockRef& cur, const BlockRef& nxt, char* lds, Seam& S, int wid) {
    const int lane = lane_now(), tid = wid * 64 + lane, r32 = lane & 31, hi = lane >> 5;
    const int NT = (cur.P0 + QB) / KVBLK - cur.jlo;
    const int qlo = cur.P0 + wid * QBLK, qm = qlo + r32 - 4 * hi;
    char* V_lds = lds; char* K_lds = lds + 2 * SHM_V; float* CB = (float*)(lds + LDS_CB);
    float* ws = (float*)(lds + LDS_WS) + wid * 64; float* li_l = ws, * al_l = ws + 32;
    float m_reg = -1e30f, l_reg = 0; f32x16 o[4] = {};
    const int sr = tid >> 4, sc = (tid & 15) * 8, vst0 = v_st(sr, sc), vst1 = v_st(32 + sr, sc), kws = KSWZ(sr, sc * 2);
    const int vb0 = (int)(uintptr_t)V_lds + v_rd_base(lane);
    const bf16_t* Kh = cur.K; const bf16_t* Vh = cur.V; const float* Ch = cur.C; const float cq = S.cq;
#define RESC(a) do { if (__any((a) < 1.f)) { if (hi == 0) al_l[r32] = (a); asm volatile("s_waitcnt lgkmcnt(0)" ::: "memory");              \
                     for (int d_ = 0; d_ < 4; ++d_) for (int r = 0; r < 16; ++r) o[d_][r] *= al_l[crow(r, hi)]; } } while (0)
#define KBASE(t) ((cur.jlo + (t)) * KVBLK)
#define MASKT(P0_, P1_, t) do { const int kb_ = KBASE(t); if (kb_ + KVBLK - 1 > qlo) mask_tile(P0_, P1_, qm - kb_); } while (0)
    constexpr int NQL = 9;
#define SEAM_K0() do { VMWN(NQL); SWRITE_HK(0); SBAR(); } while (0)
    f32x16 pA0, pA1, pB0, pB1; float mnA, mnB, alA, alB; bf16x8 pa0, pa1, pa2, pa3;
    SWRITE_HV(0); SBAR();
    if (NT > 1) { SLOAD_H(Kh, Vh, Ch, KBASE(1)); }
    SBAR(); qkt<0>(pA0, pA1, K_lds, CB, r32, hi, S.qr, cq);
    MASKT(pA0, pA1, 0); partialSM(pA0, pA1, m_reg, mnA, alA);
    if (NT > 1) { VMW(); SWRITE_H(1); }
    __syncthreads();
#define HALF_STEP(PX0, PX1, mnX, alX, PY0, PY1, alY, t, KB, VB, SB) do {                                                      \
        SBAR(); qkt<KB>(PX0, PX1, K_lds, CB, r32, hi, S.qr, cq);                                             \
        finishSM(PY0, PY1, alY, l_reg, pa0, pa1, pa2, pa3); SBAR();                                                           \
        if ((t) + 1 < NT) { SLOAD_H(Kh, Vh, Ch, KBASE((t) + 1)); SBAR(); }                                               \
        pv_tile<VB>(o, vb0, pa0, pa1, pa2, pa3); MASKT(PX0, PX1, (t)); partialSM(PX0, PX1, m_reg, mnX, alX);                                        \
        __syncthreads();                                                                                                      \
        if ((t) + 1 < NT) { VMW(); SWRITE_H(SB); }                                                                          \
        RESC(alX); __syncthreads(); } while (0)
    for (int t = 1; t + 1 < NT; t += 2) {
        HALF_STEP(pB0, pB1, mnB, alB, pA0, pA1, alA, t, 1, 0, 0);
        HALF_STEP(pA0, pA1, mnA, alA, pB0, pB1, alB, t + 1, 0, 1, 1);
    }
    const bool even = (NT & 1) == 0;
    if (even) { SBAR(); qkt<1>(pB0, pB1, K_lds, CB, r32, hi, S.qr, cq); SBAR(); }
    { SLOAD_H(nxt.K, nxt.V, nxt.C, nxt.jlo * KVBLK); SBAR();
#pragma unroll
      for (int d0 = 0; d0 < 8; ++d0) S.qr[d0] = load8(nxt.Q + (size_t)(wid * QBLK + r32) * D + d0 * 16 + hi * 8);
      S.cq = nxt.C[nxt.P0 + wid * QBLK + r32]; }
    SBAR();
    finishSM(pA0, pA1, alA, l_reg, pa0, pa1, pa2, pa3); SBAR();
    pv_tile<0>(o, vb0, pa0, pa1, pa2, pa3);
    if (even) { MASKT(pB0, pB1, NT - 1); partialSM(pB0, pB1, m_reg, mnB, alB); __syncthreads(); RESC(alB);
        finishSM(pB0, pB1, alB, l_reg, pa0, pa1, pa2, pa3); SBAR(); pv_tile<1>(o, vb0, pa0, pa1, pa2, pa3); }
    SBAR(); SEAM_K0();
    if (hi == 0) li_l[r32] = l_reg; asm volatile("s_waitcnt lgkmcnt(0)" ::: "memory");
    float rli[16];
#pragma unroll
    for (int r = 0; r < 16; ++r) rli[r] = __builtin_amdgcn_rcpf(li_l[crow(r, hi)]);
    bf16_t* Ow = cur.O + (size_t)(wid * QBLK) * OSTR;
#pragma unroll
    for (int r = 0; r < 16; ++r) { const int orow = crow(r, hi);
#pragma unroll
        for (int d0 = 0; d0 < 4; ++d0) { const float v = o[d0][r] * rli[r];
            const float vn = __shfl_xor(v, 1);
            if ((r32 & 1) == 0) *(unsigned*)(Ow + (size_t)orow * OSTR + d0 * 32 + r32) = cvtpk(v, vn); } }
    __syncthreads();
#undef RESC
#undef KBASE
#undef MASKT
#undef SEAM_K0
#undef HALF_STEP
}
#undef ROW
#undef VMW
#undef VMWN
#undef SLOAD_H
#undef SWRITE_HK
#undef SWRITE_HV
#undef SWRITE_H
#undef SBAR
}

typedef __bf16 bf16x2_t __attribute__((ext_vector_type(2)));

__device__ __forceinline__ float dot2bf(unsigned a, unsigned b, float c) {
    bf16x2_t av, bv; __builtin_memcpy(&av, &a, 4); __builtin_memcpy(&bv, &b, 4); return __builtin_amdgcn_fdot2_f32_bf16(av, bv, c, false); }
__device__ __forceinline__ float dot2bf_s(unsigned s_uniform, unsigned b, float c) { return dot2bf(s_uniform, b, c); }
namespace peer {
typedef float f32x16 __attribute__((ext_vector_type(16)));
__device__ __forceinline__ float fmaxs(float a, float b) { float r; asm("v_max_f32_e32 %0, %1, %2" : "=v"(r) : "v"(a), "v"(b)); return r; }
__device__ __forceinline__ float fmins(float a, float b) { float r; asm("v_min_f32_e32 %0, %1, %2" : "=v"(r) : "v"(a), "v"(b)); return r; }
#define CE(a, b) do { const float _h = fmaxs(a, b), _l = fmins(a, b); a = _h; b = _l; } while (0)
__device__ __forceinline__ void insert16(float (&L)[16], float x) {
#pragma unroll
    for (int i = 0; i < 16; ++i) { const float h = fmaxs(L[i], x); x = fmins(L[i], x); L[i] = h; }
}
__device__ __forceinline__ void sort16_desc(float (&v)[16]) {
#pragma unroll
    for (int k = 2; k <= 16; k <<= 1)
#pragma unroll
        for (int j = k >> 1; j >= 1; j >>= 1)
#pragma unroll
            for (int i = 0; i < 16; ++i) { const int l = i ^ j; if (l > i) { const bool desc = (i & k) == 0; const float hi_ = fmaxs(v[i], v[l]), lo_ = fmins(v[i], v[l]); v[i] = desc ? hi_ : lo_; v[l] = desc ? lo_ : hi_; } }
}
__device__ __forceinline__ void merge16(float (&L)[16], const float (&S)[16]) {
#pragma unroll
    for (int i = 0; i < 16; ++i) L[i] = fmaxs(L[i], S[15 - i]);
#pragma unroll
    for (int d = 8; d >= 1; d >>= 1)
#pragma unroll
        for (int i = 0; i < 16; ++i) if ((i & d) == 0) CE(L[i], L[i + d]);
}
__device__ __forceinline__ void merge_partner(float (&L)[16], const bool lo_half) {
    float B[16];
#pragma unroll
    for (int i = 0; i < 16; ++i) { auto r = __builtin_amdgcn_permlane32_swap(__float_as_uint(L[i]), __float_as_uint(L[i]), false, false);
        B[i] = __uint_as_float(lo_half ? r[1] : r[0]); }
#pragma unroll
    for (int i = 0; i < 16; ++i) L[i] = fmaxs(L[i], B[15 - i]);
#pragma unroll
    for (int d = 8; d >= 1; d >>= 1)
#pragma unroll
        for (int i = 0; i < 16; ++i) if ((i & d) == 0) CE(L[i], L[i + d]);
}
constexpr int KEYS_BYTES = 65536, SCR_OFF = 65536;
}

__device__ __forceinline__ void p0_transpose_item_fp8(const float* W, int K, int N, unsigned char* WT8, int row0, int src_col0, int k0, LAS float* scr, int lane, float sc) {
#pragma unroll 8
    for (int i = 0; i < 32; ++i) { const int kk = 2 * i + (lane >> 5); scr[kk * 33 + (lane & 31)] = W[(size_t)(k0 + kk) * N + src_col0 + (lane & 31)]; }
    LDS_WAIT(); asm volatile("" ::: "memory");
    const int c = lane & 3;
#pragma unroll
    for (int j = 0; j < 2; ++j) { const int n = (lane >> 2) + 16 * j; const LAS float* sp = scr + (16 * c) * 33 + n; u32x4 o;
#pragma unroll
        for (int q = 0; q < 4; ++q) { int p = 0; p = __builtin_amdgcn_cvt_pk_fp8_f32(sp[(4 * q) * 33] * sc, sp[(4 * q + 1) * 33] * sc, p, false); p = __builtin_amdgcn_cvt_pk_fp8_f32(sp[(4 * q + 2) * 33] * sc, sp[(4 * q + 3) * 33] * sc, p, true); o[q] = (unsigned)p; }
        *(u32x4*)(WT8 + (size_t)(row0 + n) * K + k0 + 16 * c) = o; }
    LDS_WAIT(); asm volatile("" ::: "memory");
}
constexpr float H8_SCALE = 16.f, W8_SCALE = 512.f;
constexpr size_t DO_W8 = 80 * MiB, DO_H8 = 96 * MiB;

struct Args { const float* in[17]; float* out; unsigned char* ws; int ph_lo, ph_hi; };
constexpr int N_PHASES = 11;

__global__ void __launch_bounds__(NTHR, 2) mega(Args args) {
    extern __shared__ __attribute__((aligned(16))) unsigned char lds_raw[];
    LAS unsigned char* lds = (LAS unsigned char*)lds_raw;
    volatile LAS unsigned* MISC = (volatile LAS unsigned*)(lds + MISC_OFF);
    const int wave = __builtin_amdgcn_readfirstlane((int)threadIdx.x >> 6);
    const int G = gridDim.x, bx = blockIdx.x, vcu = (G % 8 == 0) ? (bx % 8) * (G / 8) + bx / 8 : bx;
    unsigned char* ws = args.ws; char* dob = (char*)args.out;
    const float* x = args.in[0]; const float* g1 = args.in[1]; const float* w_in = args.in[2]; const float* fbias = args.in[3];
    const float* gq = args.in[4]; const float* gk = args.in[5]; const float* pgw = args.in[6]; const float* pscale = args.in[7];
    const float* wba = args.in[8]; const float* wbp = args.in[9]; const float* wout = args.in[10]; const float* g2 = args.in[11];
    const float* wq = args.in[12]; const float* sk1 = args.in[13]; const float* sk2 = args.in[14]; const float* eu = args.in[15]; const float* ev = args.in[16];
    bf16_t* WT_IN = (bf16_t*)(dob + DO_WT_IN); unsigned char* W8 = (unsigned char*)(dob + DO_W8); unsigned char* H8 = (unsigned char*)(dob + DO_H8); bf16_t* H1 = (bf16_t*)(dob + DO_H1); bf16_t* Ob = (bf16_t*)(dob + DO_O); bf16_t* POOLED = (bf16_t*)(dob + DO_POOLED); bf16_t* POOL2 = (bf16_t*)(dob + DO_POOL2);
    bf16_t* WT_PG = (bf16_t*)(ws + WS_WT_PG); bf16_t* WT_BA = (bf16_t*)(ws + WS_WT_BA); bf16_t* WT_BP = (bf16_t*)(ws + WS_WT_BP); bf16_t* WT_OUT = (bf16_t*)(ws + WS_WT_OUT); bf16_t* WT_Q = (bf16_t*)(ws + WS_WT_Q);
    bf16_t* SK = (bf16_t*)(ws + WS_SK); float* CS = (float*)(ws + WS_CS); float* LOGF = (float*)(ws + WS_LOGF); float* SSQ = (float*)(ws + WS_SSQ);
    bf16_t* Qb = (bf16_t*)(ws + WS_Q); bf16_t* Kb = (bf16_t*)(ws + WS_K); bf16_t* Vb = (bf16_t*)(ws + WS_V); bf16_t* PIN = (bf16_t*)(ws + WS_PIN); bf16_t* Gt = (bf16_t*)(ws + WS_G);
    bf16_t* EU = (bf16_t*)(ws + WS_EU); bf16_t* EV = (bf16_t*)(ws + WS_EV); bf16_t* XG = (bf16_t*)(ws + WS_XG); bf16_t* TMP = (bf16_t*)(ws + WS_TMP); bf16_t* MERGED = (bf16_t*)(ws + WS_MERGED); bf16_t* QP = (bf16_t*)(ws + WS_QP);
    for (int u = threadIdx.x; u < 128; u += NTHR) MISC[u] = 0u;
    __syncthreads();
    const int lo = args.ph_lo, hi = args.ph_hi;
    XcdBarrier bar; bar.bar = (unsigned*)(ws + WS_CTL) + CW_BAR + lo * XCD_BAR_WORDS; bar.x = 0; bar.st = MISC + 8;
    if (hi - lo > 1) bar = xcd_barrier_post(bar.bar, MISC + 8);
#define IN(k) (lo <= (k) && (k) < hi)
#define SEAM(k) do { if (IN(k) && IN((k) + 1)) xcd_barrier(bar); } while (0)
    const int gw = vcu * NWAVES + wave, NGW = G * NWAVES;

    if (IN(0)) {
        const int lane = lane_now(), tid = wave * 64 + lane;
        LAS float* scr = (LAS float*)(lds + RING_OFF + wave * 16384);
        constexpr int I_IN = (DM / 64) * (NPROJ / 32),     I_BA = (FW / 64) * (DM / 32), I_OUT = (DM / 64) * (DM / 32), I_PG = 4 * (256 / 64) * (256 / 32);
        constexpr int NITEMS = I_IN + 2 * I_BA + 2 * I_OUT + I_PG;
        for (int it = gw; it < NITEMS; it += NGW) {
            int r = it;
            if (r < I_IN) { const int nblk = NPROJ / 32, kb = r / nblk, nb = r % nblk, n0 = nb * 32;
                p0_transpose_item_fp8(w_in, DM, INC, W8, n0, n0 + (n0 >= 3072 ? 8 : 0), kb * 64, scr, lane, W8_SCALE);
                continue; } r -= I_IN;
            if (r < I_BA) { const int nblk = DM / 32, kb = r / nblk, nb = r % nblk; p0_transpose_item(wba, FW, DM, WT_BA, nb * 32, nb * 32, kb * 64, scr, lane); continue; } r -= I_BA;
            if (r < I_BA) { const int nblk = DM / 32, kb = r / nblk, nb = r % nblk; p0_transpose_item(wbp, PW, DM, WT_BP, nb * 32, nb * 32, kb * 64, scr, lane); continue; } r -= I_BA;
            if (r < I_OUT) { const int nblk = DM / 32, kb = r / nblk, nb = r % nblk; p0_transpose_item(wout, DM, DM, WT_OUT, nb * 32, nb * 32, kb * 64, scr, lane); continue; } r -= I_OUT;
            if (r < I_OUT) { const int nblk = DM / 32, kb = r / nblk, nb = r % nblk; p0_transpose_item(wq, DM, DM, WT_Q, nb * 32, nb * 32, kb * 64, scr, lane, g2); continue; } r -= I_OUT;
            { const int g = r / 32, rr = r % 32, kb = rr / 8, nb = rr % 8; p0_transpose_item(pgw + (size_t)g * 65536, 256, 256, WT_PG, g * 256 + nb * 32, nb * 32, kb * 64, scr, lane); }
        }
        for (int i = gw * 64 + lane; i < 2048 * 128 / 4; i += NGW * 64) { const int e = i * 4, d = e & 127, n = e >> 7, key = n & 127, f = (n >> 7) & 1, h = n >> 8;
            const f32x4 v = *(const f32x4*)((f ? sk2 : sk1) + ((size_t)h * 128 + key) * 128 + d); u32x2 o; o.x = pk2(v[0], v[1]); o.y = pk2(v[2], v[3]); *(u32x2*)(SK + e) = o; }
        { unsigned char* E8 = (unsigned char*)(ws + WS_EU); float* ESC = (float*)(ws + WS_EV);
          for (int r0 = gw; r0 < 2 * NEXP; r0 += 2 * NGW) {
            f32x4 v[2][8];
#pragma unroll
            for (int u = 0; u < 2; ++u) { const int r = r0 + u * NGW; const float* src = (r < NEXP ? eu : ev - (size_t)NEXP * DM) + (size_t)r * DM;
#pragma unroll
                for (int i = 0; i < 2; ++i)
#pragma unroll
                    for (int c = 0; c < 4; ++c) v[u][i * 4 + c] = *(const f32x4*)(src + 1024 * i + 16 * lane + 4 * c); }
#pragma unroll
            for (int u = 0; u < 2; ++u) { const int r = r0 + u * NGW; float am = 0.f;
                if (r < NEXP) {
#pragma unroll
                    for (int i = 0; i < 2; ++i)
#pragma unroll
                        for (int c = 0; c < 4; ++c) v[u][i * 4 + c] = v[u][i * 4 + c] * *(const f32x4*)(g2 + 1024 * i + 16 * lane + 4 * c); }
#pragma unroll
                for (int q = 0; q < 8; ++q) am = fmaxf(am, fmaxf(fmaxf(fabsf(v[u][q][0]), fabsf(v[u][q][1])), fmaxf(fabsf(v[u][q][2]), fabsf(v[u][q][3]))));
#pragma unroll
                for (int o = 1; o < 64; o <<= 1) am = fmaxf(am, __shfl_xor(am, o));
                int ex = (int)((__float_as_uint(am) >> 23) & 0xffu); if (ex < 16) ex = 134;
                const float sc = __uint_as_float((unsigned)(261 - ex) << 23), inv = __uint_as_float((unsigned)(ex - 7) << 23);
#pragma unroll
                for (int i = 0; i < 2; ++i) { u32x4 w;
#pragma unroll
                    for (int c = 0; c < 4; ++c) { const f32x4 t = v[u][i * 4 + c] * sc; int p = 0;
                        p = __builtin_amdgcn_cvt_pk_fp8_f32(t[0], t[1], p, false); p = __builtin_amdgcn_cvt_pk_fp8_f32(t[2], t[3], p, true); w[c] = (unsigned)p; }
                    *(u32x4*)(E8 + (size_t)(r >= NEXP) * NEXP * DM + ((size_t)(8 * i + (lane >> 3)) * NEXP + (r & (NEXP - 1))) * 128 + 16 * (lane & 7)) = w; }
                if (lane == 0) ESC[r] = inv; }
          } }
        __syncthreads();
        LAS f32x4* WfL = (LAS f32x4*)(lds + RING_OFF);
        for (int i = tid; i < 4096; i += NTHR) { const int l = i & 63, half = (i >> 6) & 1, e = (i >> 7) & 3, j = i >> 9, k = 256 * j + 4 * l + e;
            WfL[i] = *(const f32x4*)(w_in + (size_t)k * INC + 3072 + 4 * half); }
        __syncthreads();
        f32x4 gv[8];
#pragma unroll
        for (int j = 0; j < 8; ++j) gv[j] = ((const f32x4*)g1)[64 * j + lane];
        for (int row0 = gw; row0 < T; row0 += 2 * NGW) {
            asm volatile("" ::: "memory");
            f32x4 v[2][8];
#pragma unroll
            for (int u = 0; u < 2; ++u) { const f32x4* xr = (const f32x4*)(x + (size_t)(row0 + u * NGW) * DM) + lane;
#pragma unroll
                for (int j = 0; j < 8; ++j) v[u][j] = xr[64 * j]; }
#pragma unroll
            for (int u = 0; u < 2; ++u) { const int row = row0 + u * NGW; float ss = 0.f;
#pragma unroll
                for (int j = 0; j < 8; ++j) ss += (v[u][j][0] * v[u][j][0] + v[u][j][1] * v[u][j][1]) + (v[u][j][2] * v[u][j][2] + v[u][j][3] * v[u][j][3]);
                const float rstd = rsqrtf(wave_sum(ss) * (1.f / DM) + EPS);
                f32x4 a0 = {0.f, 0.f, 0.f, 0.f}, a1 = {0.f, 0.f, 0.f, 0.f};
#pragma unroll
                for (int j = 0; j < 8; ++j) { const f32x4 hv = v[u][j] * rstd * gv[j];
                    { int p8 = 0; p8 = __builtin_amdgcn_cvt_pk_fp8_f32(hv[0] * H8_SCALE, hv[1] * H8_SCALE, p8, false); p8 = __builtin_amdgcn_cvt_pk_fp8_f32(hv[2] * H8_SCALE, hv[3] * H8_SCALE, p8, true);
                      ((unsigned*)(H8 + (size_t)row * DM))[64 * j + lane] = (unsigned)p8; }
#pragma unroll
                    for (int e = 0; e < 4; ++e) { a0 += WfL[((j * 4 + e) * 2 + 0) * 64 + lane] * hv[e]; a1 += WfL[((j * 4 + e) * 2 + 1) * 64 + lane] * hv[e]; } }
                float z = 0.f;
#pragma unroll
                for (int c = 0; c < 8; ++c) { const float t = wave_sum(c < 4 ? a0[c & 3] : a1[c & 3]); if (lane == c) z = t; }
                if (lane < 8) { z += fbias[lane]; LOGF[(size_t)row * 8 + lane] = fminf(z, 0.f) - log1pf(expf(-fabsf(z))); } }
        }
    }
    SEAM(0);
    if (IN(1)) {
        if (bx < 32) {   const int lane = lane_now(), tid = wave * 64 + lane;
            LAS float* wsum = (LAS float*)(lds + EPI_OFF);
            const int b = bx >> 3, h = bx & 7; float v[8]; float run = 0.f;
#pragma unroll
            for (int i = 0; i < 8; ++i) { run += LOGF[((size_t)(b * S + tid * 8 + i)) * 8 + h]; v[i] = run; }
            float inc = run;
#pragma unroll
            for (int o = 1; o < 64; o <<= 1) { const float t = __shfl_up(inc, o); if (lane >= o) inc += t; }
            if (lane == 63) wsum[wave] = inc;
            __syncthreads();
            float base = inc - run;
            for (int w = 0; w < wave; ++w) base += wsum[w];
#pragma unroll
            for (int i = 0; i < 8; ++i) CS[(size_t)bx * S + tid * 8 + i] = (base + v[i]) * INV_SCALE;
            __syncthreads();
        }
        { pg8::SchedStd Sc{(const char*)H8, (const char*)W8, (size_t)256 * DM, (size_t)256 * DM, 0, T / 256, NPROJ / 256, (T / 256) * (NPROJ / 256), G, bx};
          EpiProj E{Qb, Kb, Vb, PIN, Gt, gq, gk, (LAS float*)(lds + EPI_OFF), 1.f / (H8_SCALE * W8_SCALE)};
          pg8::gemm_phase<true>(lds + RING_OFF, wave, DM / 2, DM / 2, DM / 2, Sc, E); }
    }
    SEAM(1);
    if (IN(2)) {
        const int lane = lane_now(), sub = lane >> 4, l16 = lane & 15;
#define POOL_BODY(W) do { \
            const int s0 = rb * 8, sq = s0 & (S - 1); const bf16_t* pp = PIN + (size_t)s0 * PW + ch; \
            f32x4 Pa[W + 7], Pb[W + 7]; \
            _Pragma("unroll") for (int r = 0; r < W + 7; ++r) { const int rel = r - (W - 1); \
                if (sq + rel >= 0) unpack8(*(const u32x4*)(pp + (long)rel * PW), Pa[r], Pb[r]); else { Pa[r] = (f32x4){0.f, 0.f, 0.f, 0.f}; Pb[r] = Pa[r]; } } \
            f32x4 Sa = {0.f, 0.f, 0.f, 0.f}, Sb = Sa; \
            _Pragma("unroll") for (int r = 0; r < W - 1; ++r) { Sa += Pa[r]; Sb += Pb[r]; } \
            _Pragma("unroll") for (int r = 0; r < 8; ++r) { Sa += Pa[r + W - 1]; Sb += Pb[r + W - 1]; \
                const int cnt = (sq + r + 1 < W) ? sq + r + 1 : W; const float inv = 1.f / (float)cnt; \
                *(u32x4*)(POOLED + (size_t)(s0 + r) * PW + ch) = pack8(Sa * inv - Pa[r + W - 1], Sb * inv - Pb[r + W - 1]); \
                Sa -= Pa[r]; Sb -= Pb[r]; } } while (0)
        for (int itp = gw; itp < 4 * (T / 16); itp += NGW) {
            const int g = itp & 3, rb = (itp >> 2) * 2 + (lane >> 5), ch = g * 256 + (lane & 31) * 8;
            if (g == 0) POOL_BODY(2); else if (g == 1) POOL_BODY(4); else if (g == 2) POOL_BODY(8); else POOL_BODY(16);
        }
#undef POOL_BODY
    }
    SEAM(2);
    if (IN(3)) {
        float bq;
        { const int lane = lane_now(); float a = fmaxf(fabsf(gq[lane]), fabsf(gq[64 + lane])), b2 = fmaxf(fabsf(gk[lane]), fabsf(gk[64 + lane]));
#pragma unroll
          for (int o = 1; o < 64; o <<= 1) { a = fmaxf(a, __shfl_xor(a, o)); b2 = fmaxf(b2, __shfl_xor(b2, o)); }
          bq = 128.f * SCALE * a * b2 + EPS; }
        const float cmargin = (30.f + 2.f * bq) * INV_SCALE;
#define ATT_JLO(Chp, qb) ({ const int lane_ = lane_now(), nte_ = 4 * ((qb) + 1); const float thr_ = (Chp)[(qb) * 256] + cmargin; \
            const float v_ = (lane_ < nte_) ? (Chp)[64 * lane_ + 63] : -3.0e38f; const int n_ = (int)__builtin_popcountll(__ballot(v_ > thr_)); \
            __builtin_amdgcn_readfirstlane(n_ < nte_ - 4 ? n_ : nte_ - 4); })
        for (int L = vcu; L < Bn * NH * 8; L += G) {
            const int bh = L >> 3, xq = L & 7, b = bh >> 3, h = bh & 7;
            const bf16_t* Kh = Kb + (size_t)bh * S * HD; const bf16_t* Vh = Vb + (size_t)bh * S * HD; const float* Ch = CS + (size_t)bh * S;
            const int j0 = ATT_JLO(Ch, xq), j1 = ATT_JLO(Ch, 15 - xq);
            att::BlockRef r0{Qb + ((size_t)bh * S + xq * 256) * HD, Kh, Vh, Ch, Ob + ((size_t)(b * S + xq * 256)) * FW + h * HD, xq * 256, j0};
            att::BlockRef r1{Qb + ((size_t)bh * S + (15 - xq) * 256) * HD, Kh, Vh, Ch, Ob + ((size_t)(b * S + (15 - xq) * 256)) * FW + h * HD, (15 - xq) * 256, j1};
            att::Seam Sm;
            att::attn_prime(r0, (char*)lds_raw, Sm, wave);
            att::attn_block(r0, r1, (char*)lds_raw, Sm, wave);
            att::attn_block(r1, r1, (char*)lds_raw, Sm, wave);
        }
#undef ATT_JLO
        VM_WAIT(); __syncthreads();
        pg8::SchedStd Sc{(const char*)POOLED, (const char*)WT_PG, (size_t)256 * PW * 2, (size_t)256 * 256 * 2, (size_t)256 * 2, T / 256, PW / 256, (T / 256) * (PW / 256), G, bx};
        EpiPool2 E{POOL2, pscale};
        pg8::gemm_phase(lds + RING_OFF, wave, 256, PW, 256, Sc, E);
    }
    SEAM(3);
    if (IN(4)) {
        pg8::SchedPair Sc{(const char*)Ob, (const char*)POOL2, (const char*)WT_BA, (const char*)WT_BP, (size_t)256 * FW * 2, (size_t)256 * FW * 2, T / 256, DM / 256, (T / 256) * (DM / 256), G, bx};
        EpiBranch E{TMP, MERGED, Gt};
        pg8::gemm_phase(lds + RING_OFF, wave, FW, FW, FW, Sc, E);
    }
    SEAM(4);
    if (IN(5)) {
        pg8::SchedStd Sc{(const char*)MERGED, (const char*)WT_OUT, (size_t)256 * DM * 2, (size_t)256 * DM * 2, 0, T / 256, DM / 256, (T / 256) * (DM / 256), G, bx};
        EpiOut E{x, XG, SSQ};
        pg8::gemm_phase(lds + RING_OFF, wave, DM, DM, DM, Sc, E);
    }
    SEAM(5);
    if (IN(6)) {
        pg8::SchedStd Sc{(const char*)XG, (const char*)WT_Q, (size_t)256 * DM * 2, (size_t)256 * DM * 2, 0, T / 256, DM / 256, (T / 256) * (DM / 256), G, bx};
        EpiBf16 E{QP, DM};
        pg8::gemm_phase(lds + RING_OFF, wave, DM, DM, DM, Sc, E);
    }
    SEAM(6);

    if (IN(7)) {
        const int lane = lane_now(), tid = wave * 64 + lane, r32 = lane & 31, hi = lane >> 5, h = vcu & 7;
#pragma unroll
        for (int i = 0; i < 8; ++i) { const int idx = tid + 512 * i, le = idx & 63, ks = (idx >> 6) & 7, tile = (idx >> 9) & 3, f = idx >> 11;
            const u32x4 v = *(const u32x4*)(SK + ((size_t)(h * 256 + f * 128 + 32 * tile + (le & 31)) * 128 + 16 * ks + 8 * (le >> 5)));
            *(LAS u32x4*)(lds + idx * 16) = v; }
        __syncthreads();
        LAS unsigned* scr = (LAS unsigned*)(lds + peer::SCR_OFF + wave * 8192) + lane;
        const unsigned nh4 = (unsigned)(1 - hi) << 2; const float NEGINF = -__builtin_inff();
        int* IDX = (int*)(ws + WS_IDX); float* GATE = (float*)(ws + WS_GATE);
        for (int tl = vcu >> 3; tl < T / 256; tl += G >> 3) {
            const int tok = tl * 256 + wave * 32 + r32;
            bf16x8 qf[2][8];
#pragma unroll
            for (int f = 0; f < 2; ++f)
#pragma unroll
                for (int ks = 0; ks < 8; ++ks) qf[f][ks] = *(const bf16x8*)(QP + (size_t)tok * DM + h * 256 + f * 128 + 16 * ks + 8 * hi);
            float tot = 0.f;
#pragma unroll
            for (int i = 0; i < 8; ++i) { const f32x4 v = *(const f32x4*)(SSQ + (size_t)tok * 32 + 4 * i); tot += (v[0] + v[1]) + (v[2] + v[3]); }
            const float rstd = rsqrtf(tot * (1.f / DM) + EPS);
            float KL[2][16];
#pragma unroll
            for (int f = 0; f < 2; ++f) {
                float L[16];
#pragma unroll
                for (int i = 0; i < 16; ++i) L[i] = NEGINF;
#pragma unroll
                for (int tile = 0; tile < 4; ++tile) {
                    peer::f32x16 acc = {};
#pragma unroll
                    for (int ks = 0; ks < 8; ++ks) acc = __builtin_amdgcn_mfma_f32_32x32x16_bf16(*(const LAS bf16x8*)(lds + (((f * 4 + tile) * 8 + ks) * 64 + lane) * 16), qf[f][ks], acc, 0, 0, 0);
                    float Sk[16];
#pragma unroll
                    for (int r = 0; r < 16; ++r) { const unsigned cp = (unsigned)(127 - 32 * tile - (r & 3) - 8 * (r >> 2) - 4);
                        Sk[r] = __uint_as_float(((__float_as_uint(acc[r]) & 0xffffff80u) | nh4) | cp); }
                    peer::sort16_desc(Sk);
                    if (tile == 0) {
#pragma unroll
                        for (int i = 0; i < 16; ++i) L[i] = Sk[i]; }
                    else peer::merge16(L, Sk);
                }
                peer::merge_partner(L, hi == 0);
#pragma unroll
                for (int i = 0; i < 16; ++i) KL[f][i] = L[i];
            }
            float Tt[16];
#pragma unroll
            for (int i = 0; i < 16; ++i) Tt[i] = NEGINF;
#pragma unroll
            for (int i = 0; i < 16; ++i)
#pragma unroll
                for (int j = 0; j < 16; ++j) if ((i + 1) * (j + 1) <= 16) {
                    const float sm = __uint_as_float(__float_as_uint(KL[0][i]) & 0xffffff80u) + __uint_as_float(__float_as_uint(KL[1][j]) & 0xffffff80u);
                    peer::insert16(Tt, __uint_as_float((__float_as_uint(sm) & 0xffffff00u) | (unsigned)(255 - (16 * i + j)))); }
#pragma unroll
            for (int k = 0; k < 16; ++k) { scr[k * 64] = __float_as_uint(KL[0][k]); scr[(16 + k) * 64] = __float_as_uint(KL[1][k]); }
            LDS_WAIT();
            int ex[16]; float gt[16]; float gs = 0.f;
            const float s0 = __uint_as_float(__float_as_uint(Tt[0]) & 0xffffff00u) * rstd;
#pragma unroll
            for (int r = 0; r < 16; ++r) { const unsigned tb = __float_as_uint(Tt[r]), pos = 255u - (tb & 255u), ci = pos >> 4, cj = pos & 15u;
                const unsigned a = scr[ci * 64], b = scr[(16 + cj) * 64];
                ex[r] = (int)((127u - (a & 127u)) * 128u + (127u - (b & 127u)));
                gt[r] = __expf(__uint_as_float(tb & 0xffffff00u) * rstd - s0); gs += gt[r]; }
            const float ginv = 1.f / gs;
            if (hi == 0) { int* o = IDX + (size_t)tok * 128 + h * 16;
#pragma unroll
                for (int q4 = 0; q4 < 4; ++q4) *(int4*)(o + 4 * q4) = make_int4(ex[4 * q4], ex[4 * q4 + 1], ex[4 * q4 + 2], ex[4 * q4 + 3]); }
            else { float* o = GATE + (size_t)tok * 128 + h * 16;
#pragma unroll
                for (int q4 = 0; q4 < 4; ++q4) *(f32x4*)(o + 4 * q4) = (f32x4){gt[4 * q4] * ginv, gt[4 * q4 + 1] * ginv, gt[4 * q4 + 2] * ginv, gt[4 * q4 + 3] * ginv}; }
            LDS_WAIT();
        }
    }
    SEAM(7);
    float* PA = (float*)(ws + WS_MERGED); float* HS = (float*)(ws + WS_QP);
    if (IN(8)) {
        const int lane = lane_now(), l8 = lane & 7, lg = lane >> 3, grp = bx & 7, nwv = (G >> 3) * NWAVES, wg = (bx >> 3) * NWAVES + wave;
        const int* IDX = (const int*)(ws + WS_IDX); const unsigned char* EU8 = (const unsigned char*)(ws + WS_EU);
#define P8_IDX(E, tk) do { const int* ip_ = IDX + (size_t)((tk) < T ? (tk) : T - 1) * 128 + lane; E[0] = ip_[0]; E[1] = ip_[64]; } while (0)
#define P8_ROWS(R, E, XA, XB, tk) do { _Pragma("unroll") for (int i = 0; i < 16; ++i) { const int e_ = __shfl(E[i >> 3], ((8 * i) & 63) + lg); R[i] = *(const u32x4*)(EU8 + (unsigned)(e_ * 128 + coffT)); } \
            const bf16_t* xp_ = XG + (size_t)((tk) < T ? (tk) : T - 1) * DM + coff; XA = *(const u32x4*)xp_; XB = *(const u32x4*)(xp_ + 8); } while (0)
#define P8_DPP(x, ctrl) __uint_as_float(__builtin_amdgcn_update_dpp(0u, __float_as_uint(x), ctrl, 0xf, 0xf, false))
#define P8_COMP(R, XA, XB, tk) do { f32x2 xf[8]; \
            _Pragma("unroll") for (int d = 0; d < 4; ++d) { xf[d] = (f32x2){__uint_as_float(XA[d] << 16), __uint_as_float(XA[d] & 0xffff0000u)}; xf[4 + d] = (f32x2){__uint_as_float(XB[d] << 16), __uint_as_float(XB[d] & 0xffff0000u)}; } \
            float sd[16]; \
            _Pragma("unroll") for (int i = 0; i < 16; ++i) { f32x2 a2 = {0.f, 0.f}; \
                _Pragma("unroll") for (int d = 0; d < 4; ++d) { a2 += __builtin_amdgcn_cvt_pk_f32_fp8((int)R[i][d], false) * xf[2 * d]; a2 += __builtin_amdgcn_cvt_pk_f32_fp8((int)R[i][d], true) * xf[2 * d + 1]; } \
                sd[i] = a2[0] + a2[1]; } \
              \
            float s8[8], s4[4], s2_[2]; \
            _Pragma("unroll") for (int k = 0; k < 8; ++k) { const float keep = q2 ? sd[k + 8] : sd[k], give = q2 ? sd[k] : sd[k + 8]; s8[k] = keep + P8_DPP(give, 0x141); }     \
            _Pragma("unroll") for (int k = 0; k < 4; ++k) { const float keep = q1 ? s8[k + 4] : s8[k], give = q1 ? s8[k] : s8[k + 4]; s4[k] = keep + P8_DPP(give, 0x4E); }      \
            _Pragma("unroll") for (int k = 0; k < 2; ++k) { const float keep = q0 ? s4[k + 2] : s4[k], give = q0 ? s4[k] : s4[k + 2]; s2_[k] = keep + P8_DPP(give, 0xB1); }     \
            if ((tk) < T) *(f32x2*)(PA + ((size_t)(tk) * 16 + c) * 128 + 2 * lane) = (f32x2){s2_[0], s2_[1]}; } while (0)
        const bool q2 = (lane & 4) != 0, q1 = (lane & 2) != 0, q0 = (lane & 1) != 0;
        LAS unsigned* wq = (LAS unsigned*)(lds + MISC_OFF + 128);
        if (lane == 0 && wave == 0) { wq[0] = 0u; wq[1] = 0u; }
        __syncthreads();
        const int tok0 = (bx >> 3) * NWAVES, npair = (T / nwv) * NWAVES / 2;
#define WQ_NEXT(slot) __builtin_amdgcn_readfirstlane((int)(lane == 0 ? __hip_atomic_fetch_add(wq + (slot), 1u, __ATOMIC_RELAXED, __HIP_MEMORY_SCOPE_WORKGROUP) : 0u))
#define WQ_TOK(p, k) ((p) < npair ? tok0 + ((2 * (p) + (k)) & 7) + nwv * ((2 * (p) + (k)) >> 3) : T)
        for (int c = grp, pass = 0; c < 16; c += 8, ++pass) {
            const int coff = 128 * c + 16 * l8, coffT = c * NEXP * 128 + 16 * l8;
            int eA[2], eB[2]; u32x4 rA[16], rB[16]; u32x4 xA0, xA1, xB0, xB1;
            int p = WQ_NEXT(pass); int ta = WQ_TOK(p, 0), tb = WQ_TOK(p, 1);
            P8_IDX(eA, ta); P8_ROWS(rA, eA, xA0, xA1, ta); P8_IDX(eB, tb);
#pragma unroll 1
            while (p < npair) {
                const int pn = WQ_NEXT(pass); const int na = WQ_TOK(pn, 0), nb = WQ_TOK(pn, 1);
                P8_ROWS(rB, eB, xB0, xB1, tb); P8_IDX(eA, na);
                P8_COMP(rA, xA0, xA1, ta);
                P8_ROWS(rA, eA, xA0, xA1, na); P8_IDX(eB, nb);
                P8_COMP(rB, xB0, xB1, tb);
                p = pn; ta = na; tb = nb;
            }
        }
#undef P8_IDX
#undef P8_ROWS
#undef P8_COMP
#undef P8_DPP
    }
    SEAM(8);
    if (IN(9)) {
        const int lane = lane_now();
        const int* IDX = (const int*)(ws + WS_IDX); const float* GATE = (const float*)(ws + WS_GATE); const float* ESC = (const float*)(ws + WS_EV);
        for (int t = gw; t < T; t += NGW) {
            const float pss = lane < 32 ? SSQ[(size_t)t * 32 + lane] : 0.f;
            const float rstd = rsqrtf(wave_sum(pss) * (1.f / DM) + EPS);
#pragma unroll
            for (int hh = 0; hh < 2; ++hh) { const int j = 64 * hh + lane; float a = 0.f;
#pragma unroll
                for (int c = 0; c < 16; ++c) a += PA[((size_t)t * 16 + c) * 128 + (j & 7) * 16 + (j >> 3)];
                const int e = IDX[(size_t)t * 128 + j];
                a *= ESC[e] * rstd;
                const float ge = 0.5f * a * (1.f + tanhf(0.7978845608028654f * (a + 0.044715f * a * a * a)));
                HS[(size_t)t * 128 + j] = ge * GATE[(size_t)t * 128 + j] * ESC[NEXP + e]; }
        }
    }
    SEAM(9);
    if (IN(10)) {
        const int lane = lane_now(), l8 = lane & 7, lg = lane >> 3, grp = bx & 7, nwv = (G >> 3) * NWAVES, wg = (bx >> 3) * NWAVES + wave;
        const int* IDX = (const int*)(ws + WS_IDX); const unsigned char* EV8 = (const unsigned char*)(ws + WS_EU) + (size_t)NEXP * DM;
        float* outp = args.out;
        const bool b16 = (lane & 16) != 0, b8 = (lane & 8) != 0;
#define P10_LOADE(E, tk) do { const int* ip_ = IDX + (size_t)((tk) < T ? (tk) : T - 1) * 128 + lane; E[0] = ip_[0]; E[1] = ip_[64]; } while (0)
#define P10_LOADH(H, tk) do { const float* hp_ = HS + (size_t)((tk) < T ? (tk) : T - 1) * 128 + lane; H[0] = hp_[0]; H[1] = hp_[64]; } while (0)
#define P10_ROWS(R, E, O, tk) do { _Pragma("unroll") for (int i = 0; i < 16; ++i) { const int e_ = __shfl(E[i >> 3], ((8 * i) & 63) + lg); R[i] = *(const u32x4*)(EV8 + (unsigned)(e_ * 128 + coffT)); } \
            { const unsigned w_ = *(const unsigned*)(XG + (size_t)((tk) < T ? (tk) : T - 1) * DM + coff + 2 * lg); O = (f32x2){__uint_as_float(w_ << 16), __uint_as_float(w_ & 0xffff0000u)}; } } while (0)
#define P10_COMP(R, H, O, tk) do { f32x2 acc[8]; \
            _Pragma("unroll") for (int d = 0; d < 8; ++d) acc[d] = (f32x2){0.f, 0.f}; \
            _Pragma("unroll") for (int i = 0; i < 16; ++i) { const float h_ = __shfl(H[i >> 3], ((8 * i) & 63) + lg); _Pragma("unroll") for (int d = 0; d < 4; ++d) { \
                acc[2 * d] += __builtin_amdgcn_cvt_pk_f32_fp8((int)R[i][d], false) * h_; acc[2 * d + 1] += __builtin_amdgcn_cvt_pk_f32_fp8((int)R[i][d], true) * h_; } } \
              \
            float f8[8], f4[4], f2[2]; \
            _Pragma("unroll") for (int k = 0; k < 8; ++k) { auto r_ = __builtin_amdgcn_permlane32_swap(__float_as_uint(acc[k >> 1][k & 1]), __float_as_uint(acc[(k + 8) >> 1][k & 1]), false, false); f8[k] = __uint_as_float(r_[0]) + __uint_as_float(r_[1]); } \
            _Pragma("unroll") for (int k = 0; k < 4; ++k) { const float keep = b16 ? f8[k + 4] : f8[k], give = b16 ? f8[k] : f8[k + 4]; f4[k] = keep + __shfl_xor(give, 16); } \
            _Pragma("unroll") for (int k = 0; k < 2; ++k) { const float keep = b8 ? f4[k + 2] : f4[k], give = b8 ? f4[k] : f4[k + 2]; f2[k] = keep + __shfl_xor(give, 8); } \
            if ((tk) < T) { f32x2 v_ = O; v_[0] += f2[0]; v_[1] += f2[1]; *(f32x2*)(outp + (size_t)(tk) * DM + coff + 2 * lg) = v_; } } while (0)
        LAS unsigned* wq = (LAS unsigned*)(lds + MISC_OFF + 128);
        if (lane == 0 && wave == 0) { wq[2] = 0u; wq[3] = 0u; }
        __syncthreads();
        const int tok0 = (bx >> 3) * NWAVES, npair = (T / nwv) * NWAVES / 2;
        for (int c = grp, pass = 0; c < 16; c += 8, ++pass) {
            const int coff = 128 * c + 16 * l8, coffT = c * NEXP * 128 + 16 * l8;
            int e[2]; float hA[2], hB[2]; u32x4 rA[16], rB[16]; f32x2 oA, oB;
            int p = WQ_NEXT(2 + pass); int ta = WQ_TOK(p, 0), tb = WQ_TOK(p, 1);
            P10_LOADE(e, ta); P10_ROWS(rA, e, oA, ta); P10_LOADH(hA, ta); P10_LOADE(e, tb);
#pragma unroll 1
            while (p < npair) {
                const int pn = WQ_NEXT(2 + pass); const int na = WQ_TOK(pn, 0), nb = WQ_TOK(pn, 1);
                P10_ROWS(rB, e, oB, tb); P10_LOADH(hB, tb); P10_LOADE(e, na);
                P10_COMP(rA, hA, oA, ta);
                P10_ROWS(rA, e, oA, na); P10_LOADH(hA, na); P10_LOADE(e, nb);
                P10_COMP(rB, hB, oB, tb);
                p = pn; ta = na; tb = nb;
            }
        }
#undef WQ_NEXT
#undef WQ_TOK
#undef P10_LOADE
#undef P10_LOADH
#undef P10_ROWS
#undef P10_COMP
    }
#undef IN
#undef SEAM
}

static int g_grid = 0;
static void launch_mega(const Args& a0, int lo, int hi, hipStream_t stream) {
    Args a = a0; a.ph_lo = lo; a.ph_hi = hi;
    hipLaunchKernelGGL(mega, dim3(g_grid), dim3(NTHR), LDS_BYTES, stream, a);
}

extern "C" void kernel_launch(void* const* d_in, const int* in_sizes, int n_in, void* d_out, int out_size, void* d_ws, size_t ws_size, hipStream_t stream) {
    if (n_in != 17 || out_size != T * DM || ws_size < 512 * MiB) { fprintf(stderr, "kernel_launch: unexpected shapes n_in=%d out=%d ws=%zu\n", n_in, out_size, ws_size); return; }
    if (g_grid == 0) {
        int dev = 0, cus = 0;
        if (hipGetDevice(&dev) != hipSuccess || hipDeviceGetAttribute(&cus, hipDeviceAttributeMultiprocessorCount, dev) != hipSuccess) { fprintf(stderr, "kernel_launch: device query failed\n"); g_grid = -1; return; }
        if (hipFuncSetAttribute((const void*)mega, hipFuncAttributeMaxDynamicSharedMemorySize, LDS_BYTES) != hipSuccess) { fprintf(stderr, "kernel_launch: hipFuncSetAttribute failed\n"); g_grid = -1; return; }
        if (cus < 256) { fprintf(stderr, "kernel_launch: this kernel needs 256 co-resident workgroups (one per CU); the device has %d CUs\n", cus); g_grid = -1; return; }
        g_grid = 256;
    }
    if (g_grid < 0) return;
    char* ws = (char*)d_ws; float* out = (float*)d_out;
    (void)hipMemsetAsync(ws + WS_CTL + CW_BAR * 4, 0, XCD_BAR_WORDS * 4, stream);
    Args a{}; for (int i = 0; i < 17; ++i) a.in[i] = (const float*)d_in[i]; a.out = out; a.ws = (unsigned char*)d_ws;
    launch_mega(a, 0, N_PHASES, stream);
}
```

```cpp
#include <hip/hip_runtime.h>
#include <cstdio>
#include <cstdint>

typedef unsigned short bf16_t;
constexpr int Bn = 4, S = 4096, DM = 2048, T = Bn * S, NH = 8, HD = 128, FW = 1024, PW = 1024;
constexpr int INC = 8200, NPROJ = 8192;
constexpr int PH = 8, PK = 128, PQD = 256, TOPK = 16, NEXP = 16384;
constexpr float EPS = 1e-6f;
constexpr float SCALE = 0.08838834764831845f;
constexpr float INV_SCALE = 11.313708498984761f;
constexpr size_t MiB = 1u << 20;
constexpr size_t WS_WT_PG = 1 * MiB, WS_WT_BA = 2 * MiB, WS_WT_BP = 6 * MiB, WS_WT_OUT = 10 * MiB, WS_WT_Q = 18 * MiB, WS_SK = 26 * MiB, WS_SKB = 27 * MiB,
                 WS_CS = 28 * MiB, WS_LOGF = 29 * MiB, WS_SSQ = 30 * MiB, WS_IDX = 32 * MiB, WS_GATE = 40 * MiB,
                 WS_Q = 48 * MiB, WS_K = 80 * MiB, WS_V = 112 * MiB, WS_PIN = 144 * MiB, WS_G = 176 * MiB, WS_EU = 304 * MiB, WS_EV = 368 * MiB, WS_XG = 432 * MiB,
                 WS_TMP = 48 * MiB, WS_MERGED = 112 * MiB, WS_QP = 48 * MiB, WS_RAWQ = 304 * MiB, WS_RAWK = 368 * MiB, WS_SC = 176 * MiB;
constexpr size_t DO_H1 = 0, DO_WT_IN = 64 * MiB, DO_O = 0, DO_POOLED = 32 * MiB, DO_POOL2 = 64 * MiB;

__device__ __forceinline__ float bf2f(bf16_t v) { return __uint_as_float(((unsigned)v) << 16); }
__device__ __forceinline__ bf16_t f2bf(float f) { unsigned u = __float_as_uint(f); return (bf16_t)((u + 0x7fffu + ((u >> 16) & 1u)) >> 16); }


#define LAS __attribute__((address_space(3)))
#define GAS __attribute__((address_space(1)))
typedef short bf16x8 __attribute__((ext_vector_type(8)));
typedef float f32x4 __attribute__((ext_vector_type(4)));
typedef float f32x2 __attribute__((ext_vector_type(2)));
typedef unsigned u32x4 __attribute__((ext_vector_type(4)));
typedef unsigned u32x2 __attribute__((ext_vector_type(2)));
typedef int v8i_t __attribute__((ext_vector_type(8)));
typedef int i32x4_t __attribute__((ext_vector_type(4)));
constexpr int NWAVES = 8, NTHR = 512;
constexpr int RING_OFF = 0, RING_BYTES = 131072, EPI_OFF = 131072, EPI_BYTES = 16384, MISC_OFF = EPI_OFF + EPI_BYTES, LDS_BYTES = MISC_OFF + 512;
constexpr size_t WS_CTL = 0, CTL_ZERO_BYTES = 65536;
constexpr int CW_BAR = 1024;

__device__ __forceinline__ unsigned cvt_pk_bf16(float lo, float hi) { unsigned r; asm volatile("s_nop 0\n\tv_cvt_pk_bf16_f32 %0, %1, %2" : "=v"(r) : "v"(lo), "v"(hi)); return r; }
__device__ __forceinline__ float wave_sum(float v) {
#pragma unroll
    for (int o = 1; o < 64; o <<= 1) v += __shfl_xor(v, o);
    return v;
}
__device__ __forceinline__ int lane_now() { int l; asm volatile("v_mbcnt_lo_u32_b32 %0, -1, 0\n\tv_mbcnt_hi_u32_b32 %0, -1, %0" : "=v"(l)); return l; }
#define LDS_WAIT() asm volatile("s_waitcnt lgkmcnt(0)" ::: "memory")
#define VM_WAIT() asm volatile("s_waitcnt vmcnt(0)" ::: "memory")

namespace pg8 {
constexpr int BM = 256, BK = 64, HALF = 128, HTB = HALF * BK * 2, STAGE_BYTES = 8 * HTB, NXCD = 8, WGM = 8;
__host__ __device__ __forceinline__ int lds_byte(int r, int c) { const int st = (r >> 4) * 2 + (c >> 5), rr = r & 15, cc = c & 31, ob = rr * 64 + cc * 2; return st * 1024 + (ob ^ (((ob >> 9) & 1) << 5)); }
__host__ __device__ __forceinline__ void stage_rc(int b, int& R, int& C) { const int st = b / 1024, sb = b % 1024, swz = sb ^ (((sb >> 9) & 1) << 5); R = (st >> 1) * 16 + swz / 64; C = (st & 1) * 32 + (swz % 64) / 2; }
__host__ __device__ __forceinline__ int perm32(int rho) { const int n = rho >> 4, i = rho & 15; return 8 * (i >> 2) + 4 * n + (i & 3); }
struct Unit { int pm, pn, aux; };
__device__ __forceinline__ void order_map(int L, int nM, int nN, int nwg, Unit& u) {
    int wgid = L; { const int q = nwg / NXCD, r = nwg % NXCD, xcd = wgid % NXCD, off = wgid / NXCD; wgid = (xcd < r ? xcd * (q + 1) : r * (q + 1) + (xcd - r) * q) + off; }
    const int nig = WGM * nN, gid = wgid / nig, fm = gid * WGM, gsz = (nM - fm) < WGM ? (nM - fm) : WGM;
    u.pm = fm + ((wgid % nig) % gsz); u.pn = (wgid % nig) / gsz; u.aux = 0;
}
struct SchedStd {
    const char* A; const char* Bt; size_t a_tile, b_tile, a_kstride; int nM, nN, nwg, G, c;
    __device__ __forceinline__ bool next(int i, Unit& u) const { const long L = (long)i * G + c; if (L >= nwg) return false; order_map((int)L, nM, nN, nwg, u); return true; }
    __device__ __forceinline__ const char* a_ptr(const Unit& u) const { return A + (size_t)u.pm * a_tile + (size_t)u.pn * a_kstride; }
    __device__ __forceinline__ const char* b_ptr(const Unit& u) const { return Bt + (size_t)u.pn * b_tile; }
};
struct SchedPair {
    const char* A0; const char* A1; const char* B0; const char* B1; size_t a_tile, b_tile; int nM, nN, nwg, G, c;
    __device__ __forceinline__ bool next(int i, Unit& u) const { const long L = (long)(i >> 1) * G + c; if (L >= nwg) return false; order_map((int)L, nM, nN, nwg, u); u.aux = i & 1; return true; }
    __device__ __forceinline__ const char* a_ptr(const Unit& u) const { return (u.aux ? A1 : A0) + (size_t)u.pm * a_tile; }
    __device__ __forceinline__ const char* b_ptr(const Unit& u) const { return (u.aux ? B1 : B0) + (size_t)u.pn * b_tile; }
};
typedef f32x4 Acc[2][2][4][2];

template <bool FP8 = false, class Epi, class Sched>
__device__ __forceinline__ void gemm_phase(LAS unsigned char* lds, const int wid, const int K, const int lda, const int ldb, const Sched& S, const Epi& E) {
    const int lane = lane_now(), tid = wid * 64 + lane, wr = wid >> 2, wc = wid & 3, fr = lane & 15, fq = lane >> 4;
    const int nt = K / BK;
    unsigned voffA[2], voffB[2];
#pragma unroll
    for (int i = 0; i < 2; ++i) { int R, C; stage_rc(tid * 16 + i * 8192, R, C); const int Rb = (R & ~31) + perm32(R & 31);
        voffA[i] = (unsigned)(R * lda + C) * 2u; voffB[i] = (unsigned)(Rb * ldb + C) * 2u; }
    const size_t kstep = (size_t)(BK * 2);
    const size_t hstepA = (size_t)HALF * lda * 2, hstepB = (size_t)HALF * ldb * 2;
    const unsigned ldsw = (unsigned)wid * 1024u;
    const int aoff = lds_byte(wr * 64 + fr, fq * 8), boff = lds_byte(wc * 32 + fr, fq * 8);
#define PG8_SA(b, h) (((b) * 2 + (h)) * HTB)
#define PG8_SB(b, h) ((4 + (b) * 2 + (h)) * HTB)
#define PG8_STAGE(bufoff, gbase, voff) do { _Pragma("unroll") for (int _i = 0; _i < 2; ++_i) \
        __builtin_amdgcn_global_load_lds((const unsigned*)((const char*)(gbase) + (voff)[_i]), (LAS unsigned*)(lds + (bufoff) + ldsw + _i * 8192), 16, 0, 0); } while (0)
#define PG8_LDA(dst, b, h) do { if constexpr (FP8) { _Pragma("unroll") for (int m = 0; m < 4; ++m) dst##8[m] = __builtin_shufflevector(*(const LAS i32x4_t*)(lds + PG8_SA(b, h) + aoff + m * 2048), *(const LAS i32x4_t*)(lds + PG8_SA(b, h) + aoff + m * 2048 + 1024), 0, 1, 2, 3, 4, 5, 6, 7); } \
        else { _Pragma("unroll") for (int m = 0; m < 4; ++m) _Pragma("unroll") for (int k = 0; k < 2; ++k) dst[m][k] = *(const LAS bf16x8*)(lds + PG8_SA(b, h) + aoff + m * 2048 + k * 1024); } } while (0)
#define PG8_LDB(dst, b, h) do { if constexpr (FP8) { _Pragma("unroll") for (int n = 0; n < 2; ++n) dst##8[n] = __builtin_shufflevector(*(const LAS i32x4_t*)(lds + PG8_SB(b, h) + boff + n * 2048), *(const LAS i32x4_t*)(lds + PG8_SB(b, h) + boff + n * 2048 + 1024), 0, 1, 2, 3, 4, 5, 6, 7); } \
        else { _Pragma("unroll") for (int n = 0; n < 2; ++n) _Pragma("unroll") for (int k = 0; k < 2; ++k) dst[n][k] = *(const LAS bf16x8*)(lds + PG8_SB(b, h) + boff + n * 2048 + k * 1024); } } while (0)
#define PG8_MMA(ai, bj, At, Bt) do { if constexpr (!FP8) __builtin_amdgcn_s_setprio(1);     \
        if constexpr (FP8) { _Pragma("unroll") for (int m = 0; m < 4; ++m) _Pragma("unroll") for (int n = 0; n < 2; ++n) \
            acc[ai][bj][m][n] = __builtin_amdgcn_mfma_scale_f32_16x16x128_f8f6f4(Bt##8[n], At##8[m], acc[ai][bj][m][n], 0, 0, 0, 0x7f7f7f7f, 0, 0x7f7f7f7f); } \
        else { _Pragma("unroll") for (int m = 0; m < 4; ++m) _Pragma("unroll") for (int n = 0; n < 2; ++n) _Pragma("unroll") for (int k = 0; k < 2; ++k) \
            acc[ai][bj][m][n] = __builtin_amdgcn_mfma_f32_16x16x32_bf16(Bt[n][k], At[m][k], acc[ai][bj][m][n], 0, 0, 0); } \
        __builtin_amdgcn_s_setprio(0); } while (0)
#define PG8_WAIT_V(n) asm volatile("s_waitcnt vmcnt(" #n ")" ::: "memory")
#define PG8_WAIT_L(n) asm volatile("s_waitcnt lgkmcnt(" #n ")" ::: "memory")
#define PG8_BAR __builtin_amdgcn_s_barrier()
#define PG8_SCHED __builtin_amdgcn_sched_barrier(0)
    Unit cur, nxt; int ui = 0;
    if (!S.next(0, cur)) return;
    Acc acc;
#pragma unroll
    for (int a = 0; a < 2; ++a)
#pragma unroll
        for (int b = 0; b < 2; ++b)
#pragma unroll
            for (int m = 0; m < 4; ++m)
#pragma unroll
                for (int n = 0; n < 2; ++n) acc[a][b][m][n] = (f32x4){0.f, 0.f, 0.f, 0.f};
    bf16x8 At[4][2], B0[2][2], B1[2][2]; v8i_t At8[4], B08[2], B18[2];
    const char* cA = S.a_ptr(cur); const char* cB = S.b_ptr(cur);
    PG8_STAGE(PG8_SB(0, 0), cB, voffB); PG8_STAGE(PG8_SB(0, 1), cB + hstepB, voffB); PG8_STAGE(PG8_SA(0, 0), cA, voffA); PG8_STAGE(PG8_SA(0, 1), cA + hstepA, voffA);
    if (wr == 1) PG8_BAR;
    PG8_WAIT_V(2); PG8_BAR;
    PG8_STAGE(PG8_SB(1, 0), cB + kstep, voffB); PG8_STAGE(PG8_SA(1, 0), cA + kstep, voffA); PG8_STAGE(PG8_SB(1, 1), cB + hstepB + kstep, voffB);
    PG8_WAIT_V(6); PG8_BAR;
#pragma unroll 1
    for (;;) {
        const bool has_next = S.next(ui + 1, nxt);
        const char* nA = has_next ? S.a_ptr(nxt) : cA; const char* nB = has_next ? S.b_ptr(nxt) : cB;
#pragma unroll 1
        for (int t = 0; t < nt; t += 2) {
            const bool last = (t == nt - 2);
            const char* a1 = cA + (size_t)(t + 1) * kstep;
            const char* a2 = last ? nA : cA + (size_t)(t + 2) * kstep; const char* b2 = last ? nB : cB + (size_t)(t + 2) * kstep;
            const char* a3 = a2 + kstep; const char* b3 = b2 + kstep;
            PG8_LDB(B0, 0, 0); PG8_LDB(B1, 0, 1); PG8_SCHED; PG8_LDA(At, 0, 0); PG8_STAGE(PG8_SA(1, 1), a1 + hstepA, voffA);
            PG8_WAIT_V(8); PG8_WAIT_L(0); PG8_BAR; PG8_MMA(0, 0, At, B0); PG8_MMA(0, 1, At, B1); PG8_BAR; PG8_SCHED;
            PG8_LDA(At, 0, 1); PG8_STAGE(PG8_SB(0, 0), b2, voffB); PG8_STAGE(PG8_SB(0, 1), b2 + hstepB, voffB); PG8_STAGE(PG8_SA(0, 0), a2, voffA);
            PG8_WAIT_V(8); PG8_WAIT_L(0); PG8_BAR; PG8_MMA(1, 0, At, B0); PG8_MMA(1, 1, At, B1); PG8_BAR; PG8_SCHED;
            PG8_LDB(B0, 1, 0); PG8_LDB(B1, 1, 1); PG8_SCHED; PG8_LDA(At, 1, 0); PG8_STAGE(PG8_SA(0, 1), a2 + hstepA, voffA);
            PG8_WAIT_V(8); PG8_WAIT_L(0); PG8_BAR; PG8_MMA(0, 0, At, B0); PG8_MMA(0, 1, At, B1); PG8_BAR; PG8_SCHED;
            PG8_LDA(At, 1, 1); PG8_STAGE(PG8_SB(1, 0), b3, voffB); PG8_STAGE(PG8_SB(1, 1), b3 + hstepB, voffB); PG8_STAGE(PG8_SA(1, 0), a3, voffA);
            PG8_WAIT_V(8); PG8_WAIT_L(0); PG8_BAR; PG8_MMA(1, 0, At, B0); PG8_MMA(1, 1, At, B1); PG8_BAR; PG8_SCHED;
        }
        if (wr == 0) PG8_BAR;
        E(acc, cur, ui, wid);
        if (!has_next) break;
#pragma unroll
        for (int a = 0; a < 2; ++a)
#pragma unroll
            for (int b = 0; b < 2; ++b)
#pragma unroll
                for (int m = 0; m < 4; ++m)
#pragma unroll
                    for (int n = 0; n < 2; ++n) acc[a][b][m][n] = (f32x4){0.f, 0.f, 0.f, 0.f};
        cur = nxt; cA = nA; cB = nB; ++ui;
        if (wr == 1) PG8_BAR;
    }
    PG8_WAIT_V(0);
    PG8_BAR;
#undef PG8_SA
#undef PG8_SB
#undef PG8_STAGE
#undef PG8_LDA
#undef PG8_LDB
#undef PG8_MMA
#undef PG8_WAIT_V
#undef PG8_WAIT_L
#undef PG8_BAR
#undef PG8_SCHED
}
}

using pg8::Acc; using pg8::Unit;
__device__ __forceinline__ u32x4 pack8(const f32x4 a, const f32x4 b) { u32x4 w; w.x = cvt_pk_bf16(a[0], a[1]); w.y = cvt_pk_bf16(a[2], a[3]); w.z = cvt_pk_bf16(b[0], b[1]); w.w = cvt_pk_bf16(b[2], b[3]); return w; }
__device__ __forceinline__ void unpack8(const u32x4 w, f32x4& a, f32x4& b) {
    a[0] = __uint_as_float(w.x << 16); a[1] = __uint_as_float(w.x & 0xffff0000u); a[2] = __uint_as_float(w.y << 16); a[3] = __uint_as_float(w.y & 0xffff0000u);
    b[0] = __uint_as_float(w.z << 16); b[1] = __uint_as_float(w.z & 0xffff0000u); b[2] = __uint_as_float(w.w << 16); b[3] = __uint_as_float(w.w & 0xffff0000u);
}
__device__ __forceinline__ float sigmoidf_fast(float v) { return __builtin_amdgcn_rcpf(1.f + __builtin_amdgcn_exp2f(-1.4426950408889634f * v)); }

struct EpiProj {
    bf16_t* Q; bf16_t* Kt; bf16_t* V; bf16_t* PIN; bf16_t* G; const float* gq; const float* gk; LAS float* P; float inv;
    __device__ __forceinline__ void operator()(const Acc& acc, const Unit& u, int ui, int wid) const {
        const int lane = lane_now(), wr = wid >> 2, wc = wid & 3, fr = lane & 15, fq = lane >> 4;
        const int pn = u.pn, c8 = wc * 32 + fq * 8;
        if (pn < 8) {
            LAS float* Pb = P + (ui & 1) * 2048;
#pragma unroll
            for (int ai = 0; ai < 2; ++ai)
#pragma unroll
                for (int m = 0; m < 4; ++m)
#pragma unroll
                    for (int bj = 0; bj < 2; ++bj) { const f32x4 a = acc[ai][bj][m][0] * inv, b = acc[ai][bj][m][1] * inv;
                        float s = (a[0] * a[0] + a[1] * a[1]) + (a[2] * a[2] + a[3] * a[3]) + (b[0] * b[0] + b[1] * b[1]) + (b[2] * b[2] + b[3] * b[3]);
                        s += __shfl_xor(s, 16); s += __shfl_xor(s, 32);
                        if (fq == 0) Pb[((ai * 128 + wr * 64 + m * 16 + fr) * 2 + bj) * 4 + wc] = s; }
            LDS_WAIT(); __builtin_amdgcn_s_barrier(); asm volatile("" ::: "memory");
            const float* g = (pn < 4) ? gq : gk; bf16_t* dst = (pn < 4) ? Q : Kt; const int h0 = (pn & 3) * 2;
            const f32x4 g0 = *(const f32x4*)(g + c8), g1 = *(const f32x4*)(g + c8 + 4);
#pragma unroll
            for (int ai = 0; ai < 2; ++ai)
#pragma unroll
                for (int m = 0; m < 4; ++m) { const int rl = ai * 128 + wr * 64 + m * 16 + fr, row = u.pm * 256 + rl, bb = row >> 12, s = row & 4095;
#pragma unroll
                    for (int bj = 0; bj < 2; ++bj) { const f32x4 p = *(const LAS f32x4*)(Pb + (rl * 2 + bj) * 4);
                        const float rstd = rsqrtf(((p[0] + p[1]) + (p[2] + p[3])) * (1.f / 128.f) + EPS);
                        const f32x4 a = acc[ai][bj][m][0] * inv * rstd * g0, b = acc[ai][bj][m][1] * inv * rstd * g1;
                        *(u32x4*)(dst + (((size_t)bb * NH + h0 + bj) * S + s) * HD + c8) = pack8(a, b); } }
        } else if (pn < 12) {
            const int h0 = (pn - 8) * 2;
#pragma unroll
            for (int ai = 0; ai < 2; ++ai)
#pragma unroll
                for (int m = 0; m < 4; ++m) { const int row = u.pm * 256 + ai * 128 + wr * 64 + m * 16 + fr, bb = row >> 12, s = row & 4095;
#pragma unroll
                    for (int bj = 0; bj < 2; ++bj) *(u32x4*)(V + (((size_t)bb * NH + h0 + bj) * S + s) * HD + c8) = pack8(acc[ai][bj][m][0] * inv, acc[ai][bj][m][1] * inv); }
        } else if (pn < 16) {
#pragma unroll
            for (int ai = 0; ai < 2; ++ai)
#pragma unroll
                for (int m = 0; m < 4; ++m) { const int row = u.pm * 256 + ai * 128 + wr * 64 + m * 16 + fr;
#pragma unroll
                    for (int bj = 0; bj < 2; ++bj) *(u32x4*)(PIN + (size_t)row * PW + (pn - 12) * 256 + bj * 128 + c8) = pack8(acc[ai][bj][m][0] * inv, acc[ai][bj][m][1] * inv); }
        } else {
#pragma unroll
            for (int ai = 0; ai < 2; ++ai)
#pragma unroll
                for (int m = 0; m < 4; ++m) { const int row = u.pm * 256 + ai * 128 + wr * 64 + m * 16 + fr;
#pragma unroll
                    for (int bj = 0; bj < 2; ++bj) { f32x4 a = acc[ai][bj][m][0] * inv, b = acc[ai][bj][m][1] * inv;
#pragma unroll
                        for (int e = 0; e < 4; ++e) { a[e] = sigmoidf_fast(a[e]); b[e] = sigmoidf_fast(b[e]); }
                        *(u32x4*)(G + (size_t)row * 4096 + (pn - 16) * 256 + bj * 128 + c8) = pack8(a, b); } }
        }
    }
};
struct EpiGate {
    bf16_t* G; float inv;
    __device__ __forceinline__ void operator()(const Acc& acc, const Unit& u, int ui, int wid) const {
        const int lane = lane_now(), wr = wid >> 2, wc = wid & 3, fr = lane & 15, fq = lane >> 4;
        const int c8 = wc * 32 + fq * 8;
#pragma unroll
        for (int ai = 0; ai < 2; ++ai)
#pragma unroll
            for (int m = 0; m < 4; ++m) { const int row = u.pm * 256 + ai * 128 + wr * 64 + m * 16 + fr;
#pragma unroll
                for (int bj = 0; bj < 2; ++bj) { f32x4 a = acc[ai][bj][m][0] * inv, b = acc[ai][bj][m][1] * inv;
#pragma unroll
                    for (int e = 0; e < 4; ++e) { a[e] = sigmoidf_fast(a[e]); b[e] = sigmoidf_fast(b[e]); }
                    *(u32x4*)(G + (size_t)row * 4096 + u.pn * 256 + bj * 128 + c8) = pack8(a, b); } }
    }
};
struct EpiPool2 {
    bf16_t* O; const float* scale;
    __device__ __forceinline__ void operator()(const Acc& acc, const Unit& u, int ui, int wid) const {
        const int lane = lane_now(), wr = wid >> 2, wc = wid & 3, fr = lane & 15, fq = lane >> 4;
        const int c8 = wc * 32 + fq * 8;
#pragma unroll
        for (int bj = 0; bj < 2; ++bj) { const int col = u.pn * 256 + bj * 128 + c8; const f32x4 s0 = *(const f32x4*)(scale + col), s1 = *(const f32x4*)(scale + col + 4);
#pragma unroll
            for (int ai = 0; ai < 2; ++ai)
#pragma unroll
                for (int m = 0; m < 4; ++m) { const int row = u.pm * 256 + ai * 128 + wr * 64 + m * 16 + fr;
                    *(u32x4*)(O + (size_t)row * PW + col) = pack8(acc[ai][bj][m][0] * s0, acc[ai][bj][m][1] * s1); } }
    }
};
template <int AUX>
struct EpiBranch {
    bf16_t* TMP; bf16_t* MERGED; const bf16_t* G; float inv;
    __device__ __forceinline__ void operator()(const Acc& acc, const Unit& u, int ui, int wid) const {
        const int lane = lane_now(), wr = wid >> 2, wc = wid & 3, fr = lane & 15, fq = lane >> 4;
        const int c8 = wc * 32 + fq * 8;
#pragma unroll
        for (int ai = 0; ai < 2; ++ai)
#pragma unroll
            for (int m = 0; m < 4; ++m) { const int row = u.pm * 256 + ai * 128 + wr * 64 + m * 16 + fr;
#pragma unroll
                for (int bj = 0; bj < 2; ++bj) { const int col = u.pn * 256 + bj * 128 + c8;
                    f32x4 ga, gb; unpack8(*(const u32x4*)(G + (size_t)row * 4096 + AUX * 2048 + col), ga, gb);
                    f32x4 a = acc[ai][bj][m][0] * inv * ga, b = acc[ai][bj][m][1] * inv * gb;
                    if (AUX == 0) { *(u32x4*)(TMP + (size_t)row * DM + col) = pack8(a, b); }
                    else { f32x4 ta, tb; unpack8(*(const u32x4*)(TMP + (size_t)row * DM + col), ta, tb); *(u32x4*)(MERGED + (size_t)row * DM + col) = pack8(a + ta, b + tb); } } }
    }
};
struct EpiOut {
    const float* x; bf16_t* XG; float* SSQ;
    __device__ __forceinline__ void operator()(const Acc& acc, const Unit& u, int ui, int wid) const {
        const int lane = lane_now(), wr = wid >> 2, wc = wid & 3, fr = lane & 15, fq = lane >> 4;
        const int c8 = wc * 32 + fq * 8;
#pragma unroll
        for (int ai = 0; ai < 2; ++ai)
#pragma unroll
            for (int m = 0; m < 4; ++m) { const int row = u.pm * 256 + ai * 128 + wr * 64 + m * 16 + fr; float ss = 0.f;
#pragma unroll
                for (int bj = 0; bj < 2; ++bj) { const size_t off = (size_t)row * DM + u.pn * 256 + bj * 128 + c8;
                    const f32x4 a = acc[ai][bj][m][0] + *(const f32x4*)(x + off), b = acc[ai][bj][m][1] + *(const f32x4*)(x + off + 4);
                    ss += (a[0] * a[0] + a[1] * a[1]) + (a[2] * a[2] + a[3] * a[3]) + (b[0] * b[0] + b[1] * b[1]) + (b[2] * b[2] + b[3] * b[3]);
                    *(u32x4*)(XG + off) = pack8(a, b); }
                ss += __shfl_xor(ss, 16); ss += __shfl_xor(ss, 32);
                if (fq == 0) SSQ[(size_t)row * 32 + u.pn * 4 + wc] = ss; }
    }
};
struct EpiBf16 {
    bf16_t* O; int ldc;
    __device__ __forceinline__ void operator()(const Acc& acc, const Unit& u, int ui, int wid) const {
        const int lane = lane_now(), wr = wid >> 2, wc = wid & 3, fr = lane & 15, fq = lane >> 4;
        const int c8 = wc * 32 + fq * 8;
#pragma unroll
        for (int ai = 0; ai < 2; ++ai)
#pragma unroll
            for (int m = 0; m < 4; ++m) { const int row = u.pm * 256 + ai * 128 + wr * 64 + m * 16 + fr;
#pragma unroll
                for (int bj = 0; bj < 2; ++bj) *(u32x4*)(O + (size_t)row * ldc + u.pn * 256 + bj * 128 + c8) = pack8(acc[ai][bj][m][0], acc[ai][bj][m][1]); }
    }
};

#define XB_TMO      128
#define XB_XCNT(j)  (256  + 64 * (j))
#define XB_XSUB(j)  (1280 + 64 * (j))
#define XB_XGEN(j)  (2304 + 64 * (j))
#define XB_TOP      3328
#define XB_TOPGEN   3392
#define XCD_BAR_WORDS 3456
#define XB_SPIN_CAP (1u << 18)
__device__ __forceinline__ unsigned xb_ld(unsigned* p)              { return __hip_atomic_load(p, __ATOMIC_RELAXED, __HIP_MEMORY_SCOPE_AGENT); }
__device__ __forceinline__ unsigned xb_add(unsigned* p, unsigned v) { return __hip_atomic_fetch_add(p, v, __ATOMIC_RELAXED, __HIP_MEMORY_SCOPE_AGENT); }
__device__ __forceinline__ unsigned xb_xcc_id() { return (unsigned)__builtin_amdgcn_s_getreg((3 << 11) | 20) & 0xFu; }
#define XB_SPIN(cond, bar) do { unsigned _sp = 0; while (cond) { __builtin_amdgcn_s_sleep(1); \
    if ((++_sp & 255u) == 0u) { if (xb_ld(&(bar)[XB_TMO])) break; if (_sp > XB_SPIN_CAP) { atomicAdd(&(bar)[XB_TMO], 1u); break; } } } } while (0)
struct XcdBarrier { unsigned* bar; unsigned x; volatile LAS unsigned* st; };
__device__ __forceinline__ XcdBarrier xcd_barrier_post(unsigned* bar, volatile LAS unsigned* st) {
    XcdBarrier b; b.bar = bar; b.x = xb_xcc_id(); b.st = st;
    if (threadIdx.x == 0) (void)xb_add(&bar[XB_XCNT(b.x)], 1u);
    return b;
}
__device__ __forceinline__ void xcd_barrier_complete(unsigned* bar, unsigned x, unsigned& nloc, unsigned& nx) {
    const unsigned G = gridDim.x * gridDim.y * gridDim.z;
    unsigned sum, cnt, mine, sp = 0u;
    for (;;) {
        sum = 0u; cnt = 0u; mine = 0u;
#pragma unroll
        for (unsigned j = 0; j < 16; ++j) { const unsigned c = xb_ld(&bar[XB_XCNT(j)]); sum += c; cnt += (c > 0u) ? 1u : 0u; mine = (j == x) ? c : mine; }
        if (sum == G) break;
        __builtin_amdgcn_s_sleep(1);
        if ((++sp & 255u) == 0u) { if (xb_ld(&bar[XB_TMO])) break; if (sp > XB_SPIN_CAP) { atomicAdd(&bar[XB_TMO], 1u); break; } }
    }
    nloc = mine > 0u ? mine : 1u; nx = cnt > 0u ? cnt : 1u;
}
__device__ __forceinline__ void xcd_barrier(const XcdBarrier& b) {
    asm volatile("s_waitcnt vmcnt(0)" ::: "memory");
    __syncthreads();
    if (threadIdx.x == 0) {
        unsigned* bar = b.bar;
        __builtin_amdgcn_s_waitcnt(0);
        unsigned nloc = b.st[0], nx = b.st[1];
        if (nloc == 0u) { xcd_barrier_complete(bar, b.x, nloc, nx); b.st[0] = nloc; b.st[1] = nx; }
        const unsigned old = xb_add(&bar[XB_XSUB(b.x)], 1u);
        const unsigned gen = old / nloc;
        if (old + 1u == (gen + 1u) * nloc) {
            __builtin_amdgcn_fence(__ATOMIC_RELEASE, "agent");
            asm volatile("s_waitcnt vmcnt(0)" ::: "memory");
            const unsigned og = xb_add(&bar[XB_TOP], 1u);
            const unsigned tg = og / nx;
            if (og + 1u == (tg + 1u) * nx) xb_add(&bar[XB_TOPGEN], 1u);
            else XB_SPIN(xb_ld(&bar[XB_TOPGEN]) == tg, bar);
            __builtin_amdgcn_fence(__ATOMIC_ACQUIRE, "agent");
            xb_add(&bar[XB_XGEN(b.x)], 1u);
            asm volatile("s_waitcnt vmcnt(0)" ::: "memory");
        } else {
            XB_SPIN(xb_ld(&bar[XB_XGEN(b.x)]) == gen, bar);
            __builtin_amdgcn_fence(__ATOMIC_ACQUIRE, "agent");
            asm volatile("s_waitcnt vmcnt(0)" ::: "memory");
        }
    }
    __syncthreads();
}

__device__ __forceinline__ unsigned pk2(float lo, float hi) { return (unsigned)f2bf(lo) | ((unsigned)f2bf(hi) << 16); }
__device__ __forceinline__ void p0_transpose_item(const float* W, int K, int N, bf16_t* WT, int row0, int src_col0, int k0, LAS float* scr, int lane, const float* kscale = nullptr) {
#pragma unroll 8
    for (int i = 0; i < 32; ++i) { const int kk = 2 * i + (lane >> 5); scr[kk * 33 + (lane & 31)] = W[(size_t)(k0 + kk) * N + src_col0 + (lane & 31)] * (kscale ? kscale[k0 + kk] : 1.f); }
    LDS_WAIT(); asm volatile("" ::: "memory");
    const int c = lane & 7;
#pragma unroll
    for (int j = 0; j < 4; ++j) { const int n = (lane >> 3) + 8 * j; const LAS float* s = scr + (8 * c) * 33 + n;
        u32x4 o; o.x = pk2(s[0 * 33], s[1 * 33]); o.y = pk2(s[2 * 33], s[3 * 33]); o.z = pk2(s[4 * 33], s[5 * 33]); o.w = pk2(s[6 * 33], s[7 * 33]);
        *(u32x4*)(WT + (size_t)(row0 + n) * K + k0 + 8 * c) = o; }
    LDS_WAIT(); asm volatile("" ::: "memory");
}


namespace att {
typedef short s16x4 __attribute__((ext_vector_type(4)));
typedef float f32x16 __attribute__((ext_vector_type(16)));
constexpr int D = 128, NW = 8, QBLK = 32, KVBLK = 64, QB = NW * QBLK;
constexpr int SHM_V = KVBLK * D * 2, SHM_K = KVBLK * D * 2;
constexpr int LDS_WS = 2 * SHM_V + 2 * SHM_K, LDS_CB = LDS_WS + NW * 64 * 4, LDS_ATT_BYTES = LDS_CB + 2 * 64 * 4;
constexpr float THR = 8.f;
constexpr float O8_SCALE = 32.f;
constexpr int OSTR = FW;
#define KSWZ(row, colB) ((row) * 256 + ((colB) ^ (((row) & 7) << 4)))
#define SBAR() __builtin_amdgcn_sched_barrier(0)
__device__ __forceinline__ int v_st(int k, int c) { const int kk = (k & ~0xC) | ((k & 4) << 1) | ((k & 8) >> 1); return ((kk >> 3) * 4 + (c >> 5)) * 512 + ((kk & 7) * 32 + (c & 31)) * 2; }
__device__ __forceinline__ int v_rd_base(int lane) { return ((lane & 3) << 3) | (((lane >> 2) & 3) << 6) | (((lane >> 4) & 1) << 5) | (((lane >> 5) & 1) << 8); }
constexpr int v_rd_off(int d0, int ks, int half) { return d0 * 512 + ks * 4096 + half * 2048; }
__device__ __forceinline__ int crow(int r, int hi) { return (r & 3) + 8 * (r >> 2) + 4 * hi; }
__device__ __forceinline__ unsigned cvtpk(float lo, float hi) { unsigned r; asm volatile("s_nop 0\n\tv_cvt_pk_bf16_f32 %0, %1, %2" : "=v"(r) : "v"(lo), "v"(hi)); return r; }
__device__ __forceinline__ bf16x8 load8(const bf16_t* p) { return *reinterpret_cast<const bf16x8*>(p); }
__device__ __forceinline__ void mask_tile(f32x16& p0, f32x16& p1, int dq) {
    const float NEG = -__builtin_inff();
#pragma unroll
    for (int r = 0; r < 16; ++r) { const int c = (r & 3) + 8 * (r >> 2);
        if (dq - c < 0) p0[r] = NEG;
        if (dq - c - 32 < 0) p1[r] = NEG; }
}
__device__ __forceinline__ void partialSM(f32x16& p0, f32x16& p1, float& m_reg, float& mn, float& alpha) {
    float pmax = p0[0];
#pragma unroll
    for (int r = 1; r < 16; ++r) pmax = fmaxf(pmax, p0[r]);
#pragma unroll
    for (int r = 0; r < 16; ++r) pmax = fmaxf(pmax, p1[r]);
    { auto rr = __builtin_amdgcn_permlane32_swap(__float_as_uint(pmax), __float_as_uint(pmax), false, false);
      pmax = fmaxf(__uint_as_float(rr[0]), __uint_as_float(rr[1])); }
    constexpr float C2 = 1.4426950408889634f * SCALE;
    if (__builtin_expect(__all((pmax - m_reg) * SCALE <= THR), 1)) { mn = m_reg; alpha = 1.f; }
    else { mn = fmaxf(m_reg, pmax); alpha = __builtin_amdgcn_exp2f((m_reg - mn) * C2); m_reg = mn; }
    const float mnL = -mn * C2;
#pragma unroll
    for (int r = 0; r < 16; ++r) p0[r] = fmaf(p0[r], C2, mnL);
#pragma unroll
    for (int r = 0; r < 16; ++r) p1[r] = fmaf(p1[r], C2, mnL);
#pragma unroll
    for (int r = 0; r < 16; ++r) p0[r] = __builtin_amdgcn_exp2f(p0[r]);
}
__device__ __forceinline__ void finishSM(f32x16& p0, f32x16& p1, float alpha, float& l_reg, bf16x8& pa0, bf16x8& pa1, bf16x8& pa2, bf16x8& pa3) {
#pragma unroll
    for (int r = 0; r < 16; ++r) p1[r] = __builtin_amdgcn_exp2f(p1[r]);
    float ps = 0;
#pragma unroll
    for (int r = 0; r < 16; ++r) ps += p0[r];
#pragma unroll
    for (int r = 0; r < 16; ++r) ps += p1[r];
    { auto rr = __builtin_amdgcn_permlane32_swap(__float_as_uint(ps), __float_as_uint(ps), false, false);
      ps = __uint_as_float(rr[0]) + __uint_as_float(rr[1]); }
    l_reg = l_reg * alpha + ps;
#define PK4(P, B_, OUT) do { unsigned a0 = cvtpk(P[B_+0], P[B_+1]), a1 = cvtpk(P[B_+2], P[B_+3]);                          \
        unsigned b0 = cvtpk(P[B_+4], P[B_+5]), b1 = cvtpk(P[B_+6], P[B_+7]);                                             \
        auto r0 = __builtin_amdgcn_permlane32_swap(a0, b0, false, false); auto r1 = __builtin_amdgcn_permlane32_swap(a1, b1, false, false); \
        u32x4 w = {r0[0], r1[0], r0[1], r1[1]}; OUT = *reinterpret_cast<bf16x8*>(&w); } while (0)
    PK4(p0, 0, pa0); PK4(p0, 8, pa1); PK4(p1, 0, pa2); PK4(p1, 8, pa3);
#undef PK4
}
template <int KB>
__device__ __forceinline__ void qkt(f32x16& p0, f32x16& p1, const char* K_lds, const float* CB, int r32, int hi, const bf16x8* qr, float cq) {
    const float* cb = CB + KB * 64 + 4 * hi;
#pragma unroll
    for (int g = 0; g < 4; ++g) { const f32x4 c0 = *(const f32x4*)(cb + 8 * g), c1 = *(const f32x4*)(cb + 32 + 8 * g);
#pragma unroll
        for (int e = 0; e < 4; ++e) { p0[4 * g + e] = cq - c0[e]; p1[4 * g + e] = cq - c1[e]; } }
    const char* kb[4];
#pragma unroll
    for (int dd = 0; dd < 4; ++dd) kb[dd] = K_lds + KB * SHM_K + KSWZ(r32, (dd * 16 + hi * 8) * 2);
#pragma unroll
    for (int d0 = 0; d0 < 8; ++d0) { const char* a = kb[d0 & 3] + (d0 >> 2) * 128;
        bf16x8 b0 = *reinterpret_cast<const bf16x8*>(a);
        bf16x8 b1 = *reinterpret_cast<const bf16x8*>(a + 32 * 256);
        p0 = __builtin_amdgcn_mfma_f32_32x32x16_bf16(b0, qr[d0], p0, 0, 0, 0);
        p1 = __builtin_amdgcn_mfma_f32_32x32x16_bf16(b1, qr[d0], p1, 0, 0, 0); }
}
template <int VB>
__device__ __forceinline__ void pv_tile(f32x16* o, int vb0, bf16x8 pa0, bf16x8 pa1, bf16x8 pa2, bf16x8 pa3) {
#define TRRD(dst, off) asm volatile("ds_read_b64_tr_b16 %0, %1 offset:%2" : "=&v"(dst) : "v"(vb0), "i"(off) : "memory")
#define PV_D0(d0) do { s16x4 l0, l1, l2, l3, h0, h1, h2, h3; constexpr int b_ = VB * SHM_V + v_rd_off(d0, 0, 0); \
        TRRD(l0, b_); TRRD(h0, b_ + 2048); TRRD(l1, b_ + 4096); TRRD(h1, b_ + 6144); TRRD(l2, b_ + 8192); TRRD(h2, b_ + 10240); TRRD(l3, b_ + 12288); TRRD(h3, b_ + 14336); \
        asm volatile("s_waitcnt lgkmcnt(0)" ::: "memory"); SBAR();   \
        o[d0] = __builtin_amdgcn_mfma_f32_32x32x16_bf16(pa0, (bf16x8){l0[0], l0[1], l0[2], l0[3], h0[0], h0[1], h0[2], h0[3]}, o[d0], 0, 0, 0);   \
        o[d0] = __builtin_amdgcn_mfma_f32_32x32x16_bf16(pa1, (bf16x8){l1[0], l1[1], l1[2], l1[3], h1[0], h1[1], h1[2], h1[3]}, o[d0], 0, 0, 0);   \
        o[d0] = __builtin_amdgcn_mfma_f32_32x32x16_bf16(pa2, (bf16x8){l2[0], l2[1], l2[2], l2[3], h2[0], h2[1], h2[2], h2[3]}, o[d0], 0, 0, 0);   \
        o[d0] = __builtin_amdgcn_mfma_f32_32x32x16_bf16(pa3, (bf16x8){l3[0], l3[1], l3[2], l3[3], h3[0], h3[1], h3[2], h3[3]}, o[d0], 0, 0, 0); } while (0)
    PV_D0(0); PV_D0(1); PV_D0(2); PV_D0(3);
#undef PV_D0
#undef TRRD
}
struct BlockRef { const bf16_t* Q; const bf16_t* K; const bf16_t* V; const float* C; unsigned char* O; int P0; int jlo; };
struct Seam { bf16x8 qr[8]; bf16x8 st_v0, st_v1, st_k0, st_k1; float st_c; float cq; };
#define ROW(p, k0, rr) ((p) + (size_t)((k0) + (rr)) * D + sc)
#define VMW() asm volatile("s_waitcnt vmcnt(0)" ::: "memory")
#define VMWN(n) asm volatile("s_waitcnt vmcnt(%0)" :: "i"(n) : "memory")
#define SLOAD_H(Kp, Vp, Cp, k0) do { S.st_v0 = load8(ROW(Vp, k0, sr)); S.st_v1 = load8(ROW(Vp, k0, 32 + sr));              \
                         S.st_k0 = load8(ROW(Kp, k0, sr)); S.st_k1 = load8(ROW(Kp, k0, 32 + sr)); S.st_c = (Cp)[(k0) + (tid & 63)]; } while (0)
#define SWRITE_HK(bf) do { *(bf16x8*)(K_lds + (bf) * SHM_K + kws) = S.st_k0; *(bf16x8*)(K_lds + (bf) * SHM_K + kws + 32 * 256) = S.st_k1; if (wid == 0) CB[(bf) * 64 + lane] = S.st_c; } while (0)
#define SWRITE_HV(bf) do { *(bf16x8*)(V_lds + (bf) * SHM_V + vst0) = S.st_v0; *(bf16x8*)(V_lds + (bf) * SHM_V + vst1) = S.st_v1; } while (0)
#define SWRITE_H(bf) do { SWRITE_HV(bf); SWRITE_HK(bf); } while (0)
__device__ __forceinline__ void attn_prime(const BlockRef& cur, char* lds, Seam& S, int wid) {
    const int lane = lane_now(), tid = wid * 64 + lane, r32 = lane & 31, hi = lane >> 5;
    const int sr = tid >> 4, sc = (tid & 15) * 8, kws = KSWZ(sr, sc * 2); char* K_lds = lds + 2 * SHM_V; float* CB = (float*)(lds + LDS_CB);
#pragma unroll
    for (int d0 = 0; d0 < 8; ++d0) S.qr[d0] = load8(cur.Q + (size_t)(wid * QBLK + r32) * D + d0 * 16 + hi * 8);
    S.cq = cur.C[cur.P0 + wid * QBLK + r32];
    SLOAD_H(cur.K, cur.V, cur.C, cur.jlo * KVBLK); VMW(); SWRITE_HK(0);
    __syncthreads();
}
__device__ __forceinline__ void attn_block(const BlockRef& cur, const BlockRef& nxt, char* lds, Seam& S, int wid) {
    const int lane = lane_now(), tid = wid * 64 + lane, r32 = lane & 31, hi = lane >> 5;
    const int NT = (cur.P0 + QB) / KVBLK - cur.jlo;
    const int qlo = cur.P0 + wid * QBLK, qm = qlo + r32 - 4 * hi;
    char* V_lds = lds; char* K_lds = lds + 2 * SHM_V; float* CB = (float*)(lds + LDS_CB);
    float* ws = (float*)(lds + LDS_WS) + wid * 64; float* li_l = ws, * al_l = ws + 32;
    float m_reg = -1e30f, l_reg = 0; f32x16 o[4] = {};
    const int sr = tid >> 4, sc = (tid & 15) * 8, vst0 = v_st(sr, sc), vst1 = v_st(32 + sr, sc), kws = KSWZ(sr, sc * 2);
    const int vb0 = (int)(uintptr_t)V_lds + v_rd_base(lane);
    const bf16_t* Kh = cur.K; const bf16_t* Vh = cur.V; const float* Ch = cur.C; const float cq = S.cq;
#define RESC(a) do { if (__any((a) < 1.f)) { if (hi == 0) al_l[r32] = (a); asm volatile("s_waitcnt lgkmcnt(0)" ::: "memory");              \
                     for (int d_ = 0; d_ < 4; ++d_) for (int r = 0; r < 16; ++r) o[d_][r] *= al_l[crow(r, hi)]; } } while (0)
#define KBASE(t) ((cur.jlo + (t)) * KVBLK)
#define MASKT(P0_, P1_, t) do { const int kb_ = KBASE(t); if (kb_ + KVBLK - 1 > qlo) mask_tile(P0_, P1_, qm - kb_); } while (0)
    constexpr int NQL = 9;
#define SEAM_K0() do { VMWN(NQL); SWRITE_HK(0); SBAR(); } while (0)
    f32x16 pA0, pA1, pB0, pB1; float mnA, mnB, alA, alB; bf16x8 pa0, pa1, pa2, pa3;
    SWRITE_HV(0); SBAR();
    if (NT > 1) { SLOAD_H(Kh, Vh, Ch, KBASE(1)); }
    SBAR(); qkt<0>(pA0, pA1, K_lds, CB, r32, hi, S.qr, cq);
    MASKT(pA0, pA1, 0); partialSM(pA0, pA1, m_reg, mnA, alA);
    if (NT > 1) { VMW(); SWRITE_H(1); }
    __syncthreads();
#define HALF_STEP(PX0, PX1, mnX, alX, PY0, PY1, alY, t, KB, VB, SB) do {                                                      \
        SBAR(); qkt<KB>(PX0, PX1, K_lds, CB, r32, hi, S.qr, cq);                                             \
        finishSM(PY0, PY1, alY, l_reg, pa0, pa1, pa2, pa3); SBAR();                                                           \
        if ((t) + 1 < NT) { SLOAD_H(Kh, Vh, Ch, KBASE((t) + 1)); SBAR(); }                                               \
        pv_tile<VB>(o, vb0, pa0, pa1, pa2, pa3); MASKT(PX0, PX1, (t)); partialSM(PX0, PX1, m_reg, mnX, alX);                                        \
        __syncthreads();                                                                                                      \
        if ((t) + 1 < NT) { VMW(); SWRITE_H(SB); }                                                                          \
        RESC(alX); __syncthreads(); } while (0)
    for (int t = 1; t + 1 < NT; t += 2) {
        HALF_STEP(pB0, pB1, mnB, alB, pA0, pA1, alA, t, 1, 0, 0);
        HALF_STEP(pA0, pA1, mnA, alA, pB0, pB1, alB, t + 1, 0, 1, 1);
    }
    const bool even = (NT & 1) == 0;
    if (even) { SBAR(); qkt<1>(pB0, pB1, K_lds, CB, r32, hi, S.qr, cq); SBAR(); }
    { SLOAD_H(nxt.K, nxt.V, nxt.C, nxt.jlo * KVBLK); SBAR();
#pragma unroll
      for (int d0 = 0; d0 < 8; ++d0) S.qr[d0] = load8(nxt.Q + (size_t)(wid * QBLK + r32) * D + d0 * 16 + hi * 8);
      S.cq = nxt.C[nxt.P0 + wid * QBLK + r32]; }
    SBAR();
    finishSM(pA0, pA1, alA, l_reg, pa0, pa1, pa2, pa3); SBAR();
    pv_tile<0>(o, vb0, pa0, pa1, pa2, pa3);
    if (even) { MASKT(pB0, pB1, NT - 1); partialSM(pB0, pB1, m_reg, mnB, alB); __syncthreads(); RESC(alB);
        finishSM(pB0, pB1, alB, l_reg, pa0, pa1, pa2, pa3); SBAR(); pv_tile<1>(o, vb0, pa0, pa1, pa2, pa3); }
    SBAR(); SEAM_K0();
    if (hi == 0) li_l[r32] = l_reg; asm volatile("s_waitcnt lgkmcnt(0)" ::: "memory");
    float rli[16];
#pragma unroll
    for (int r = 0; r < 16; ++r) rli[r] = __builtin_amdgcn_rcpf(li_l[crow(r, hi)]);
    unsigned char* Ow = cur.O + (size_t)(wid * QBLK) * OSTR;
#pragma unroll
    for (int r = 0; r < 16; ++r) { const int orow = crow(r, hi);
#pragma unroll
        for (int d0 = 0; d0 < 4; ++d0) { const float v = o[d0][r] * (rli[r] * O8_SCALE);
            const float vn = __shfl_xor(v, 1);
            const int p = __builtin_amdgcn_cvt_pk_fp8_f32(v, vn, 0, false);
            const int p2 = __shfl_xor(p, 2);
            if ((r32 & 3) == 0) *(unsigned*)(Ow + (size_t)orow * OSTR + d0 * 32 + r32) = ((unsigned)p & 0xffffu) | ((unsigned)p2 << 16); } }
    __syncthreads();
#undef RESC
#undef KBASE
#undef MASKT
#undef SEAM_K0
#undef HALF_STEP
}
#undef ROW
#undef VMW
#undef VMWN
#undef SLOAD_H
#undef SWRITE_HK
#undef SWRITE_HV
#undef SWRITE_H
#undef SBAR
}

typedef __bf16 bf16x2_t __attribute__((ext_vector_type(2)));

__device__ __forceinline__ float dot2bf(unsigned a, unsigned b, float c) {
    bf16x2_t av, bv; __builtin_memcpy(&av, &a, 4); __builtin_memcpy(&bv, &b, 4); return __builtin_amdgcn_fdot2_f32_bf16(av, bv, c, false); }
__device__ __forceinline__ float dot2bf_s(unsigned s_uniform, unsigned b, float c) { return dot2bf(s_uniform, b, c); }
namespace peer {
typedef float f32x16 __attribute__((ext_vector_type(16)));
__device__ __forceinline__ float fmaxs(float a, float b) { float r; asm("v_max_f32_e32 %0, %1, %2" : "=v"(r) : "v"(a), "v"(b)); return r; }
__device__ __forceinline__ float fmins(float a, float b) { float r; asm("v_min_f32_e32 %0, %1, %2" : "=v"(r) : "v"(a), "v"(b)); return r; }
#define CE(a, b) do { const float _h = fmaxs(a, b), _l = fmins(a, b); a = _h; b = _l; } while (0)
__device__ __forceinline__ void insert16(float (&L)[16], float x) {
#pragma unroll
    for (int i = 0; i < 16; ++i) { const float h = fmaxs(L[i], x); x = fmins(L[i], x); L[i] = h; }
}
__device__ __forceinline__ void sort16_desc(float (&v)[16]) {
#pragma unroll
    for (int k = 2; k <= 16; k <<= 1)
#pragma unroll
        for (int j = k >> 1; j >= 1; j >>= 1)
#pragma unroll
            for (int i = 0; i < 16; ++i) { const int l = i ^ j; if (l > i) { const bool desc = (i & k) == 0; const float hi_ = fmaxs(v[i], v[l]), lo_ = fmins(v[i], v[l]); v[i] = desc ? hi_ : lo_; v[l] = desc ? lo_ : hi_; } }
}
__device__ __forceinline__ void merge16(float (&L)[16], const float (&S)[16]) {
#pragma unroll
    for (int i = 0; i < 16; ++i) L[i] = fmaxs(L[i], S[15 - i]);
#pragma unroll
    for (int d = 8; d >= 1; d >>= 1)
#pragma unroll
        for (int i = 0; i < 16; ++i) if ((i & d) == 0) CE(L[i], L[i + d]);
}
__device__ __forceinline__ void merge_partner(float (&L)[16], const bool lo_half) {
    float B[16];
#pragma unroll
    for (int i = 0; i < 16; ++i) { auto r = __builtin_amdgcn_permlane32_swap(__float_as_uint(L[i]), __float_as_uint(L[i]), false, false);
        B[i] = __uint_as_float(lo_half ? r[1] : r[0]); }
#pragma unroll
    for (int i = 0; i < 16; ++i) L[i] = fmaxs(L[i], B[15 - i]);
#pragma unroll
    for (int d = 8; d >= 1; d >>= 1)
#pragma unroll
        for (int i = 0; i < 16; ++i) if ((i & d) == 0) CE(L[i], L[i + d]);
}
constexpr int KEYS_BYTES = 65536, SCR_OFF = 65536;
}

__device__ __forceinline__ void p0_transpose_item_fp8(const float* W, int K, int N, unsigned char* WT8, int row0, int src_col0, int k0, LAS float* scr, int lane, float sc) {
#pragma unroll 8
    for (int i = 0; i < 32; ++i) { const int kk = 2 * i + (lane >> 5); scr[kk * 33 + (lane & 31)] = W[(size_t)(k0 + kk) * N + src_col0 + (lane & 31)]; }
    LDS_WAIT(); asm volatile("" ::: "memory");
    const int c = lane & 3;
#pragma unroll
    for (int j = 0; j < 2; ++j) { const int n = (lane >> 2) + 16 * j; const LAS float* sp = scr + (16 * c) * 33 + n; u32x4 o;
#pragma unroll
        for (int q = 0; q < 4; ++q) { int p = 0; p = __builtin_amdgcn_cvt_pk_fp8_f32(sp[(4 * q) * 33] * sc, sp[(4 * q + 1) * 33] * sc, p, false); p = __builtin_amdgcn_cvt_pk_fp8_f32(sp[(4 * q + 2) * 33] * sc, sp[(4 * q + 3) * 33] * sc, p, true); o[q] = (unsigned)p; }
        *(u32x4*)(WT8 + (size_t)(row0 + n) * K + k0 + 16 * c) = o; }
    LDS_WAIT(); asm volatile("" ::: "memory");
}
constexpr float H8_SCALE = 16.f, W8_SCALE = 512.f;
constexpr size_t DO_W8 = 80 * MiB, DO_H8 = 96 * MiB;

struct Args { const float* in[17]; float* out; unsigned char* ws; int ph_lo, ph_hi; };
constexpr int N_PHASES = 11;

__global__ void __launch_bounds__(NTHR, 2) mega(Args args) {
    extern __shared__ __attribute__((aligned(16))) unsigned char lds_raw[];
    LAS unsigned char* lds = (LAS unsigned char*)lds_raw;
    volatile LAS unsigned* MISC = (volatile LAS unsigned*)(lds + MISC_OFF);
    const int wave = __builtin_amdgcn_readfirstlane((int)threadIdx.x >> 6);
    const int G = gridDim.x, bx = blockIdx.x, vcu = (G % 8 == 0) ? (bx % 8) * (G / 8) + bx / 8 : bx;
    unsigned char* ws = args.ws; char* dob = (char*)args.out;
    const float* x = args.in[0]; const float* g1 = args.in[1]; const float* w_in = args.in[2]; const float* fbias = args.in[3];
    const float* gq = args.in[4]; const float* gk = args.in[5]; const float* pgw = args.in[6]; const float* pscale = args.in[7];
    const float* wba = args.in[8]; const float* wbp = args.in[9]; const float* wout = args.in[10]; const float* g2 = args.in[11];
    const float* wq = args.in[12]; const float* sk1 = args.in[13]; const float* sk2 = args.in[14]; const float* eu = args.in[15]; const float* ev = args.in[16];
    bf16_t* WT_IN = (bf16_t*)(dob + DO_WT_IN); unsigned char* W8 = (unsigned char*)(dob + DO_W8); unsigned char* H8 = (unsigned char*)(dob + DO_H8); bf16_t* H1 = (bf16_t*)(dob + DO_H1); bf16_t* Ob = (bf16_t*)(dob + DO_O); bf16_t* POOLED = (bf16_t*)(dob + DO_POOLED); bf16_t* POOL2 = (bf16_t*)(dob + DO_POOL2);
    bf16_t* WT_PG = (bf16_t*)(ws + WS_WT_PG); bf16_t* WT_BA = (bf16_t*)(ws + WS_WT_BA); bf16_t* WT_BP = (bf16_t*)(ws + WS_WT_BP); bf16_t* WT_OUT = (bf16_t*)(ws + WS_WT_OUT); bf16_t* WT_Q = (bf16_t*)(ws + WS_WT_Q);
    bf16_t* SK = (bf16_t*)(ws + WS_SK); float* CS = (float*)(ws + WS_CS); float* LOGF = (float*)(ws + WS_LOGF); float* SSQ = (float*)(ws + WS_SSQ);
    bf16_t* Qb = (bf16_t*)(ws + WS_Q); bf16_t* Kb = (bf16_t*)(ws + WS_K); bf16_t* Vb = (bf16_t*)(ws + WS_V); bf16_t* PIN = (bf16_t*)(ws + WS_PIN); bf16_t* Gt = (bf16_t*)(ws + WS_G);
    bf16_t* EU = (bf16_t*)(ws + WS_EU); bf16_t* EV = (bf16_t*)(ws + WS_EV); bf16_t* XG = (bf16_t*)(ws + WS_XG); bf16_t* TMP = (bf16_t*)(ws + WS_TMP); bf16_t* MERGED = (bf16_t*)(ws + WS_MERGED); bf16_t* QP = (bf16_t*)(ws + WS_QP);
    for (int u = threadIdx.x; u < 128; u += NTHR) MISC[u] = 0u;
    __syncthreads();
    const int lo = args.ph_lo, hi = args.ph_hi;
    XcdBarrier bar; bar.bar = (unsigned*)(ws + WS_CTL) + CW_BAR + lo * XCD_BAR_WORDS; bar.x = 0; bar.st = MISC + 8;
    if (hi - lo > 1) bar = xcd_barrier_post(bar.bar, MISC + 8);
#define IN(k) (lo <= (k) && (k) < hi)
#define SEAM(k) do { if (IN(k) && IN((k) + 1)) xcd_barrier(bar); } while (0)
    const int gw = vcu * NWAVES + wave, NGW = G * NWAVES;

    if (IN(0)) {
        const int lane = lane_now(), tid = wave * 64 + lane;
        LAS float* scr = (LAS float*)(lds + RING_OFF + wave * 16384);
        constexpr int I_IN = (DM / 64) * (NPROJ / 32),     I_BA = (FW / 64) * (DM / 32), I_OUT = (DM / 64) * (DM / 32), I_PG = 4 * (256 / 64) * (256 / 32);
        constexpr int NITEMS = I_IN + 2 * I_BA + 2 * I_OUT + I_PG;
        for (int it = gw; it < NITEMS; it += NGW) {
            int r = it;
            if (r < I_IN) { const int nblk = NPROJ / 32, kb = r / nblk, nb = r % nblk, n0 = nb * 32;
                p0_transpose_item_fp8(w_in, DM, INC, W8, n0, n0 + (n0 >= 3072 ? 8 : 0), kb * 64, scr, lane, W8_SCALE);
                continue; } r -= I_IN;
            if (r < I_BA) { const int nblk = DM / 32, kb = r / nblk, nb = r % nblk; p0_transpose_item_fp8(wba, FW, DM, (unsigned char*)WT_BA, nb * 32, nb * 32, kb * 64, scr, lane, W8_SCALE); continue; } r -= I_BA;
            if (r < I_BA) { const int nblk = DM / 32, kb = r / nblk, nb = r % nblk; p0_transpose_item(wbp, PW, DM, WT_BP, nb * 32, nb * 32, kb * 64, scr, lane); continue; } r -= I_BA;
            if (r < I_OUT) { const int nblk = DM / 32, kb = r / nblk, nb = r % nblk; p0_transpose_item(wout, DM, DM, WT_OUT, nb * 32, nb * 32, kb * 64, scr, lane); continue; } r -= I_OUT;
            if (r < I_OUT) { const int nblk = DM / 32, kb = r / nblk, nb = r % nblk; p0_transpose_item(wq, DM, DM, WT_Q, nb * 32, nb * 32, kb * 64, scr, lane, g2); continue; } r -= I_OUT;
            { const int g = r / 32, rr = r % 32, kb = rr / 8, nb = rr % 8; p0_transpose_item(pgw + (size_t)g * 65536, 256, 256, WT_PG, g * 256 + nb * 32, nb * 32, kb * 64, scr, lane); }
        }
        for (int i = gw * 64 + lane; i < 2048 * 128 / 4; i += NGW * 64) { const int e = i * 4, d = e & 127, n = e >> 7, key = n & 127, f = (n >> 7) & 1, h = n >> 8;
            const f32x4 v = *(const f32x4*)((f ? sk2 : sk1) + ((size_t)h * 128 + key) * 128 + d); u32x2 o; o.x = pk2(v[0], v[1]); o.y = pk2(v[2], v[3]); *(u32x2*)(SK + e) = o; }
        { unsigned char* E8 = (unsigned char*)(ws + WS_EU); float* ESC = (float*)(ws + WS_EV);
          for (int r0 = gw; r0 < 2 * NEXP; r0 += 2 * NGW) {
            f32x4 v[2][8];
#pragma unroll
            for (int u = 0; u < 2; ++u) { const int r = r0 + u * NGW; const float* src = (r < NEXP ? eu : ev - (size_t)NEXP * DM) + (size_t)r * DM;
#pragma unroll
                for (int i = 0; i < 2; ++i)
#pragma unroll
                    for (int c = 0; c < 4; ++c) v[u][i * 4 + c] = *(const f32x4*)(src + 1024 * i + 16 * lane + 4 * c); }
#pragma unroll
            for (int u = 0; u < 2; ++u) { const int r = r0 + u * NGW; float am = 0.f;
                if (r < NEXP) {
#pragma unroll
                    for (int i = 0; i < 2; ++i)
#pragma unroll
                        for (int c = 0; c < 4; ++c) v[u][i * 4 + c] = v[u][i * 4 + c] * *(const f32x4*)(g2 + 1024 * i + 16 * lane + 4 * c); }
#pragma unroll
                for (int q = 0; q < 8; ++q) am = fmaxf(am, fmaxf(fmaxf(fabsf(v[u][q][0]), fabsf(v[u][q][1])), fmaxf(fabsf(v[u][q][2]), fabsf(v[u][q][3]))));
#pragma unroll
                for (int o = 1; o < 64; o <<= 1) am = fmaxf(am, __shfl_xor(am, o));
                int ex = (int)((__float_as_uint(am) >> 23) & 0xffu); if (ex < 16) ex = 134;
                const float sc = __uint_as_float((unsigned)(261 - ex) << 23), inv = __uint_as_float((unsigned)(ex - 7) << 23);
#pragma unroll
                for (int i = 0; i < 2; ++i) { u32x4 w;
#pragma unroll
                    for (int c = 0; c < 4; ++c) { const f32x4 t = v[u][i * 4 + c] * sc; int p = 0;
                        p = __builtin_amdgcn_cvt_pk_fp8_f32(t[0], t[1], p, false); p = __builtin_amdgcn_cvt_pk_fp8_f32(t[2], t[3], p, true); w[c] = (unsigned)p; }
                    *(u32x4*)(E8 + (size_t)(r >= NEXP) * NEXP * DM + ((size_t)(8 * i + (lane >> 3)) * NEXP + (r & (NEXP - 1))) * 128 + 16 * (lane & 7)) = w; }
                if (lane == 0) ESC[r] = inv; }
          } }
        __syncthreads();
        LAS f32x4* WfL = (LAS f32x4*)(lds + RING_OFF);
        for (int i = tid; i < 4096; i += NTHR) { const int l = i & 63, half = (i >> 6) & 1, e = (i >> 7) & 3, j = i >> 9, k = 256 * j + 4 * l + e;
            WfL[i] = *(const f32x4*)(w_in + (size_t)k * INC + 3072 + 4 * half); }
        __syncthreads();
        f32x4 gv[8];
#pragma unroll
        for (int j = 0; j < 8; ++j) gv[j] = ((const f32x4*)g1)[64 * j + lane];
        for (int row0 = gw; row0 < T; row0 += 2 * NGW) {
            asm volatile("" ::: "memory");
            f32x4 v[2][8];
#pragma unroll
            for (int u = 0; u < 2; ++u) { const f32x4* xr = (const f32x4*)(x + (size_t)(row0 + u * NGW) * DM) + lane;
#pragma unroll
                for (int j = 0; j < 8; ++j) v[u][j] = xr[64 * j]; }
#pragma unroll
            for (int u = 0; u < 2; ++u) { const int row = row0 + u * NGW; float ss = 0.f;
#pragma unroll
                for (int j = 0; j < 8; ++j) ss += (v[u][j][0] * v[u][j][0] + v[u][j][1] * v[u][j][1]) + (v[u][j][2] * v[u][j][2] + v[u][j][3] * v[u][j][3]);
                const float rstd = rsqrtf(wave_sum(ss) * (1.f / DM) + EPS);
                f32x4 a0 = {0.f, 0.f, 0.f, 0.f}, a1 = {0.f, 0.f, 0.f, 0.f};
#pragma unroll
                for (int j = 0; j < 8; ++j) { const f32x4 hv = v[u][j] * rstd * gv[j];
                    { int p8 = 0; p8 = __builtin_amdgcn_cvt_pk_fp8_f32(hv[0] * H8_SCALE, hv[1] * H8_SCALE, p8, false); p8 = __builtin_amdgcn_cvt_pk_fp8_f32(hv[2] * H8_SCALE, hv[3] * H8_SCALE, p8, true);
                      ((unsigned*)(H8 + (size_t)row * DM))[64 * j + lane] = (unsigned)p8; }
#pragma unroll
                    for (int e = 0; e < 4; ++e) { a0 += WfL[((j * 4 + e) * 2 + 0) * 64 + lane] * hv[e]; a1 += WfL[((j * 4 + e) * 2 + 1) * 64 + lane] * hv[e]; } }
                float z = 0.f;
#pragma unroll
                for (int c = 0; c < 8; ++c) { const float t = wave_sum(c < 4 ? a0[c & 3] : a1[c & 3]); if (lane == c) z = t; }
                if (lane < 8) { z += fbias[lane]; LOGF[(size_t)row * 8 + lane] = fminf(z, 0.f) - log1pf(expf(-fabsf(z))); } }
        }
    }
    SEAM(0);
    if (IN(1)) {
        if (bx < 32) {   const int lane = lane_now(), tid = wave * 64 + lane;
            LAS float* wsum = (LAS float*)(lds + EPI_OFF);
            const int b = bx >> 3, h = bx & 7; float v[8]; float run = 0.f;
#pragma unroll
            for (int i = 0; i < 8; ++i) { run += LOGF[((size_t)(b * S + tid * 8 + i)) * 8 + h]; v[i] = run; }
            float inc = run;
#pragma unroll
            for (int o = 1; o < 64; o <<= 1) { const float t = __shfl_up(inc, o); if (lane >= o) inc += t; }
            if (lane == 63) wsum[wave] = inc;
            __syncthreads();
            float base = inc - run;
            for (int w = 0; w < wave; ++w) base += wsum[w];
#pragma unroll
            for (int i = 0; i < 8; ++i) CS[(size_t)bx * S + tid * 8 + i] = (base + v[i]) * INV_SCALE;
            __syncthreads();
        }
        { pg8::SchedStd Sc{(const char*)H8, (const char*)W8, (size_t)256 * DM, (size_t)256 * DM, 0, T / 256, NPROJ / 256, (T / 256) * (NPROJ / 256), G, bx};
          EpiProj E{Qb, Kb, Vb, PIN, Gt, gq, gk, (LAS float*)(lds + EPI_OFF), 1.f / (H8_SCALE * W8_SCALE)};
          pg8::gemm_phase<true>(lds + RING_OFF, wave, DM / 2, DM / 2, DM / 2, Sc, E); }
    }
    SEAM(1);
    if (IN(2)) {
        const int lane = lane_now(), sub = lane >> 4, l16 = lane & 15;
#define POOL_BODY(W) do { \
            const int s0 = rb * 8, sq = s0 & (S - 1); const bf16_t* pp = PIN + (size_t)s0 * PW + ch; \
            f32x4 Pa[W + 7], Pb[W + 7]; \
            _Pragma("unroll") for (int r = 0; r < W + 7; ++r) { const int rel = r - (W - 1); \
                if (sq + rel >= 0) unpack8(*(const u32x4*)(pp + (long)rel * PW), Pa[r], Pb[r]); else { Pa[r] = (f32x4){0.f, 0.f, 0.f, 0.f}; Pb[r] = Pa[r]; } } \
            f32x4 Sa = {0.f, 0.f, 0.f, 0.f}, Sb = Sa; \
            _Pragma("unroll") for (int r = 0; r < W - 1; ++r) { Sa += Pa[r]; Sb += Pb[r]; } \
            _Pragma("unroll") for (int r = 0; r < 8; ++r) { Sa += Pa[r + W - 1]; Sb += Pb[r + W - 1]; \
                const int cnt = (sq + r + 1 < W) ? sq + r + 1 : W; const float inv = 1.f / (float)cnt; \
                *(u32x4*)(POOLED + (size_t)(s0 + r) * PW + ch) = pack8(Sa * inv - Pa[r + W - 1], Sb * inv - Pb[r + W - 1]); \
                Sa -= Pa[r]; Sb -= Pb[r]; } } while (0)
        for (int itp = gw; itp < 4 * (T / 16); itp += NGW) {
            const int g = itp & 3, rb = (itp >> 2) * 2 + (lane >> 5), ch = g * 256 + (lane & 31) * 8;
            if (g == 0) POOL_BODY(2); else if (g == 1) POOL_BODY(4); else if (g == 2) POOL_BODY(8); else POOL_BODY(16);
        }
#undef POOL_BODY
    }
    SEAM(2);
    if (IN(3)) {
        float bq;
        { const int lane = lane_now(); float a = fmaxf(fabsf(gq[lane]), fabsf(gq[64 + lane])), b2 = fmaxf(fabsf(gk[lane]), fabsf(gk[64 + lane]));
#pragma unroll
          for (int o = 1; o < 64; o <<= 1) { a = fmaxf(a, __shfl_xor(a, o)); b2 = fmaxf(b2, __shfl_xor(b2, o)); }
          bq = 128.f * SCALE * a * b2 + EPS; }
        const float cmargin = (30.f + 2.f * bq) * INV_SCALE;
#define ATT_JLO(Chp, qb) ({ const int lane_ = lane_now(), nte_ = 4 * ((qb) + 1); const float thr_ = (Chp)[(qb) * 256] + cmargin; \
            const float v_ = (lane_ < nte_) ? (Chp)[64 * lane_ + 63] : -3.0e38f; const int n_ = (int)__builtin_popcountll(__ballot(v_ > thr_)); \
            __builtin_amdgcn_readfirstlane(n_ < nte_ - 4 ? n_ : nte_ - 4); })
        for (int L = vcu; L < Bn * NH * 8; L += G) {
            const int bh = L >> 3, xq = L & 7, b = bh >> 3, h = bh & 7;
            const bf16_t* Kh = Kb + (size_t)bh * S * HD; const bf16_t* Vh = Vb + (size_t)bh * S * HD; const float* Ch = CS + (size_t)bh * S;
            const int j0 = ATT_JLO(Ch, xq), j1 = ATT_JLO(Ch, 15 - xq);
            att::BlockRef r0{Qb + ((size_t)bh * S + xq * 256) * HD, Kh, Vh, Ch, (unsigned char*)Ob + ((size_t)(b * S + xq * 256)) * FW + h * HD, xq * 256, j0};
            att::BlockRef r1{Qb + ((size_t)bh * S + (15 - xq) * 256) * HD, Kh, Vh, Ch, (unsigned char*)Ob + ((size_t)(b * S + (15 - xq) * 256)) * FW + h * HD, (15 - xq) * 256, j1};
            att::Seam Sm;
            att::attn_prime(r0, (char*)lds_raw, Sm, wave);
            att::attn_block(r0, r1, (char*)lds_raw, Sm, wave);
            att::attn_block(r1, r1, (char*)lds_raw, Sm, wave);
        }
#undef ATT_JLO
        VM_WAIT(); __syncthreads();
        pg8::SchedStd Sc{(const char*)POOLED, (const char*)WT_PG, (size_t)256 * PW * 2, (size_t)256 * 256 * 2, (size_t)256 * 2, T / 256, PW / 256, (T / 256) * (PW / 256), G, bx};
        EpiPool2 E{POOL2, pscale};
        pg8::gemm_phase(lds + RING_OFF, wave, 256, PW, 256, Sc, E);
    }
    SEAM(3);
    if (IN(4)) {
        { pg8::SchedStd Sc{(const char*)Ob, (const char*)WT_BA, (size_t)256 * FW, (size_t)256 * FW, 0, T / 256, DM / 256, (T / 256) * (DM / 256), G, bx};
          EpiBranch<0> E{TMP, MERGED, Gt, 1.f / (att::O8_SCALE * W8_SCALE)};
          pg8::gemm_phase<true>(lds + RING_OFF, wave, FW / 2, FW / 2, FW / 2, Sc, E); }
        { pg8::SchedStd Sc{(const char*)POOL2, (const char*)WT_BP, (size_t)256 * FW * 2, (size_t)256 * FW * 2, 0, T / 256, DM / 256, (T / 256) * (DM / 256), G, bx};
          EpiBranch<1> E{TMP, MERGED, Gt, 1.f};
          pg8::gemm_phase(lds + RING_OFF, wave, FW, FW, FW, Sc, E); }
    }
    SEAM(4);
    if (IN(5)) {
        pg8::SchedStd Sc{(const char*)MERGED, (const char*)WT_OUT, (size_t)256 * DM * 2, (size_t)256 * DM * 2, 0, T / 256, DM / 256, (T / 256) * (DM / 256), G, bx};
        EpiOut E{x, XG, SSQ};
        pg8::gemm_phase(lds + RING_OFF, wave, DM, DM, DM, Sc, E);
    }
    SEAM(5);
    if (IN(6)) {
        pg8::SchedStd Sc{(const char*)XG, (const char*)WT_Q, (size_t)256 * DM * 2, (size_t)256 * DM * 2, 0, T / 256, DM / 256, (T / 256) * (DM / 256), G, bx};
        EpiBf16 E{QP, DM};
        pg8::gemm_phase(lds + RING_OFF, wave, DM, DM, DM, Sc, E);
    }
    SEAM(6);

    if (IN(7)) {
        const int lane = lane_now(), tid = wave * 64 + lane, r32 = lane & 31, hi = lane >> 5, h = vcu & 7;
#pragma unroll
        for (int i = 0; i < 8; ++i) { const int idx = tid + 512 * i, le = idx & 63, ks = (idx >> 6) & 7, tile = (idx >> 9) & 3, f = idx >> 11;
            const u32x4 v = *(const u32x4*)(SK + ((size_t)(h * 256 + f * 128 + 32 * tile + (le & 31)) * 128 + 16 * ks + 8 * (le >> 5)));
            *(LAS u32x4*)(lds + idx * 16) = v; }
        __syncthreads();
        LAS unsigned* scr = (LAS unsigned*)(lds + peer::SCR_OFF + wave * 8192) + lane;
        const unsigned nh4 = (unsigned)(1 - hi) << 2; const float NEGINF = -__builtin_inff();
        int* IDX = (int*)(ws + WS_IDX); float* GATE = (float*)(ws + WS_GATE);
        for (int tl = vcu >> 3; tl < T / 256; tl += G >> 3) {
            const int tok = tl * 256 + wave * 32 + r32;
            bf16x8 qf[2][8];
#pragma unroll
            for (int f = 0; f < 2; ++f)
#pragma unroll
                for (int ks = 0; ks < 8; ++ks) qf[f][ks] = *(const bf16x8*)(QP + (size_t)tok * DM + h * 256 + f * 128 + 16 * ks + 8 * hi);
            float tot = 0.f;
#pragma unroll
            for (int i = 0; i < 8; ++i) { const f32x4 v = *(const f32x4*)(SSQ + (size_t)tok * 32 + 4 * i); tot += (v[0] + v[1]) + (v[2] + v[3]); }
            const float rstd = rsqrtf(tot * (1.f / DM) + EPS);
            float KL[2][16];
#pragma unroll
            for (int f = 0; f < 2; ++f) {
                float L[16];
#pragma unroll
                for (int i = 0; i < 16; ++i) L[i] = NEGINF;
#pragma unroll
                for (int tile = 0; tile < 4; ++tile) {
                    peer::f32x16 acc = {};
#pragma unroll
                    for (int ks = 0; ks < 8; ++ks) acc = __builtin_amdgcn_mfma_f32_32x32x16_bf16(*(const LAS bf16x8*)(lds + (((f * 4 + tile) * 8 + ks) * 64 + lane) * 16), qf[f][ks], acc, 0, 0, 0);
                    float Sk[16];
#pragma unroll
                    for (int r = 0; r < 16; ++r) { const unsigned cp = (unsigned)(127 - 32 * tile - (r & 3) - 8 * (r >> 2) - 4);
                        Sk[r] = __uint_as_float(((__float_as_uint(acc[r]) & 0xffffff80u) | nh4) | cp); }
                    peer::sort16_desc(Sk);
                    if (tile == 0) {
#pragma unroll
                        for (int i = 0; i < 16; ++i) L[i] = Sk[i]; }
                    else peer::merge16(L, Sk);
                }
                peer::merge_partner(L, hi == 0);
#pragma unroll
                for (int i = 0; i < 16; ++i) KL[f][i] = L[i];
            }
            float Tt[16];
#pragma unroll
            for (int i = 0; i < 16; ++i) Tt[i] = NEGINF;
#pragma unroll
            for (int i = 0; i < 16; ++i)
#pragma unroll
                for (int j = 0; j < 16; ++j) if ((i + 1) * (j + 1) <= 16) {
                    const float sm = __uint_as_float(__float_as_uint(KL[0][i]) & 0xffffff80u) + __uint_as_float(__float_as_uint(KL[1][j]) & 0xffffff80u);
                    peer::insert16(Tt, __uint_as_float((__float_as_uint(sm) & 0xffffff00u) | (unsigned)(255 - (16 * i + j)))); }
#pragma unroll
            for (int k = 0; k < 16; ++k) { scr[k * 64] = __float_as_uint(KL[0][k]); scr[(16 + k) * 64] = __float_as_uint(KL[1][k]); }
            LDS_WAIT();
            int ex[16]; float gt[16]; float gs = 0.f;
            const float s0 = __uint_as_float(__float_as_uint(Tt[0]) & 0xffffff00u) * rstd;
#pragma unroll
            for (int r = 0; r < 16; ++r) { const unsigned tb = __float_as_uint(Tt[r]), pos = 255u - (tb & 255u), ci = pos >> 4, cj = pos & 15u;
                const unsigned a = scr[ci * 64], b = scr[(16 + cj) * 64];
                ex[r] = (int)((127u - (a & 127u)) * 128u + (127u - (b & 127u)));
                gt[r] = __expf(__uint_as_float(tb & 0xffffff00u) * rstd - s0); gs += gt[r]; }
            const float ginv = 1.f / gs;
            if (hi == 0) { int* o = IDX + (size_t)tok * 128 + h * 16;
#pragma unroll
                for (int q4 = 0; q4 < 4; ++q4) *(int4*)(o + 4 * q4) = make_int4(ex[4 * q4], ex[4 * q4 + 1], ex[4 * q4 + 2], ex[4 * q4 + 3]); }
            else { float* o = GATE + (size_t)tok * 128 + h * 16;
#pragma unroll
                for (int q4 = 0; q4 < 4; ++q4) *(f32x4*)(o + 4 * q4) = (f32x4){gt[4 * q4] * ginv, gt[4 * q4 + 1] * ginv, gt[4 * q4 + 2] * ginv, gt[4 * q4 + 3] * ginv}; }
            LDS_WAIT();
        }
    }
    SEAM(7);
    float* PA = (float*)(ws + WS_MERGED); float* HS = (float*)(ws + WS_QP);
    if (IN(8)) {
        const int lane = lane_now(), l8 = lane & 7, lg = lane >> 3, grp = bx & 7, nwv = (G >> 3) * NWAVES, wg = (bx >> 3) * NWAVES + wave;
        const int* IDX = (const int*)(ws + WS_IDX); const unsigned char* EU8 = (const unsigned char*)(ws + WS_EU);
#define P8_IDX(E, tk) do { const int* ip_ = IDX + (size_t)((tk) < T ? (tk) : T - 1) * 128 + lane; E[0] = ip_[0]; E[1] = ip_[64]; } while (0)
#define P8_ROWS(R, E, XA, XB, tk) do { _Pragma("unroll") for (int i = 0; i < 16; ++i) { const int e_ = __shfl(E[i >> 3], ((8 * i) & 63) + lg); R[i] = *(const u32x4*)(EU8 + (unsigned)(e_ * 128 + coffT)); } \
            const bf16_t* xp_ = XG + (size_t)((tk) < T ? (tk) : T - 1) * DM + coff; XA = *(const u32x4*)xp_; XB = *(const u32x4*)(xp_ + 8); } while (0)
#define P8_DPP(x, ctrl) __uint_as_float(__builtin_amdgcn_update_dpp(0u, __float_as_uint(x), ctrl, 0xf, 0xf, false))
#define P8_COMP(R, XA, XB, tk) do { f32x2 xf[8]; \
            _Pragma("unroll") for (int d = 0; d < 4; ++d) { xf[d] = (f32x2){__uint_as_float(XA[d] << 16), __uint_as_float(XA[d] & 0xffff0000u)}; xf[4 + d] = (f32x2){__uint_as_float(XB[d] << 16), __uint_as_float(XB[d] & 0xffff0000u)}; } \
            float sd[16]; \
            _Pragma("unroll") for (int i = 0; i < 16; ++i) { f32x2 a2 = {0.f, 0.f}; \
                _Pragma("unroll") for (int d = 0; d < 4; ++d) { a2 += __builtin_amdgcn_cvt_pk_f32_fp8((int)R[i][d], false) * xf[2 * d]; a2 += __builtin_amdgcn_cvt_pk_f32_fp8((int)R[i][d], true) * xf[2 * d + 1]; } \
                sd[i] = a2[0] + a2[1]; } \
              \
            float s8[8], s4[4], s2_[2]; \
            _Pragma("unroll") for (int k = 0; k < 8; ++k) { const float keep = q2 ? sd[k + 8] : sd[k], give = q2 ? sd[k] : sd[k + 8]; s8[k] = keep + P8_DPP(give, 0x141); }     \
            _Pragma("unroll") for (int k = 0; k < 4; ++k) { const float keep = q1 ? s8[k + 4] : s8[k], give = q1 ? s8[k] : s8[k + 4]; s4[k] = keep + P8_DPP(give, 0x4E); }      \
            _Pragma("unroll") for (int k = 0; k < 2; ++k) { const float keep = q0 ? s4[k + 2] : s4[k], give = q0 ? s4[k] : s4[k + 2]; s2_[k] = keep + P8_DPP(give, 0xB1); }     \
            if ((tk) < T) *(f32x2*)(PA + ((size_t)(tk) * 16 + c) * 128 + 2 * lane) = (f32x2){s2_[0], s2_[1]}; } while (0)
        const bool q2 = (lane & 4) != 0, q1 = (lane & 2) != 0, q0 = (lane & 1) != 0;
        LAS unsigned* wq = (LAS unsigned*)(lds + MISC_OFF + 128);
        if (lane == 0 && wave == 0) { wq[0] = 0u; wq[1] = 0u; }
        __syncthreads();
        const int tok0 = (bx >> 3) * NWAVES, npair = (T / nwv) * NWAVES / 2;
#define WQ_NEXT(slot) __builtin_amdgcn_readfirstlane((int)(lane == 0 ? __hip_atomic_fetch_add(wq + (slot), 1u, __ATOMIC_RELAXED, __HIP_MEMORY_SCOPE_WORKGROUP) : 0u))
#define WQ_TOK(p, k) ((p) < npair ? tok0 + ((2 * (p) + (k)) & 7) + nwv * ((2 * (p) + (k)) >> 3) : T)
        for (int c = grp, pass = 0; c < 16; c += 8, ++pass) {
            const int coff = 128 * c + 16 * l8, coffT = c * NEXP * 128 + 16 * l8;
            int eA[2], eB[2]; u32x4 rA[16], rB[16]; u32x4 xA0, xA1, xB0, xB1;
            int p = WQ_NEXT(pass); int ta = WQ_TOK(p, 0), tb = WQ_TOK(p, 1);
            P8_IDX(eA, ta); P8_ROWS(rA, eA, xA0, xA1, ta); P8_IDX(eB, tb);
#pragma unroll 1
            while (p < npair) {
                const int pn = WQ_NEXT(pass); const int na = WQ_TOK(pn, 0), nb = WQ_TOK(pn, 1);
                P8_ROWS(rB, eB, xB0, xB1, tb); P8_IDX(eA, na);
                P8_COMP(rA, xA0, xA1, ta);
                P8_ROWS(rA, eA, xA0, xA1, na); P8_IDX(eB, nb);
                P8_COMP(rB, xB0, xB1, tb);
                p = pn; ta = na; tb = nb;
            }
        }
#undef P8_IDX
#undef P8_ROWS
#undef P8_COMP
#undef P8_DPP
    }
    SEAM(8);
    if (IN(9)) {
        const int lane = lane_now();
        const int* IDX = (const int*)(ws + WS_IDX); const float* GATE = (const float*)(ws + WS_GATE); const float* ESC = (const float*)(ws + WS_EV);
        for (int t = gw; t < T; t += NGW) {
            const float pss = lane < 32 ? SSQ[(size_t)t * 32 + lane] : 0.f;
            const float rstd = rsqrtf(wave_sum(pss) * (1.f / DM) + EPS);
#pragma unroll
            for (int hh = 0; hh < 2; ++hh) { const int j = 64 * hh + lane; float a = 0.f;
#pragma unroll
                for (int c = 0; c < 16; ++c) a += PA[((size_t)t * 16 + c) * 128 + (j & 7) * 16 + (j >> 3)];
                const int e = IDX[(size_t)t * 128 + j];
                a *= ESC[e] * rstd;
                const float ge = 0.5f * a * (1.f + tanhf(0.7978845608028654f * (a + 0.044715f * a * a * a)));
                HS[(size_t)t * 128 + j] = ge * GATE[(size_t)t * 128 + j] * ESC[NEXP + e]; }
        }
    }
    SEAM(9);
    if (IN(10)) {
        const int lane = lane_now(), l8 = lane & 7, lg = lane >> 3, grp = bx & 7, nwv = (G >> 3) * NWAVES, wg = (bx >> 3) * NWAVES + wave;
        const int* IDX = (const int*)(ws + WS_IDX); const unsigned char* EV8 = (const unsigned char*)(ws + WS_EU) + (size_t)NEXP * DM;
        float* outp = args.out;
        const bool b16 = (lane & 16) != 0, b8 = (lane & 8) != 0;
#define P10_LOADE(E, tk) do { const int* ip_ = IDX + (size_t)((tk) < T ? (tk) : T - 1) * 128 + lane; E[0] = ip_[0]; E[1] = ip_[64]; } while (0)
#define P10_LOADH(H, tk) do { const float* hp_ = HS + (size_t)((tk) < T ? (tk) : T - 1) * 128 + lane; H[0] = hp_[0]; H[1] = hp_[64]; } while (0)
#define P10_ROWS(R, E, O, tk) do { _Pragma("unroll") for (int i = 0; i < 16; ++i) { const int e_ = __shfl(E[i >> 3], ((8 * i) & 63) + lg); R[i] = *(const u32x4*)(EV8 + (unsigned)(e_ * 128 + coffT)); } \
            { const unsigned w_ = *(const unsigned*)(XG + (size_t)((tk) < T ? (tk) : T - 1) * DM + coff + 2 * lg); O = (f32x2){__uint_as_float(w_ << 16), __uint_as_float(w_ & 0xffff0000u)}; } } while (0)
#define P10_COMP(R, H, O, tk) do { f32x2 acc[8]; \
            _Pragma("unroll") for (int d = 0; d < 8; ++d) acc[d] = (f32x2){0.f, 0.f}; \
            _Pragma("unroll") for (int i = 0; i < 16; ++i) { const float h_ = __shfl(H[i >> 3], ((8 * i) & 63) + lg); _Pragma("unroll") for (int d = 0; d < 4; ++d) { \
                acc[2 * d] += __builtin_amdgcn_cvt_pk_f32_fp8((int)R[i][d], false) * h_; acc[2 * d + 1] += __builtin_amdgcn_cvt_pk_f32_fp8((int)R[i][d], true) * h_; } } \
              \
            float f8[8], f4[4], f2[2]; \
            _Pragma("unroll") for (int k = 0; k < 8; ++k) { auto r_ = __builtin_amdgcn_permlane32_swap(__float_as_uint(acc[k >> 1][k & 1]), __float_as_uint(acc[(k + 8) >> 1][k & 1]), false, false); f8[k] = __uint_as_float(r_[0]) + __uint_as_float(r_[1]); } \
            _Pragma("unroll") for (int k = 0; k < 4; ++k) { const float keep = b16 ? f8[k + 4] : f8[k], give = b16 ? f8[k] : f8[k + 4]; f4[k] = keep + __shfl_xor(give, 16); } \
            _Pragma("unroll") for (int k = 0; k < 2; ++k) { const float keep = b8 ? f4[k + 2] : f4[k], give = b8 ? f4[k] : f4[k + 2]; f2[k] = keep + __shfl_xor(give, 8); } \
            if ((tk) < T) { f32x2 v_ = O; v_[0] += f2[0]; v_[1] += f2[1]; *(f32x2*)(outp + (size_t)(tk) * DM + coff + 2 * lg) = v_; } } while (0)
        LAS unsigned* wq = (LAS unsigned*)(lds + MISC_OFF + 128);
        if (lane == 0 && wave == 0) { wq[2] = 0u; wq[3] = 0u; }
        __syncthreads();
        const int tok0 = (bx >> 3) * NWAVES, npair = (T / nwv) * NWAVES / 2;
        for (int c = grp, pass = 0; c < 16; c += 8, ++pass) {
            const int coff = 128 * c + 16 * l8, coffT = c * NEXP * 128 + 16 * l8;
            int e[2]; float hA[2], hB[2]; u32x4 rA[16], rB[16]; f32x2 oA, oB;
            int p = WQ_NEXT(2 + pass); int ta = WQ_TOK(p, 0), tb = WQ_TOK(p, 1);
            P10_LOADE(e, ta); P10_ROWS(rA, e, oA, ta); P10_LOADH(hA, ta); P10_LOADE(e, tb);
#pragma unroll 1
            while (p < npair) {
                const int pn = WQ_NEXT(2 + pass); const int na = WQ_TOK(pn, 0), nb = WQ_TOK(pn, 1);
                P10_ROWS(rB, e, oB, tb); P10_LOADH(hB, tb); P10_LOADE(e, na);
                P10_COMP(rA, hA, oA, ta);
                P10_ROWS(rA, e, oA, na); P10_LOADH(hA, na); P10_LOADE(e, nb);
                P10_COMP(rB, hB, oB, tb);
                p = pn; ta = na; tb = nb;
            }
        }
#undef WQ_NEXT
#undef WQ_TOK
#undef P10_LOADE
#undef P10_LOADH
#undef P10_ROWS
#undef P10_COMP
    }
#undef IN
#undef SEAM
}

static int g_grid = 0;
static void launch_mega(const Args& a0, int lo, int hi, hipStream_t stream) {
    Args a = a0; a.ph_lo = lo; a.ph_hi = hi;
    hipLaunchKernelGGL(mega, dim3(g_grid), dim3(NTHR), LDS_BYTES, stream, a);
}

extern "C" void kernel_launch(void* const* d_in, const int* in_sizes, int n_in, void* d_out, int out_size, void* d_ws, size_t ws_size, hipStream_t stream) {
    if (n_in != 17 || out_size != T * DM || ws_size < 512 * MiB) { fprintf(stderr, "kernel_launch: unexpected shapes n_in=%d out=%d ws=%zu\n", n_in, out_size, ws_size); return; }
    if (g_grid == 0) {
        int dev = 0, cus = 0;
        if (hipGetDevice(&dev) != hipSuccess || hipDeviceGetAttribute(&cus, hipDeviceAttributeMultiprocessorCount, dev) != hipSuccess) { fprintf(stderr, "kernel_launch: device query failed\n"); g_grid = -1; return; }
        if (hipFuncSetAttribute((const void*)mega, hipFuncAttributeMaxDynamicSharedMemorySize, LDS_BYTES) != hipSuccess) { fprintf(stderr, "kernel_launch: hipFuncSetAttribute failed\n"); g_grid = -1; return; }
        if (cus < 256) { fprintf(stderr, "kernel_launch: this kernel needs 256 co-resident workgroups (one per CU); the device has %d CUs\n", cus); g_grid = -1; return; }
        g_grid = 256;
    }
    if (g_grid < 0) return;
    char* ws = (char*)d_ws; float* out = (float*)d_out;
    (void)hipMemsetAsync(ws + WS_CTL + CW_BAR * 4, 0, XCD_BAR_WORDS * 4, stream);
    Args a{}; for (int i = 0; i < 17; ++i) a.in[i] = (const float*)d_in[i]; a.out = out; a.ws = (unsigned char*)d_ws;
    launch_mega(a, 0, N_PHASES, stream);
}
```

```cpp
#include <hip/hip_runtime.h>
#include <cstdio>
#include <cstdint>

typedef unsigned short bf16_t;
constexpr int Bn = 4, S = 4096, DM = 2048, T = Bn * S, NH = 8, HD = 128, FW = 1024, PW = 1024;
constexpr int INC = 8200, NPROJ = 8192;
constexpr int PH = 8, PK = 128, PQD = 256, TOPK = 16, NEXP = 16384;
constexpr float EPS = 1e-6f;
constexpr float SCALE = 0.08838834764831845f;
constexpr float INV_SCALE = 11.313708498984761f;
constexpr size_t MiB = 1u << 20;
constexpr size_t WS_WT_PG = 1 * MiB, WS_WT_BA = 2 * MiB, WS_WT_BP = 6 * MiB, WS_WT_OUT = 10 * MiB, WS_WT_Q = 18 * MiB, WS_SK = 26 * MiB, WS_SKB = 27 * MiB,
                 WS_CS = 28 * MiB, WS_LOGF = 29 * MiB, WS_SSQ = 30 * MiB, WS_IDX = 32 * MiB, WS_GATE = 40 * MiB,
                 WS_Q = 48 * MiB, WS_K = 80 * MiB, WS_V = 112 * MiB, WS_PIN = 144 * MiB, WS_G = 176 * MiB, WS_EU = 304 * MiB, WS_EV = 368 * MiB, WS_XG = 432 * MiB,
                 WS_TMP = 48 * MiB, WS_MERGED = 112 * MiB, WS_QP = 48 * MiB, WS_RAWQ = 304 * MiB, WS_RAWK = 368 * MiB, WS_SC = 176 * MiB;
constexpr size_t DO_H1 = 0, DO_WT_IN = 64 * MiB, DO_O = 0, DO_POOLED = 32 * MiB, DO_POOL2 = 64 * MiB;

__device__ __forceinline__ float bf2f(bf16_t v) { return __uint_as_float(((unsigned)v) << 16); }
__device__ __forceinline__ bf16_t f2bf(float f) { unsigned u = __float_as_uint(f); return (bf16_t)((u + 0x7fffu + ((u >> 16) & 1u)) >> 16); }


#define LAS __attribute__((address_space(3)))
#define GAS __attribute__((address_space(1)))
typedef short bf16x8 __attribute__((ext_vector_type(8)));
typedef float f32x4 __attribute__((ext_vector_type(4)));
typedef float f32x2 __attribute__((ext_vector_type(2)));
typedef unsigned u32x4 __attribute__((ext_vector_type(4)));
typedef unsigned u32x2 __attribute__((ext_vector_type(2)));
typedef int v8i_t __attribute__((ext_vector_type(8)));
typedef int i32x4_t __attribute__((ext_vector_type(4)));
constexpr int NWAVES = 8, NTHR = 512;
constexpr int RING_OFF = 0, RING_BYTES = 131072, EPI_OFF = 131072, EPI_BYTES = 16384, MISC_OFF = EPI_OFF + EPI_BYTES, LDS_BYTES = MISC_OFF + 512;
constexpr size_t WS_CTL = 0, CTL_ZERO_BYTES = 65536;
constexpr int CW_BAR = 1024;

__device__ __forceinline__ unsigned cvt_pk_bf16(float lo, float hi) { unsigned r; asm volatile("s_nop 0\n\tv_cvt_pk_bf16_f32 %0, %1, %2" : "=v"(r) : "v"(lo), "v"(hi)); return r; }
__device__ __forceinline__ float wave_sum(float v) {
#pragma unroll
    for (int o = 1; o < 64; o <<= 1) v += __shfl_xor(v, o);
    return v;
}
__device__ __forceinline__ int lane_now() { int l; asm volatile("v_mbcnt_lo_u32_b32 %0, -1, 0\n\tv_mbcnt_hi_u32_b32 %0, -1, %0" : "=v"(l)); return l; }
#define LDS_WAIT() asm volatile("s_waitcnt lgkmcnt(0)" ::: "memory")
#define VM_WAIT() asm volatile("s_waitcnt vmcnt(0)" ::: "memory")

namespace pg8 {
constexpr int BM = 256, BK = 64, HALF = 128, HTB = HALF * BK * 2, STAGE_BYTES = 8 * HTB, NXCD = 8, WGM = 8;
__host__ __device__ __forceinline__ int lds_byte(int r, int c) { const int st = (r >> 4) * 2 + (c >> 5), rr = r & 15, cc = c & 31, ob = rr * 64 + cc * 2; return st * 1024 + (ob ^ (((ob >> 9) & 1) << 5)); }
__host__ __device__ __forceinline__ void stage_rc(int b, int& R, int& C) { const int st = b / 1024, sb = b % 1024, swz = sb ^ (((sb >> 9) & 1) << 5); R = (st >> 1) * 16 + swz / 64; C = (st & 1) * 32 + (swz % 64) / 2; }
__host__ __device__ __forceinline__ int perm32(int rho) { const int n = rho >> 4, i = rho & 15; return 8 * (i >> 2) + 4 * n + (i & 3); }
struct Unit { int pm, pn, aux; };
__device__ __forceinline__ void order_map(int L, int nM, int nN, int nwg, Unit& u) {
    int wgid = L; { const int q = nwg / NXCD, r = nwg % NXCD, xcd = wgid % NXCD, off = wgid / NXCD; wgid = (xcd < r ? xcd * (q + 1) : r * (q + 1) + (xcd - r) * q) + off; }
    const int nig = WGM * nN, gid = wgid / nig, fm = gid * WGM, gsz = (nM - fm) < WGM ? (nM - fm) : WGM;
    u.pm = fm + ((wgid % nig) % gsz); u.pn = (wgid % nig) / gsz; u.aux = 0;
}
struct SchedStd {
    const char* A; const char* Bt; size_t a_tile, b_tile, a_kstride; int nM, nN, nwg, G, c;
    __device__ __forceinline__ bool next(int i, Unit& u) const { const long L = (long)i * G + c; if (L >= nwg) return false; order_map((int)L, nM, nN, nwg, u); return true; }
    __device__ __forceinline__ const char* a_ptr(const Unit& u) const { return A + (size_t)u.pm * a_tile + (size_t)u.pn * a_kstride; }
    __device__ __forceinline__ const char* b_ptr(const Unit& u) const { return Bt + (size_t)u.pn * b_tile; }
};
struct SchedPair {
    const char* A0; const char* A1; const char* B0; const char* B1; size_t a_tile, b_tile; int nM, nN, nwg, G, c;
    __device__ __forceinline__ bool next(int i, Unit& u) const { const long L = (long)(i >> 1) * G + c; if (L >= nwg) return false; order_map((int)L, nM, nN, nwg, u); u.aux = i & 1; return true; }
    __device__ __forceinline__ const char* a_ptr(const Unit& u) const { return (u.aux ? A1 : A0) + (size_t)u.pm * a_tile; }
    __device__ __forceinline__ const char* b_ptr(const Unit& u) const { return (u.aux ? B1 : B0) + (size_t)u.pn * b_tile; }
};
typedef f32x4 Acc[2][2][4][2];

template <bool FP8 = false, class Epi, class Sched>
__device__ __forceinline__ void gemm_phase(LAS unsigned char* lds, const int wid, const int K, const int lda, const int ldb, const Sched& S, const Epi& E) {
    const int lane = lane_now(), tid = wid * 64 + lane, wr = wid >> 2, wc = wid & 3, fr = lane & 15, fq = lane >> 4;
    const int nt = K / BK;
    unsigned voffA[2], voffB[2];
#pragma unroll
    for (int i = 0; i < 2; ++i) { int R, C; stage_rc(tid * 16 + i * 8192, R, C); const int Rb = (R & ~31) + perm32(R & 31);
        voffA[i] = (unsigned)(R * lda + C) * 2u; voffB[i] = (unsigned)(Rb * ldb + C) * 2u; }
    const size_t kstep = (size_t)(BK * 2);
    const size_t hstepA = (size_t)HALF * lda * 2, hstepB = (size_t)HALF * ldb * 2;
    const unsigned ldsw = (unsigned)wid * 1024u;
    const int aoff = lds_byte(wr * 64 + fr, fq * 8), boff = lds_byte(wc * 32 + fr, fq * 8);
#define PG8_SA(b, h) (((b) * 2 + (h)) * HTB)
#define PG8_SB(b, h) ((4 + (b) * 2 + (h)) * HTB)
#define PG8_STAGE(bufoff, gbase, voff) do { _Pragma("unroll") for (int _i = 0; _i < 2; ++_i) \
        __builtin_amdgcn_global_load_lds((const unsigned*)((const char*)(gbase) + (voff)[_i]), (LAS unsigned*)(lds + (bufoff) + ldsw + _i * 8192), 16, 0, 0); } while (0)
#define PG8_LDA(dst, b, h) do { if constexpr (FP8) { _Pragma("unroll") for (int m = 0; m < 4; ++m) dst##8[m] = __builtin_shufflevector(*(const LAS i32x4_t*)(lds + PG8_SA(b, h) + aoff + m * 2048), *(const LAS i32x4_t*)(lds + PG8_SA(b, h) + aoff + m * 2048 + 1024), 0, 1, 2, 3, 4, 5, 6, 7); } \
        else { _Pragma("unroll") for (int m = 0; m < 4; ++m) _Pragma("unroll") for (int k = 0; k < 2; ++k) dst[m][k] = *(const LAS bf16x8*)(lds + PG8_SA(b, h) + aoff + m * 2048 + k * 1024); } } while (0)
#define PG8_LDB(dst, b, h) do { if constexpr (FP8) { _Pragma("unroll") for (int n = 0; n < 2; ++n) dst##8[n] = __builtin_shufflevector(*(const LAS i32x4_t*)(lds + PG8_SB(b, h) + boff + n * 2048), *(const LAS i32x4_t*)(lds + PG8_SB(b, h) + boff + n * 2048 + 1024), 0, 1, 2, 3, 4, 5, 6, 7); } \
        else { _Pragma("unroll") for (int n = 0; n < 2; ++n) _Pragma("unroll") for (int k = 0; k < 2; ++k) dst[n][k] = *(const LAS bf16x8*)(lds + PG8_SB(b, h) + boff + n * 2048 + k * 1024); } } while (0)
#define PG8_MMA(ai, bj, At, Bt) do { if constexpr (!FP8) __builtin_amdgcn_s_setprio(1);     \
        if constexpr (FP8) { _Pragma("unroll") for (int m = 0; m < 4; ++m) _Pragma("unroll") for (int n = 0; n < 2; ++n) \
            acc[ai][bj][m][n] = __builtin_amdgcn_mfma_scale_f32_16x16x128_f8f6f4(Bt##8[n], At##8[m], acc[ai][bj][m][n], 0, 0, 0, 0x7f7f7f7f, 0, 0x7f7f7f7f); } \
        else { _Pragma("unroll") for (int m = 0; m < 4; ++m) _Pragma("unroll") for (int n = 0; n < 2; ++n) _Pragma("unroll") for (int k = 0; k < 2; ++k) \
            acc[ai][bj][m][n] = __builtin_amdgcn_mfma_f32_16x16x32_bf16(Bt[n][k], At[m][k], acc[ai][bj][m][n], 0, 0, 0); } \
        __builtin_amdgcn_s_setprio(0); } while (0)
#define PG8_WAIT_V(n) asm volatile("s_waitcnt vmcnt(" #n ")" ::: "memory")
#define PG8_WAIT_L(n) asm volatile("s_waitcnt lgkmcnt(" #n ")" ::: "memory")
#define PG8_BAR __builtin_amdgcn_s_barrier()
#define PG8_SCHED __builtin_amdgcn_sched_barrier(0)
    Unit cur, nxt; int ui = 0;
    if (!S.next(0, cur)) return;
    Acc acc;
#pragma unroll
    for (int a = 0; a < 2; ++a)
#pragma unroll
        for (int b = 0; b < 2; ++b)
#pragma unroll
            for (int m = 0; m < 4; ++m)
#pragma unroll
                for (int n = 0; n < 2; ++n) acc[a][b][m][n] = (f32x4){0.f, 0.f, 0.f, 0.f};
    bf16x8 At[4][2], B0[2][2], B1[2][2]; v8i_t At8[4], B08[2], B18[2];
    const char* cA = S.a_ptr(cur); const char* cB = S.b_ptr(cur);
    PG8_STAGE(PG8_SB(0, 0), cB, voffB); PG8_STAGE(PG8_SB(0, 1), cB + hstepB, voffB); PG8_STAGE(PG8_SA(0, 0), cA, voffA); PG8_STAGE(PG8_SA(0, 1), cA + hstepA, voffA);
    if (wr == 1) PG8_BAR;
    PG8_WAIT_V(2); PG8_BAR;
    PG8_STAGE(PG8_SB(1, 0), cB + kstep, voffB); PG8_STAGE(PG8_SA(1, 0), cA + kstep, voffA); PG8_STAGE(PG8_SB(1, 1), cB + hstepB + kstep, voffB);
    PG8_WAIT_V(6); PG8_BAR;
#pragma unroll 1
    for (;;) {
        const bool has_next = S.next(ui + 1, nxt);
        const char* nA = has_next ? S.a_ptr(nxt) : cA; const char* nB = has_next ? S.b_ptr(nxt) : cB;
#pragma unroll 1
        for (int t = 0; t < nt; t += 2) {
            const bool last = (t == nt - 2);
            const char* a1 = cA + (size_t)(t + 1) * kstep;
            const char* a2 = last ? nA : cA + (size_t)(t + 2) * kstep; const char* b2 = last ? nB : cB + (size_t)(t + 2) * kstep;
            const char* a3 = a2 + kstep; const char* b3 = b2 + kstep;
            PG8_LDB(B0, 0, 0); PG8_LDB(B1, 0, 1); PG8_SCHED; PG8_LDA(At, 0, 0); PG8_STAGE(PG8_SA(1, 1), a1 + hstepA, voffA);
            PG8_WAIT_V(8); PG8_WAIT_L(0); PG8_BAR; PG8_MMA(0, 0, At, B0); PG8_MMA(0, 1, At, B1); PG8_BAR; PG8_SCHED;
            PG8_LDA(At, 0, 1); PG8_STAGE(PG8_SB(0, 0), b2, voffB); PG8_STAGE(PG8_SB(0, 1), b2 + hstepB, voffB); PG8_STAGE(PG8_SA(0, 0), a2, voffA);
            PG8_WAIT_V(8); PG8_WAIT_L(0); PG8_BAR; PG8_MMA(1, 0, At, B0); PG8_MMA(1, 1, At, B1); PG8_BAR; PG8_SCHED;
            PG8_LDB(B0, 1, 0); PG8_LDB(B1, 1, 1); PG8_SCHED; PG8_LDA(At, 1, 0); PG8_STAGE(PG8_SA(0, 1), a2 + hstepA, voffA);
            PG8_WAIT_V(8); PG8_WAIT_L(0); PG8_BAR; PG8_MMA(0, 0, At, B0); PG8_MMA(0, 1, At, B1); PG8_BAR; PG8_SCHED;
            PG8_LDA(At, 1, 1); PG8_STAGE(PG8_SB(1, 0), b3, voffB); PG8_STAGE(PG8_SB(1, 1), b3 + hstepB, voffB); PG8_STAGE(PG8_SA(1, 0), a3, voffA);
            PG8_WAIT_V(8); PG8_WAIT_L(0); PG8_BAR; PG8_MMA(1, 0, At, B0); PG8_MMA(1, 1, At, B1); PG8_BAR; PG8_SCHED;
        }
        if (wr == 0) PG8_BAR;
        E(acc, cur, ui, wid);
        if (!has_next) break;
#pragma unroll
        for (int a = 0; a < 2; ++a)
#pragma unroll
            for (int b = 0; b < 2; ++b)
#pragma unroll
                for (int m = 0; m < 4; ++m)
#pragma unroll
                    for (int n = 0; n < 2; ++n) acc[a][b][m][n] = (f32x4){0.f, 0.f, 0.f, 0.f};
        cur = nxt; cA = nA; cB = nB; ++ui;
        if (wr == 1) PG8_BAR;
    }
    PG8_WAIT_V(0);
    PG8_BAR;
#undef PG8_SA
#undef PG8_SB
#undef PG8_STAGE
#undef PG8_LDA
#undef PG8_LDB
#undef PG8_MMA
#undef PG8_WAIT_V
#undef PG8_WAIT_L
#undef PG8_BAR
#undef PG8_SCHED
}
}

using pg8::Acc; using pg8::Unit;
__device__ __forceinline__ u32x4 pack8(const f32x4 a, const f32x4 b) { u32x4 w; w.x = cvt_pk_bf16(a[0], a[1]); w.y = cvt_pk_bf16(a[2], a[3]); w.z = cvt_pk_bf16(b[0], b[1]); w.w = cvt_pk_bf16(b[2], b[3]); return w; }
__device__ __forceinline__ void unpack8(const u32x4 w, f32x4& a, f32x4& b) {
    a[0] = __uint_as_float(w.x << 16); a[1] = __uint_as_float(w.x & 0xffff0000u); a[2] = __uint_as_float(w.y << 16); a[3] = __uint_as_float(w.y & 0xffff0000u);
    b[0] = __uint_as_float(w.z << 16); b[1] = __uint_as_float(w.z & 0xffff0000u); b[2] = __uint_as_float(w.w << 16); b[3] = __uint_as_float(w.w & 0xffff0000u);
}
__device__ __forceinline__ float sigmoidf_fast(float v) { return __builtin_amdgcn_rcpf(1.f + __builtin_amdgcn_exp2f(-1.4426950408889634f * v)); }

struct EpiProj {
    bf16_t* Q; bf16_t* Kt; bf16_t* V; bf16_t* PIN; bf16_t* G; const float* gq; const float* gk; LAS float* P; float inv;
    __device__ __forceinline__ void operator()(const Acc& acc, const Unit& u, int ui, int wid) const {
        const int lane = lane_now(), wr = wid >> 2, wc = wid & 3, fr = lane & 15, fq = lane >> 4;
        const int pn = u.pn, c8 = wc * 32 + fq * 8;
        if (pn < 8) {
            LAS float* Pb = P + (ui & 1) * 2048;
#pragma unroll
            for (int ai = 0; ai < 2; ++ai)
#pragma unroll
                for (int m = 0; m < 4; ++m)
#pragma unroll
                    for (int bj = 0; bj < 2; ++bj) { const f32x4 a = acc[ai][bj][m][0] * inv, b = acc[ai][bj][m][1] * inv;
                        float s = (a[0] * a[0] + a[1] * a[1]) + (a[2] * a[2] + a[3] * a[3]) + (b[0] * b[0] + b[1] * b[1]) + (b[2] * b[2] + b[3] * b[3]);
                        s += __shfl_xor(s, 16); s += __shfl_xor(s, 32);
                        if (fq == 0) Pb[((ai * 128 + wr * 64 + m * 16 + fr) * 2 + bj) * 4 + wc] = s; }
            LDS_WAIT(); __builtin_amdgcn_s_barrier(); asm volatile("" ::: "memory");
            const float* g = (pn < 4) ? gq : gk; bf16_t* dst = (pn < 4) ? Q : Kt; const int h0 = (pn & 3) * 2;
            const f32x4 g0 = *(const f32x4*)(g + c8), g1 = *(const f32x4*)(g + c8 + 4);
#pragma unroll
            for (int ai = 0; ai < 2; ++ai)
#pragma unroll
                for (int m = 0; m < 4; ++m) { const int rl = ai * 128 + wr * 64 + m * 16 + fr, row = u.pm * 256 + rl, bb = row >> 12, s = row & 4095;
#pragma unroll
                    for (int bj = 0; bj < 2; ++bj) { const f32x4 p = *(const LAS f32x4*)(Pb + (rl * 2 + bj) * 4);
                        const float rstd = rsqrtf(((p[0] + p[1]) + (p[2] + p[3])) * (1.f / 128.f) + EPS);
                        const f32x4 a = acc[ai][bj][m][0] * inv * rstd * g0, b = acc[ai][bj][m][1] * inv * rstd * g1;
                        *(u32x4*)(dst + (((size_t)bb * NH + h0 + bj) * S + s) * HD + c8) = pack8(a, b); } }
        } else if (pn < 12) {
            const int h0 = (pn - 8) * 2;
#pragma unroll
            for (int ai = 0; ai < 2; ++ai)
#pragma unroll
                for (int m = 0; m < 4; ++m) { const int row = u.pm * 256 + ai * 128 + wr * 64 + m * 16 + fr, bb = row >> 12, s = row & 4095;
#pragma unroll
                    for (int bj = 0; bj < 2; ++bj) *(u32x4*)(V + (((size_t)bb * NH + h0 + bj) * S + s) * HD + c8) = pack8(acc[ai][bj][m][0] * inv, acc[ai][bj][m][1] * inv); }
        } else if (pn < 16) {
#pragma unroll
            for (int ai = 0; ai < 2; ++ai)
#pragma unroll
                for (int m = 0; m < 4; ++m) { const int row = u.pm * 256 + ai * 128 + wr * 64 + m * 16 + fr;
#pragma unroll
                    for (int bj = 0; bj < 2; ++bj) *(u32x4*)(PIN + (size_t)row * PW + (pn - 12) * 256 + bj * 128 + c8) = pack8(acc[ai][bj][m][0] * inv, acc[ai][bj][m][1] * inv); }
        } else {
#pragma unroll
            for (int ai = 0; ai < 2; ++ai)
#pragma unroll
                for (int m = 0; m < 4; ++m) { const int row = u.pm * 256 + ai * 128 + wr * 64 + m * 16 + fr;
#pragma unroll
                    for (int bj = 0; bj < 2; ++bj) { f32x4 a = acc[ai][bj][m][0] * inv, b = acc[ai][bj][m][1] * inv;
#pragma unroll
                        for (int e = 0; e < 4; ++e) { a[e] = sigmoidf_fast(a[e]); b[e] = sigmoidf_fast(b[e]); }
                        *(u32x4*)(G + (size_t)row * 4096 + (pn - 16) * 256 + bj * 128 + c8) = pack8(a, b); } }
        }
    }
};
struct EpiGate {
    bf16_t* G; float inv;
    __device__ __forceinline__ void operator()(const Acc& acc, const Unit& u, int ui, int wid) const {
        const int lane = lane_now(), wr = wid >> 2, wc = wid & 3, fr = lane & 15, fq = lane >> 4;
        const int c8 = wc * 32 + fq * 8;
#pragma unroll
        for (int ai = 0; ai < 2; ++ai)
#pragma unroll
            for (int m = 0; m < 4; ++m) { const int row = u.pm * 256 + ai * 128 + wr * 64 + m * 16 + fr;
#pragma unroll
                for (int bj = 0; bj < 2; ++bj) { f32x4 a = acc[ai][bj][m][0] * inv, b = acc[ai][bj][m][1] * inv;
#pragma unroll
                    for (int e = 0; e < 4; ++e) { a[e] = sigmoidf_fast(a[e]); b[e] = sigmoidf_fast(b[e]); }
                    *(u32x4*)(G + (size_t)row * 4096 + u.pn * 256 + bj * 128 + c8) = pack8(a, b); } }
    }
};
struct EpiPool2 {
    bf16_t* O; const float* scale;
    __device__ __forceinline__ void operator()(const Acc& acc, const Unit& u, int ui, int wid) const {
        const int lane = lane_now(), wr = wid >> 2, wc = wid & 3, fr = lane & 15, fq = lane >> 4;
        const int c8 = wc * 32 + fq * 8;
#pragma unroll
        for (int bj = 0; bj < 2; ++bj) { const int col = u.pn * 256 + bj * 128 + c8; const f32x4 s0 = *(const f32x4*)(scale + col), s1 = *(const f32x4*)(scale + col + 4);
#pragma unroll
            for (int ai = 0; ai < 2; ++ai)
#pragma unroll
                for (int m = 0; m < 4; ++m) { const int row = u.pm * 256 + ai * 128 + wr * 64 + m * 16 + fr;
                    *(u32x4*)(O + (size_t)row * PW + col) = pack8(acc[ai][bj][m][0] * s0, acc[ai][bj][m][1] * s1); } }
    }
};
template <int AUX>
struct EpiBranch {
    bf16_t* TMP; bf16_t* MERGED; const bf16_t* G; float inv;
    __device__ __forceinline__ void operator()(const Acc& acc, const Unit& u, int ui, int wid) const {
        const int lane = lane_now(), wr = wid >> 2, wc = wid & 3, fr = lane & 15, fq = lane >> 4;
        const int c8 = wc * 32 + fq * 8;
#pragma unroll
        for (int ai = 0; ai < 2; ++ai)
#pragma unroll
            for (int m = 0; m < 4; ++m) { const int row = u.pm * 256 + ai * 128 + wr * 64 + m * 16 + fr;
#pragma unroll
                for (int bj = 0; bj < 2; ++bj) { const int col = u.pn * 256 + bj * 128 + c8;
                    f32x4 ga, gb; unpack8(*(const u32x4*)(G + (size_t)row * 4096 + AUX * 2048 + col), ga, gb);
                    f32x4 a = acc[ai][bj][m][0] * inv * ga, b = acc[ai][bj][m][1] * inv * gb;
                    if (AUX == 0) { *(u32x4*)(TMP + (size_t)row * DM + col) = pack8(a, b); }
                    else { f32x4 ta, tb; unpack8(*(const u32x4*)(TMP + (size_t)row * DM + col), ta, tb); *(u32x4*)(MERGED + (size_t)row * DM + col) = pack8(a + ta, b + tb); } } }
    }
};
struct EpiOut {
    const float* x; bf16_t* XG; float* SSQ;
    __device__ __forceinline__ void operator()(const Acc& acc, const Unit& u, int ui, int wid) const {
        const int lane = lane_now(), wr = wid >> 2, wc = wid & 3, fr = lane & 15, fq = lane >> 4;
        const int c8 = wc * 32 + fq * 8;
#pragma unroll
        for (int ai = 0; ai < 2; ++ai)
#pragma unroll
            for (int m = 0; m < 4; ++m) { const int row = u.pm * 256 + ai * 128 + wr * 64 + m * 16 + fr; float ss = 0.f;
#pragma unroll
                for (int bj = 0; bj < 2; ++bj) { const size_t off = (size_t)row * DM + u.pn * 256 + bj * 128 + c8;
                    const f32x4 a = acc[ai][bj][m][0] + *(const f32x4*)(x + off), b = acc[ai][bj][m][1] + *(const f32x4*)(x + off + 4);
                    ss += (a[0] * a[0] + a[1] * a[1]) + (a[2] * a[2] + a[3] * a[3]) + (b[0] * b[0] + b[1] * b[1]) + (b[2] * b[2] + b[3] * b[3]);
                    *(u32x4*)(XG + off) = pack8(a, b); }
                ss += __shfl_xor(ss, 16); ss += __shfl_xor(ss, 32);
                if (fq == 0) SSQ[(size_t)row * 32 + u.pn * 4 + wc] = ss; }
    }
};
struct EpiBf16 {
    bf16_t* O; int ldc;
    __device__ __forceinline__ void operator()(const Acc& acc, const Unit& u, int ui, int wid) const {
        const int lane = lane_now(), wr = wid >> 2, wc = wid & 3, fr = lane & 15, fq = lane >> 4;
        const int c8 = wc * 32 + fq * 8;
#pragma unroll
        for (int ai = 0; ai < 2; ++ai)
#pragma unroll
            for (int m = 0; m < 4; ++m) { const int row = u.pm * 256 + ai * 128 + wr * 64 + m * 16 + fr;
#pragma unroll
                for (int bj = 0; bj < 2; ++bj) *(u32x4*)(O + (size_t)row * ldc + u.pn * 256 + bj * 128 + c8) = pack8(acc[ai][bj][m][0], acc[ai][bj][m][1]); }
    }
};

#define XB_TMO      128
#define XB_XCNT(j)  (256  + 64 * (j))
#define XB_XSUB(j)  (1280 + 64 * (j))
#define XB_XGEN(j)  (2304 + 64 * (j))
#define XB_TOP      3328
#define XB_TOPGEN   3392
#define XCD_BAR_WORDS 3456
#define XB_SPIN_CAP (1u << 18)
__device__ __forceinline__ unsigned xb_ld(unsigned* p)              { return __hip_atomic_load(p, __ATOMIC_RELAXED, __HIP_MEMORY_SCOPE_AGENT); }
__device__ __forceinline__ unsigned xb_add(unsigned* p, unsigned v) { return __hip_atomic_fetch_add(p, v, __ATOMIC_RELAXED, __HIP_MEMORY_SCOPE_AGENT); }
__device__ __forceinline__ unsigned xb_xcc_id() { return (unsigned)__builtin_amdgcn_s_getreg((3 << 11) | 20) & 0xFu; }
#define XB_SPIN(cond, bar) do { unsigned _sp = 0; while (cond) { __builtin_amdgcn_s_sleep(1); \
    if ((++_sp & 255u) == 0u) { if (xb_ld(&(bar)[XB_TMO])) break; if (_sp > XB_SPIN_CAP) { atomicAdd(&(bar)[XB_TMO], 1u); break; } } } } while (0)
struct XcdBarrier { unsigned* bar; unsigned x; volatile LAS unsigned* st; };
__device__ __forceinline__ XcdBarrier xcd_barrier_post(unsigned* bar, volatile LAS unsigned* st) {
    XcdBarrier b; b.bar = bar; b.x = xb_xcc_id(); b.st = st;
    if (threadIdx.x == 0) (void)xb_add(&bar[XB_XCNT(b.x)], 1u);
    return b;
}
__device__ __forceinline__ void xcd_barrier_complete(unsigned* bar, unsigned x, unsigned& nloc, unsigned& nx) {
    const unsigned G = gridDim.x * gridDim.y * gridDim.z;
    unsigned sum, cnt, mine, sp = 0u;
    for (;;) {
        sum = 0u; cnt = 0u; mine = 0u;
#pragma unroll
        for (unsigned j = 0; j < 16; ++j) { const unsigned c = xb_ld(&bar[XB_XCNT(j)]); sum += c; cnt += (c > 0u) ? 1u : 0u; mine = (j == x) ? c : mine; }
        if (sum == G) break;
        __builtin_amdgcn_s_sleep(1);
        if ((++sp & 255u) == 0u) { if (xb_ld(&bar[XB_TMO])) break; if (sp > XB_SPIN_CAP) { atomicAdd(&bar[XB_TMO], 1u); break; } }
    }
    nloc = mine > 0u ? mine : 1u; nx = cnt > 0u ? cnt : 1u;
}
__device__ __forceinline__ void xcd_barrier(const XcdBarrier& b) {
    asm volatile("s_waitcnt vmcnt(0)" ::: "memory");
    __syncthreads();
    if (threadIdx.x == 0) {
        unsigned* bar = b.bar;
        __builtin_amdgcn_s_waitcnt(0);
        unsigned nloc = b.st[0], nx = b.st[1];
        if (nloc == 0u) { xcd_barrier_complete(bar, b.x, nloc, nx); b.st[0] = nloc; b.st[1] = nx; }
        const unsigned old = xb_add(&bar[XB_XSUB(b.x)], 1u);
        const unsigned gen = old / nloc;
        if (old + 1u == (gen + 1u) * nloc) {
            __builtin_amdgcn_fence(__ATOMIC_RELEASE, "agent");
            asm volatile("s_waitcnt vmcnt(0)" ::: "memory");
            const unsigned og = xb_add(&bar[XB_TOP], 1u);
            const unsigned tg = og / nx;
            if (og + 1u == (tg + 1u) * nx) xb_add(&bar[XB_TOPGEN], 1u);
            else XB_SPIN(xb_ld(&bar[XB_TOPGEN]) == tg, bar);
            __builtin_amdgcn_fence(__ATOMIC_ACQUIRE, "agent");
            xb_add(&bar[XB_XGEN(b.x)], 1u);
            asm volatile("s_waitcnt vmcnt(0)" ::: "memory");
        } else {
            XB_SPIN(xb_ld(&bar[XB_XGEN(b.x)]) == gen, bar);
            __builtin_amdgcn_fence(__ATOMIC_ACQUIRE, "agent");
            asm volatile("s_waitcnt vmcnt(0)" ::: "memory");
        }
    }
    __syncthreads();
}

__device__ __forceinline__ unsigned pk2(float lo, float hi) { return (unsigned)f2bf(lo) | ((unsigned)f2bf(hi) << 16); }
__device__ __forceinline__ void p0_transpose_item(const float* W, int K, int N, bf16_t* WT, int row0, int src_col0, int k0, LAS float* scr, int lane, const float* kscale = nullptr) {
#pragma unroll 8
    for (int i = 0; i < 32; ++i) { const int kk = 2 * i + (lane >> 5); scr[kk * 33 + (lane & 31)] = W[(size_t)(k0 + kk) * N + src_col0 + (lane & 31)] * (kscale ? kscale[k0 + kk] : 1.f); }
    LDS_WAIT(); asm volatile("" ::: "memory");
    const int c = lane & 7;
#pragma unroll
    for (int j = 0; j < 4; ++j) { const int n = (lane >> 3) + 8 * j; const LAS float* s = scr + (8 * c) * 33 + n;
        u32x4 o; o.x = pk2(s[0 * 33], s[1 * 33]); o.y = pk2(s[2 * 33], s[3 * 33]); o.z = pk2(s[4 * 33], s[5 * 33]); o.w = pk2(s[6 * 33], s[7 * 33]);
        *(u32x4*)(WT + (size_t)(row0 + n) * K + k0 + 8 * c) = o; }
    LDS_WAIT(); asm volatile("" ::: "memory");
}


namespace att {
typedef short s16x4 __attribute__((ext_vector_type(4)));
typedef float f32x16 __attribute__((ext_vector_type(16)));
constexpr int D = 128, NW = 8, QBLK = 32, KVBLK = 64, QB = NW * QBLK;
constexpr int SHM_V = KVBLK * D * 2, SHM_K = KVBLK * D * 2;
constexpr int LDS_WS = 2 * SHM_V + 2 * SHM_K, LDS_CB = LDS_WS + NW * 64 * 4, LDS_ATT_BYTES = LDS_CB + 2 * 64 * 4;
constexpr float THR = 8.f;
constexpr float O8_SCALE = 32.f;
constexpr int OSTR = FW;
#define KSWZ(row, colB) ((row) * 256 + ((colB) ^ (((row) & 7) << 4)))
#define SBAR() __builtin_amdgcn_sched_barrier(0)
__device__ __forceinline__ int v_st(int k, int c) { const int kk = (k & ~0xC) | ((k & 4) << 1) | ((k & 8) >> 1); return ((kk >> 3) * 4 + (c >> 5)) * 512 + ((kk & 7) * 32 + (c & 31)) * 2; }
__device__ __forceinline__ int v_rd_base(int lane) { return ((lane & 3) << 3) | (((lane >> 2) & 3) << 6) | (((lane >> 4) & 1) << 5) | (((lane >> 5) & 1) << 8); }
constexpr int v_rd_off(int d0, int ks, int half) { return d0 * 512 + ks * 4096 + half * 2048; }
__device__ __forceinline__ int crow(int r, int hi) { return (r & 3) + 8 * (r >> 2) + 4 * hi; }
__device__ __forceinline__ unsigned cvtpk(float lo, float hi) { unsigned r; asm volatile("s_nop 0\n\tv_cvt_pk_bf16_f32 %0, %1, %2" : "=v"(r) : "v"(lo), "v"(hi)); return r; }
__device__ __forceinline__ bf16x8 load8(const bf16_t* p) { return *reinterpret_cast<const bf16x8*>(p); }
__device__ __forceinline__ void mask_tile(f32x16& p0, f32x16& p1, int dq) {
    const float NEG = -__builtin_inff();
#pragma unroll
    for (int r = 0; r < 16; ++r) { const int c = (r & 3) + 8 * (r >> 2);
        if (dq - c < 0) p0[r] = NEG;
        if (dq - c - 32 < 0) p1[r] = NEG; }
}
__device__ __forceinline__ void partialSM(f32x16& p0, f32x16& p1, float& m_reg, float& mn, float& alpha) {
    float pmax = p0[0];
#pragma unroll
    for (int r = 1; r < 16; ++r) pmax = fmaxf(pmax, p0[r]);
#pragma unroll
    for (int r = 0; r < 16; ++r) pmax = fmaxf(pmax, p1[r]);
    { auto rr = __builtin_amdgcn_permlane32_swap(__float_as_uint(pmax), __float_as_uint(pmax), false, false);
      pmax = fmaxf(__uint_as_float(rr[0]), __uint_as_float(rr[1])); }
    constexpr float C2 = 1.4426950408889634f * SCALE;
    if (__builtin_expect(__all((pmax - m_reg) * SCALE <= THR), 1)) { mn = m_reg; alpha = 1.f; }
    else { mn = fmaxf(m_reg, pmax); alpha = __builtin_amdgcn_exp2f((m_reg - mn) * C2); m_reg = mn; }
    const float mnL = -mn * C2;
#pragma unroll
    for (int r = 0; r < 16; ++r) p0[r] = fmaf(p0[r], C2, mnL);
#pragma unroll
    for (int r = 0; r < 16; ++r) p1[r] = fmaf(p1[r], C2, mnL);
#pragma unroll
    for (int r = 0; r < 16; ++r) p0[r] = __builtin_amdgcn_exp2f(p0[r]);
}
__device__ __forceinline__ void finishSM(f32x16& p0, f32x16& p1, float alpha, float& l_reg, bf16x8& pa0, bf16x8& pa1, bf16x8& pa2, bf16x8& pa3) {
#pragma unroll
    for (int r = 0; r < 16; ++r) p1[r] = __builtin_amdgcn_exp2f(p1[r]);
    float ps = 0;
#pragma unroll
    for (int r = 0; r < 16; ++r) ps += p0[r];
#pragma unroll
    for (int r = 0; r < 16; ++r) ps += p1[r];
    { auto rr = __builtin_amdgcn_permlane32_swap(__float_as_uint(ps), __float_as_uint(ps), false, false);
      ps = __uint_as_float(rr[0]) + __uint_as_float(rr[1]); }
    l_reg = l_reg * alpha + ps;
#define PK4(P, B_, OUT) do { unsigned a0 = cvtpk(P[B_+0], P[B_+1]), a1 = cvtpk(P[B_+2], P[B_+3]);                          \
        unsigned b0 = cvtpk(P[B_+4], P[B_+5]), b1 = cvtpk(P[B_+6], P[B_+7]);                                             \
        auto r0 = __builtin_amdgcn_permlane32_swap(a0, b0, false, false); auto r1 = __builtin_amdgcn_permlane32_swap(a1, b1, false, false); \
        u32x4 w = {r0[0], r1[0], r0[1], r1[1]}; OUT = *reinterpret_cast<bf16x8*>(&w); } while (0)
    PK4(p0, 0, pa0); PK4(p0, 8, pa1); PK4(p1, 0, pa2); PK4(p1, 8, pa3);
#undef PK4
}
template <int KB>
__device__ __forceinline__ void qkt(f32x16& p0, f32x16& p1, const char* K_lds, const float* CB, int r32, int hi, const bf16x8* qr, float cq) {
    const float* cb = CB + KB * 64 + 4 * hi;
#pragma unroll
    for (int g = 0; g < 4; ++g) { const f32x4 c0 = *(const f32x4*)(cb + 8 * g), c1 = *(const f32x4*)(cb + 32 + 8 * g);
#pragma unroll
        for (int e = 0; e < 4; ++e) { p0[4 * g + e] = cq - c0[e]; p1[4 * g + e] = cq - c1[e]; } }
    const char* kb[4];
#pragma unroll
    for (int dd = 0; dd < 4; ++dd) kb[dd] = K_lds + KB * SHM_K + KSWZ(r32, (dd * 16 + hi * 8) * 2);
#pragma unroll
    for (int d0 = 0; d0 < 8; ++d0) { const char* a = kb[d0 & 3] + (d0 >> 2) * 128;
        bf16x8 b0 = *reinterpret_cast<const bf16x8*>(a);
        bf16x8 b1 = *reinterpret_cast<const bf16x8*>(a + 32 * 256);
        p0 = __builtin_amdgcn_mfma_f32_32x32x16_bf16(b0, qr[d0], p0, 0, 0, 0);
        p1 = __builtin_amdgcn_mfma_f32_32x32x16_bf16(b1, qr[d0], p1, 0, 0, 0); }
}
template <int VB>
__device__ __forceinline__ void pv_tile(f32x16* o, int vb0, bf16x8 pa0, bf16x8 pa1, bf16x8 pa2, bf16x8 pa3) {
#define TRRD(dst, off) asm volatile("ds_read_b64_tr_b16 %0, %1 offset:%2" : "=&v"(dst) : "v"(vb0), "i"(off) : "memory")
#define PV_D0(d0) do { s16x4 l0, l1, l2, l3, h0, h1, h2, h3; constexpr int b_ = VB * SHM_V + v_rd_off(d0, 0, 0); \
        TRRD(l0, b_); TRRD(h0, b_ + 2048); TRRD(l1, b_ + 4096); TRRD(h1, b_ + 6144); TRRD(l2, b_ + 8192); TRRD(h2, b_ + 10240); TRRD(l3, b_ + 12288); TRRD(h3, b_ + 14336); \
        asm volatile("s_waitcnt lgkmcnt(0)" ::: "memory"); SBAR();   \
        o[d0] = __builtin_amdgcn_mfma_f32_32x32x16_bf16(pa0, (bf16x8){l0[0], l0[1], l0[2], l0[3], h0[0], h0[1], h0[2], h0[3]}, o[d0], 0, 0, 0);   \
        o[d0] = __builtin_amdgcn_mfma_f32_32x32x16_bf16(pa1, (bf16x8){l1[0], l1[1], l1[2], l1[3], h1[0], h1[1], h1[2], h1[3]}, o[d0], 0, 0, 0);   \
        o[d0] = __builtin_amdgcn_mfma_f32_32x32x16_bf16(pa2, (bf16x8){l2[0], l2[1], l2[2], l2[3], h2[0], h2[1], h2[2], h2[3]}, o[d0], 0, 0, 0);   \
        o[d0] = __builtin_amdgcn_mfma_f32_32x32x16_bf16(pa3, (bf16x8){l3[0], l3[1], l3[2], l3[3], h3[0], h3[1], h3[2], h3[3]}, o[d0], 0, 0, 0); } while (0)
    PV_D0(0); PV_D0(1); PV_D0(2); PV_D0(3);
#undef PV_D0
#undef TRRD
}
struct BlockRef { const bf16_t* Q; const bf16_t* K; const bf16_t* V; const float* C; unsigned char* O; int P0; int jlo; };
struct Seam { bf16x8 qr[8]; bf16x8 st_v0, st_v1, st_k0, st_k1; float st_c; float cq; };
#define ROW(p, k0, rr) ((p) + (size_t)((k0) + (rr)) * D + sc)
#define VMW() asm volatile("s_waitcnt vmcnt(0)" ::: "memory")
#define VMWN(n) asm volatile("s_waitcnt vmcnt(%0)" :: "i"(n) : "memory")
#define SLOAD_H(Kp, Vp, Cp, k0) do { S.st_v0 = load8(ROW(Vp, k0, sr)); S.st_v1 = load8(ROW(Vp, k0, 32 + sr));              \
                         S.st_k0 = load8(ROW(Kp, k0, sr)); S.st_k1 = load8(ROW(Kp, k0, 32 + sr)); S.st_c = (Cp)[(k0) + (tid & 63)]; } while (0)
#define SWRITE_HK(bf) do { *(bf16x8*)(K_lds + (bf) * SHM_K + kws) = S.st_k0; *(bf16x8*)(K_lds + (bf) * SHM_K + kws + 32 * 256) = S.st_k1; if (wid == 0) CB[(bf) * 64 + lane] = S.st_c; } while (0)
#define SWRITE_HV(bf) do { *(bf16x8*)(V_lds + (bf) * SHM_V + vst0) = S.st_v0; *(bf16x8*)(V_lds + (bf) * SHM_V + vst1) = S.st_v1; } while (0)
#define SWRITE_H(bf) do { SWRITE_HV(bf); SWRITE_HK(bf); } while (0)
__device__ __forceinline__ void attn_prime(const BlockRef& cur, char* lds, Seam& S, int wid) {
    const int lane = lane_now(), tid = wid * 64 + lane, r32 = lane & 31, hi = lane >> 5;
    const int sr = tid >> 4, sc = (tid & 15) * 8, kws = KSWZ(sr, sc * 2); char* K_lds = lds + 2 * SHM_V; float* CB = (float*)(lds + LDS_CB);
#pragma unroll
    for (int d0 = 0; d0 < 8; ++d0) S.qr[d0] = load8(cur.Q + (size_t)(wid * QBLK + r32) * D + d0 * 16 + hi * 8);
    S.cq = cur.C[cur.P0 + wid * QBLK + r32];
    SLOAD_H(cur.K, cur.V, cur.C, cur.jlo * KVBLK); VMW(); SWRITE_HK(0);
    __syncthreads();
}
__device__ __forceinline__ void attn_block(const BlockRef& cur, const BlockRef& nxt, char* lds, Seam& S, int wid) {
    const int lane = lane_now(), tid = wid * 64 + lane, r32 = lane & 31, hi = lane >> 5;
    const int NT = (cur.P0 + QB) / KVBLK - cur.jlo;
    const int qlo = cur.P0 + wid * QBLK, qm = qlo + r32 - 4 * hi;
    char* V_lds = lds; char* K_lds = lds + 2 * SHM_V; float* CB = (float*)(lds + LDS_CB);
    float* ws = (float*)(lds + LDS_WS) + wid * 64; float* li_l = ws, * al_l = ws + 32;
    float m_reg = -1e30f, l_reg = 0; f32x16 o[4] = {};
    const int sr = tid >> 4, sc = (tid & 15) * 8, vst0 = v_st(sr, sc), vst1 = v_st(32 + sr, sc), kws = KSWZ(sr, sc * 2);
    const int vb0 = (int)(uintptr_t)V_lds + v_rd_base(lane);
    const bf16_t* Kh = cur.K; const bf16_t* Vh = cur.V; const float* Ch = cur.C; const float cq = S.cq;
#define RESC(a) do { if (__any((a) < 1.f)) { if (hi == 0) al_l[r32] = (a); asm volatile("s_waitcnt lgkmcnt(0)" ::: "memory");              \
                     for (int d_ = 0; d_ < 4; ++d_) for (int r = 0; r < 16; ++r) o[d_][r] *= al_l[crow(r, hi)]; } } while (0)
#define KBASE(t) ((cur.jlo + (t)) * KVBLK)
#define MASKT(P0_, P1_, t) do { const int kb_ = KBASE(t); if (kb_ + KVBLK - 1 > qlo) mask_tile(P0_, P1_, qm - kb_); } while (0)
    constexpr int NQL = 9;
#define SEAM_K0() do { VMWN(NQL); SWRITE_HK(0); SBAR(); } while (0)
    f32x16 pA0, pA1, pB0, pB1; float mnA, mnB, alA, alB; bf16x8 pa0, pa1, pa2, pa3;
    SWRITE_HV(0); SBAR();
    if (NT > 1) { SLOAD_H(Kh, Vh, Ch, KBASE(1)); }
    SBAR(); qkt<0>(pA0, pA1, K_lds, CB, r32, hi, S.qr, cq);
    MASKT(pA0, pA1, 0); partialSM(pA0, pA1, m_reg, mnA, alA);
    if (NT > 1) { VMW(); SWRITE_H(1); }
    __syncthreads();
#define HALF_STEP(PX0, PX1, mnX, alX, PY0, PY1, alY, t, KB, VB, SB) do {                                                      \
        SBAR(); qkt<KB>(PX0, PX1, K_lds, CB, r32, hi, S.qr, cq);                                             \
        finishSM(PY0, PY1, alY, l_reg, pa0, pa1, pa2, pa3); SBAR();                                                           \
        if ((t) + 1 < NT) { SLOAD_H(Kh, Vh, Ch, KBASE((t) + 1)); SBAR(); }                                               \
        pv_tile<VB>(o, vb0, pa0, pa1, pa2, pa3); MASKT(PX0, PX1, (t)); partialSM(PX0, PX1, m_reg, mnX, alX);                                        \
        __syncthreads();                                                                                                      \
        if ((t) + 1 < NT) { VMW(); SWRITE_H(SB); }                                                                          \
        RESC(alX); __syncthreads(); } while (0)
    for (int t = 1; t + 1 < NT; t += 2) {
        HALF_STEP(pB0, pB1, mnB, alB, pA0, pA1, alA, t, 1, 0, 0);
        HALF_STEP(pA0, pA1, mnA, alA, pB0, pB1, alB, t + 1, 0, 1, 1);
    }
    const bool even = (NT & 1) == 0;
    if (even) { SBAR(); qkt<1>(pB0, pB1, K_lds, CB, r32, hi, S.qr, cq); SBAR(); }
    { SLOAD_H(nxt.K, nxt.V, nxt.C, nxt.jlo * KVBLK); SBAR();
#pragma unroll
      for (int d0 = 0; d0 < 8; ++d0) S.qr[d0] = load8(nxt.Q + (size_t)(wid * QBLK + r32) * D + d0 * 16 + hi * 8);
      S.cq = nxt.C[nxt.P0 + wid * QBLK + r32]; }
    SBAR();
    finishSM(pA0, pA1, alA, l_reg, pa0, pa1, pa2, pa3); SBAR();
    pv_tile<0>(o, vb0, pa0, pa1, pa2, pa3);
    if (even) { MASKT(pB0, pB1, NT - 1); partialSM(pB0, pB1, m_reg, mnB, alB); __syncthreads(); RESC(alB);
        finishSM(pB0, pB1, alB, l_reg, pa0, pa1, pa2, pa3); SBAR(); pv_tile<1>(o, vb0, pa0, pa1, pa2, pa3); }
    SBAR(); SEAM_K0();
    if (hi == 0) li_l[r32] = l_reg; asm volatile("s_waitcnt lgkmcnt(0)" ::: "memory");
    float rli[16];
#pragma unroll
    for (int r = 0; r < 16; ++r) rli[r] = __builtin_amdgcn_rcpf(li_l[crow(r, hi)]);
    unsigned char* Ow = cur.O + (size_t)(wid * QBLK) * OSTR;
#pragma unroll
    for (int r = 0; r < 16; ++r) { const int orow = crow(r, hi);
#pragma unroll
        for (int d0 = 0; d0 < 4; ++d0) { const float v = o[d0][r] * (rli[r] * O8_SCALE);
            const float vn = __shfl_xor(v, 1);
            const int p = __builtin_amdgcn_cvt_pk_fp8_f32(v, vn, 0, false);
            const int p2 = __shfl_xor(p, 2);
            if ((r32 & 3) == 0) *(unsigned*)(Ow + (size_t)orow * OSTR + d0 * 32 + r32) = ((unsigned)p & 0xffffu) | ((unsigned)p2 << 16); } }
    __syncthreads();
#undef RESC
#undef KBASE
#undef MASKT
#undef SEAM_K0
#undef HALF_STEP
}
#undef ROW
#undef VMW
#undef VMWN
#undef SLOAD_H
#undef SWRITE_HK
#undef SWRITE_HV
#undef SWRITE_H
#undef SBAR
}

typedef __bf16 bf16x2_t __attribute__((ext_vector_type(2)));

__device__ __forceinline__ float dot2bf(unsigned a, unsigned b, float c) {
    bf16x2_t av, bv; __builtin_memcpy(&av, &a, 4); __builtin_memcpy(&bv, &b, 4); return __builtin_amdgcn_fdot2_f32_bf16(av, bv, c, false); }
__device__ __forceinline__ float dot2bf_s(unsigned s_uniform, unsigned b, float c) { return dot2bf(s_uniform, b, c); }
namespace peer {
typedef float f32x16 __attribute__((ext_vector_type(16)));
__device__ __forceinline__ float fmaxs(float a, float b) { float r; asm("v_max_f32_e32 %0, %1, %2" : "=v"(r) : "v"(a), "v"(b)); return r; }
__device__ __forceinline__ float fmins(float a, float b) { float r; asm("v_min_f32_e32 %0, %1, %2" : "=v"(r) : "v"(a), "v"(b)); return r; }
#define CE(a, b) do { const float _h = fmaxs(a, b), _l = fmins(a, b); a = _h; b = _l; } while (0)
__device__ __forceinline__ void insert16(float (&L)[16], float x) {
#pragma unroll
    for (int i = 0; i < 16; ++i) { const float h = fmaxs(L[i], x); x = fmins(L[i], x); L[i] = h; }
}
__device__ __forceinline__ void sort16_desc(float (&v)[16]) {
#pragma unroll
    for (int k = 2; k <= 16; k <<= 1)
#pragma unroll
        for (int j = k >> 1; j >= 1; j >>= 1)
#pragma unroll
            for (int i = 0; i < 16; ++i) { const int l = i ^ j; if (l > i) { const bool desc = (i & k) == 0; const float hi_ = fmaxs(v[i], v[l]), lo_ = fmins(v[i], v[l]); v[i] = desc ? hi_ : lo_; v[l] = desc ? lo_ : hi_; } }
}
__device__ __forceinline__ void merge16(float (&L)[16], const float (&S)[16]) {
#pragma unroll
    for (int i = 0; i < 16; ++i) L[i] = fmaxs(L[i], S[15 - i]);
#pragma unroll
    for (int d = 8; d >= 1; d >>= 1)
#pragma unroll
        for (int i = 0; i < 16; ++i) if ((i & d) == 0) CE(L[i], L[i + d]);
}
__device__ __forceinline__ void merge_partner(float (&L)[16], const bool lo_half) {
    float B[16];
#pragma unroll
    for (int i = 0; i < 16; ++i) { auto r = __builtin_amdgcn_permlane32_swap(__float_as_uint(L[i]), __float_as_uint(L[i]), false, false);
        B[i] = __uint_as_float(lo_half ? r[1] : r[0]); }
#pragma unroll
    for (int i = 0; i < 16; ++i) L[i] = fmaxs(L[i], B[15 - i]);
#pragma unroll
    for (int d = 8; d >= 1; d >>= 1)
#pragma unroll
        for (int i = 0; i < 16; ++i) if ((i & d) == 0) CE(L[i], L[i + d]);
}
constexpr int KEYS_BYTES = 65536, SCR_OFF = 65536;
}

__device__ __forceinline__ void p0_transpose_item_fp8(const float* W, int K, int N, unsigned char* WT8, int row0, int src_col0, int k0, LAS float* scr, int lane, float sc) {
#pragma unroll 8
    for (int i = 0; i < 32; ++i) { const int kk = 2 * i + (lane >> 5); scr[kk * 33 + (lane & 31)] = W[(size_t)(k0 + kk) * N + src_col0 + (lane & 31)]; }
    LDS_WAIT(); asm volatile("" ::: "memory");
    const int c = lane & 3;
#pragma unroll
    for (int j = 0; j < 2; ++j) { const int n = (lane >> 2) + 16 * j; const LAS float* sp = scr + (16 * c) * 33 + n; u32x4 o;
#pragma unroll
        for (int q = 0; q < 4; ++q) { int p = 0; p = __builtin_amdgcn_cvt_pk_fp8_f32(sp[(4 * q) * 33] * sc, sp[(4 * q + 1) * 33] * sc, p, false); p = __builtin_amdgcn_cvt_pk_fp8_f32(sp[(4 * q + 2) * 33] * sc, sp[(4 * q + 3) * 33] * sc, p, true); o[q] = (unsigned)p; }
        *(u32x4*)(WT8 + (size_t)(row0 + n) * K + k0 + 16 * c) = o; }
    LDS_WAIT(); asm volatile("" ::: "memory");
}
constexpr float H8_SCALE = 16.f, W8_SCALE = 512.f;
constexpr size_t DO_W8 = 80 * MiB, DO_H8 = 96 * MiB;

struct Args { const float* in[17]; float* out; unsigned char* ws; int ph_lo, ph_hi; };
constexpr int N_PHASES = 11;

__global__ void __launch_bounds__(NTHR, 2) mega(Args args) {
    extern __shared__ __attribute__((aligned(16))) unsigned char lds_raw[];
    LAS unsigned char* lds = (LAS unsigned char*)lds_raw;
    volatile LAS unsigned* MISC = (volatile LAS unsigned*)(lds + MISC_OFF);
    const int wave = __builtin_amdgcn_readfirstlane((int)threadIdx.x >> 6);
    const int G = gridDim.x, bx = blockIdx.x, vcu = (G % 8 == 0) ? (bx % 8) * (G / 8) + bx / 8 : bx;
    unsigned char* ws = args.ws; char* dob = (char*)args.out;
    const float* x = args.in[0]; const float* g1 = args.in[1]; const float* w_in = args.in[2]; const float* fbias = args.in[3];
    const float* gq = args.in[4]; const float* gk = args.in[5]; const float* pgw = args.in[6]; const float* pscale = args.in[7];
    const float* wba = args.in[8]; const float* wbp = args.in[9]; const float* wout = args.in[10]; const float* g2 = args.in[11];
    const float* wq = args.in[12]; const float* sk1 = args.in[13]; const float* sk2 = args.in[14]; const float* eu = args.in[15]; const float* ev = args.in[16];
    bf16_t* WT_IN = (bf16_t*)(dob + DO_WT_IN); unsigned char* W8 = (unsigned char*)(dob + DO_W8); unsigned char* H8 = (unsigned char*)(dob + DO_H8); bf16_t* H1 = (bf16_t*)(dob + DO_H1); bf16_t* Ob = (bf16_t*)(dob + DO_O); bf16_t* POOLED = (bf16_t*)(dob + DO_POOLED); bf16_t* POOL2 = (bf16_t*)(dob + DO_POOL2);
    bf16_t* WT_PG = (bf16_t*)(ws + WS_WT_PG); bf16_t* WT_BA = (bf16_t*)(ws + WS_WT_BA); bf16_t* WT_BP = (bf16_t*)(ws + WS_WT_BP); bf16_t* WT_OUT = (bf16_t*)(ws + WS_WT_OUT); bf16_t* WT_Q = (bf16_t*)(ws + WS_WT_Q);
    bf16_t* SK = (bf16_t*)(ws + WS_SK); float* CS = (float*)(ws + WS_CS); float* LOGF = (float*)(ws + WS_LOGF); float* SSQ = (float*)(ws + WS_SSQ);
    bf16_t* Qb = (bf16_t*)(ws + WS_Q); bf16_t* Kb = (bf16_t*)(ws + WS_K); bf16_t* Vb = (bf16_t*)(ws + WS_V); bf16_t* PIN = (bf16_t*)(ws + WS_PIN); bf16_t* Gt = (bf16_t*)(ws + WS_G);
    bf16_t* EU = (bf16_t*)(ws + WS_EU); bf16_t* EV = (bf16_t*)(ws + WS_EV); bf16_t* XG = (bf16_t*)(ws + WS_XG); bf16_t* TMP = (bf16_t*)(ws + WS_TMP); bf16_t* MERGED = (bf16_t*)(ws + WS_MERGED); bf16_t* QP = (bf16_t*)(ws + WS_QP);
    for (int u = threadIdx.x; u < 128; u += NTHR) MISC[u] = 0u;
    __syncthreads();
    const int lo = args.ph_lo, hi = args.ph_hi;
    XcdBarrier bar; bar.bar = (unsigned*)(ws + WS_CTL) + CW_BAR + lo * XCD_BAR_WORDS; bar.x = 0; bar.st = MISC + 8;
    if (hi - lo > 1) bar = xcd_barrier_post(bar.bar, MISC + 8);
#define IN(k) (lo <= (k) && (k) < hi)
#define SEAM(k) do { if (IN(k) && IN((k) + 1)) xcd_barrier(bar); } while (0)
    const int gw = vcu * NWAVES + wave, NGW = G * NWAVES;

    if (IN(0)) {
        const int lane = lane_now(), tid = wave * 64 + lane;
        LAS float* scr = (LAS float*)(lds + RING_OFF + wave * 16384);
        constexpr int I_IN = (DM / 64) * (NPROJ / 32),     I_BA = (FW / 64) * (DM / 32), I_OUT = (DM / 64) * (DM / 32), I_PG = 4 * (256 / 64) * (256 / 32);
        constexpr int NITEMS = I_IN + 2 * I_BA + 2 * I_OUT + I_PG;
        for (int it = gw; it < NITEMS; it += NGW) {
            int r = it;
            if (r < I_IN) { const int nblk = NPROJ / 32, kb = r / nblk, nb = r % nblk, n0 = nb * 32;
                p0_transpose_item_fp8(w_in, DM, INC, W8, n0, n0 + (n0 >= 3072 ? 8 : 0), kb * 64, scr, lane, W8_SCALE);
                continue; } r -= I_IN;
            if (r < I_BA) { const int nblk = DM / 32, kb = r / nblk, nb = r % nblk; p0_transpose_item_fp8(wba, FW, DM, (unsigned char*)WT_BA, nb * 32, nb * 32, kb * 64, scr, lane, W8_SCALE); continue; } r -= I_BA;
            if (r < I_BA) { const int nblk = DM / 32, kb = r / nblk, nb = r % nblk; p0_transpose_item(wbp, PW, DM, WT_BP, nb * 32, nb * 32, kb * 64, scr, lane); continue; } r -= I_BA;
            if (r < I_OUT) { const int nblk = DM / 32, kb = r / nblk, nb = r % nblk; p0_transpose_item(wout, DM, DM, WT_OUT, nb * 32, nb * 32, kb * 64, scr, lane); continue; } r -= I_OUT;
            if (r < I_OUT) { const int nblk = DM / 32, kb = r / nblk, nb = r % nblk; p0_transpose_item(wq, DM, DM, WT_Q, nb * 32, nb * 32, kb * 64, scr, lane, g2); continue; } r -= I_OUT;
            { const int g = r / 32, rr = r % 32, kb = rr / 8, nb = rr % 8; p0_transpose_item(pgw + (size_t)g * 65536, 256, 256, WT_PG, g * 256 + nb * 32, nb * 32, kb * 64, scr, lane); }
        }
        for (int i = gw * 64 + lane; i < 2048 * 128 / 4; i += NGW * 64) { const int e = i * 4, d = e & 127, n = e >> 7, key = n & 127, f = (n >> 7) & 1, h = n >> 8;
            const f32x4 v = *(const f32x4*)((f ? sk2 : sk1) + ((size_t)h * 128 + key) * 128 + d); u32x2 o; o.x = pk2(v[0], v[1]); o.y = pk2(v[2], v[3]); *(u32x2*)(SK + e) = o; }
        { unsigned char* E8 = (unsigned char*)(ws + WS_EU); float* ESC = (float*)(ws + WS_EV);
          for (int r0 = gw; r0 < 2 * NEXP; r0 += 2 * NGW) {
            f32x4 v[2][8];
#pragma unroll
            for (int u = 0; u < 2; ++u) { const int r = r0 + u * NGW; const float* src = (r < NEXP ? eu : ev - (size_t)NEXP * DM) + (size_t)r * DM;
#pragma unroll
                for (int i = 0; i < 2; ++i)
#pragma unroll
                    for (int c = 0; c < 4; ++c) v[u][i * 4 + c] = *(const f32x4*)(src + 1024 * i + 16 * lane + 4 * c); }
#pragma unroll
            for (int u = 0; u < 2; ++u) { const int r = r0 + u * NGW; float am = 0.f;
                if (r < NEXP) {
#pragma unroll
                    for (int i = 0; i < 2; ++i)
#pragma unroll
                        for (int c = 0; c < 4; ++c) v[u][i * 4 + c] = v[u][i * 4 + c] * *(const f32x4*)(g2 + 1024 * i + 16 * lane + 4 * c); }
#pragma unroll
                for (int q = 0; q < 8; ++q) am = fmaxf(am, fmaxf(fmaxf(fabsf(v[u][q][0]), fabsf(v[u][q][1])), fmaxf(fabsf(v[u][q][2]), fabsf(v[u][q][3]))));
#pragma unroll
                for (int o = 1; o < 64; o <<= 1) am = fmaxf(am, __shfl_xor(am, o));
                int ex = (int)((__float_as_uint(am) >> 23) & 0xffu); if (ex < 16) ex = 134;
                const float sc = __uint_as_float((unsigned)(261 - ex) << 23), inv = __uint_as_float((unsigned)(ex - 7) << 23);
#pragma unroll
                for (int i = 0; i < 2; ++i) { u32x4 w;
#pragma unroll
                    for (int c = 0; c < 4; ++c) { const f32x4 t = v[u][i * 4 + c] * sc; int p = 0;
                        p = __builtin_amdgcn_cvt_pk_fp8_f32(t[0], t[1], p, false); p = __builtin_amdgcn_cvt_pk_fp8_f32(t[2], t[3], p, true); w[c] = (unsigned)p; }
                    *(u32x4*)(E8 + (size_t)(r >= NEXP) * NEXP * DM + ((size_t)(8 * i + (lane >> 3)) * NEXP + (r & (NEXP - 1))) * 128 + 16 * (lane & 7)) = w; }
                if (lane == 0) ESC[r] = inv; }
          } }
        __syncthreads();
        LAS f32x4* WfL = (LAS f32x4*)(lds + RING_OFF);
        for (int i = tid; i < 4096; i += NTHR) { const int l = i & 63, half = (i >> 6) & 1, e = (i >> 7) & 3, j = i >> 9, k = 256 * j + 4 * l + e;
            WfL[i] = *(const f32x4*)(w_in + (size_t)k * INC + 3072 + 4 * half); }
        __syncthreads();
        f32x4 gv[8];
#pragma unroll
        for (int j = 0; j < 8; ++j) gv[j] = ((const f32x4*)g1)[64 * j + lane];
        for (int row0 = gw; row0 < T; row0 += 2 * NGW) {
            asm volatile("" ::: "memory");
            f32x4 v[2][8];
#pragma unroll
            for (int u = 0; u < 2; ++u) { const f32x4* xr = (const f32x4*)(x + (size_t)(row0 + u * NGW) * DM) + lane;
#pragma unroll
                for (int j = 0; j < 8; ++j) v[u][j] = xr[64 * j]; }
#pragma unroll
            for (int u = 0; u < 2; ++u) { const int row = row0 + u * NGW; float ss = 0.f;
#pragma unroll
                for (int j = 0; j < 8; ++j) ss += (v[u][j][0] * v[u][j][0] + v[u][j][1] * v[u][j][1]) + (v[u][j][2] * v[u][j][2] + v[u][j][3] * v[u][j][3]);
                const float rstd = rsqrtf(wave_sum(ss) * (1.f / DM) + EPS);
                f32x4 a0 = {0.f, 0.f, 0.f, 0.f}, a1 = {0.f, 0.f, 0.f, 0.f};
#pragma unroll
                for (int j = 0; j < 8; ++j) { const f32x4 hv = v[u][j] * rstd * gv[j];
                    { int p8 = 0; p8 = __builtin_amdgcn_cvt_pk_fp8_f32(hv[0] * H8_SCALE, hv[1] * H8_SCALE, p8, false); p8 = __builtin_amdgcn_cvt_pk_fp8_f32(hv[2] * H8_SCALE, hv[3] * H8_SCALE, p8, true);
                      ((unsigned*)(H8 + (size_t)row * DM))[64 * j + lane] = (unsigned)p8; }
#pragma unroll
                    for (int e = 0; e < 4; ++e) { a0 += WfL[((j * 4 + e) * 2 + 0) * 64 + lane] * hv[e]; a1 += WfL[((j * 4 + e) * 2 + 1) * 64 + lane] * hv[e]; } }
                float z = 0.f;
#pragma unroll
                for (int c = 0; c < 8; ++c) { const float t = wave_sum(c < 4 ? a0[c & 3] : a1[c & 3]); if (lane == c) z = t; }
                if (lane < 8) { z += fbias[lane]; LOGF[(size_t)row * 8 + lane] = fminf(z, 0.f) - log1pf(expf(-fabsf(z))); } }
        }
    }
    SEAM(0);
    if (IN(1)) {
        if (bx < 32) {   const int lane = lane_now(), tid = wave * 64 + lane;
            LAS float* wsum = (LAS float*)(lds + EPI_OFF);
            const int b = bx >> 3, h = bx & 7; float v[8]; float run = 0.f;
#pragma unroll
            for (int i = 0; i < 8; ++i) { run += LOGF[((size_t)(b * S + tid * 8 + i)) * 8 + h]; v[i] = run; }
            float inc = run;
#pragma unroll
            for (int o = 1; o < 64; o <<= 1) { const float t = __shfl_up(inc, o); if (lane >= o) inc += t; }
            if (lane == 63) wsum[wave] = inc;
            __syncthreads();
            float base = inc - run;
            for (int w = 0; w < wave; ++w) base += wsum[w];
#pragma unroll
            for (int i = 0; i < 8; ++i) CS[(size_t)bx * S + tid * 8 + i] = (base + v[i]) * INV_SCALE;
            __syncthreads();
        }
        { pg8::SchedStd Sc{(const char*)H8, (const char*)W8, (size_t)256 * DM, (size_t)256 * DM, 0, T / 256, NPROJ / 256, (T / 256) * (NPROJ / 256), G, bx};
          EpiProj E{Qb, Kb, Vb, PIN, Gt, gq, gk, (LAS float*)(lds + EPI_OFF), 1.f / (H8_SCALE * W8_SCALE)};
          pg8::gemm_phase<true>(lds + RING_OFF, wave, DM / 2, DM / 2, DM / 2, Sc, E); }
    }
    SEAM(1);
    if (IN(2)) {
        const int lane = lane_now(), sub = lane >> 4, l16 = lane & 15;
#define POOL_BODY(W) do { \
            const int s0 = rb * 8, sq = s0 & (S - 1); const bf16_t* pp = PIN + (size_t)s0 * PW + ch; \
            f32x4 Pa[W + 7], Pb[W + 7]; \
            _Pragma("unroll") for (int r = 0; r < W + 7; ++r) { const int rel = r - (W - 1); \
                if (sq + rel >= 0) unpack8(*(const u32x4*)(pp + (long)rel * PW), Pa[r], Pb[r]); else { Pa[r] = (f32x4){0.f, 0.f, 0.f, 0.f}; Pb[r] = Pa[r]; } } \
            f32x4 Sa = {0.f, 0.f, 0.f, 0.f}, Sb = Sa; \
            _Pragma("unroll") for (int r = 0; r < W - 1; ++r) { Sa += Pa[r]; Sb += Pb[r]; } \
            _Pragma("unroll") for (int r = 0; r < 8; ++r) { Sa += Pa[r + W - 1]; Sb += Pb[r + W - 1]; \
                const int cnt = (sq + r + 1 < W) ? sq + r + 1 : W; const float inv = 1.f / (float)cnt; \
                *(u32x4*)(POOLED + (size_t)(s0 + r) * PW + ch) = pack8(Sa * inv - Pa[r + W - 1], Sb * inv - Pb[r + W - 1]); \
                Sa -= Pa[r]; Sb -= Pb[r]; } } while (0)
        for (int itp = gw; itp < 4 * (T / 16); itp += NGW) {
            const int g = itp & 3, rb = (itp >> 2) * 2 + (lane >> 5), ch = g * 256 + (lane & 31) * 8;
            if (g == 0) POOL_BODY(2); else if (g == 1) POOL_BODY(4); else if (g == 2) POOL_BODY(8); else POOL_BODY(16);
        }
#undef POOL_BODY
    }
    SEAM(2);
    if (IN(3)) {
        float bq;
        { const int lane = lane_now(); float a = fmaxf(fabsf(gq[lane]), fabsf(gq[64 + lane])), b2 = fmaxf(fabsf(gk[lane]), fabsf(gk[64 + lane]));
#pragma unroll
          for (int o = 1; o < 64; o <<= 1) { a = fmaxf(a, __shfl_xor(a, o)); b2 = fmaxf(b2, __shfl_xor(b2, o)); }
          bq = 128.f * SCALE * a * b2 + EPS; }
        const float cmargin = (30.f + 2.f * bq) * INV_SCALE;
#define ATT_JLO(Chp, qb) ({ const int lane_ = lane_now(), nte_ = 4 * ((qb) + 1); const float thr_ = (Chp)[(qb) * 256] + cmargin; \
            const float v_ = (lane_ < nte_) ? (Chp)[64 * lane_ + 63] : -3.0e38f; const int n_ = (int)__builtin_popcountll(__ballot(v_ > thr_)); \
            __builtin_amdgcn_readfirstlane(n_ < nte_ - 4 ? n_ : nte_ - 4); })
        for (int L = vcu; L < Bn * NH * 8; L += G) {
            const int bh = L >> 3, xq = L & 7, b = bh >> 3, h = bh & 7;
            const bf16_t* Kh = Kb + (size_t)bh * S * HD; const bf16_t* Vh = Vb + (size_t)bh * S * HD; const float* Ch = CS + (size_t)bh * S;
            const int j0 = ATT_JLO(Ch, xq), j1 = ATT_JLO(Ch, 15 - xq);
            att::BlockRef r0{Qb + ((size_t)bh * S + xq * 256) * HD, Kh, Vh, Ch, (unsigned char*)Ob + ((size_t)(b * S + xq * 256)) * FW + h * HD, xq * 256, j0};
            att::BlockRef r1{Qb + ((size_t)bh * S + (15 - xq) * 256) * HD, Kh, Vh, Ch, (unsigned char*)Ob + ((size_t)(b * S + (15 - xq) * 256)) * FW + h * HD, (15 - xq) * 256, j1};
            att::Seam Sm;
            att::attn_prime(r0, (char*)lds_raw, Sm, wave);
            att::attn_block(r0, r1, (char*)lds_raw, Sm, wave);
            att::attn_block(r1, r1, (char*)lds_raw, Sm, wave);
        }
#undef ATT_JLO
        VM_WAIT(); __syncthreads();
        pg8::SchedStd Sc{(const char*)POOLED, (const char*)WT_PG, (size_t)256 * PW * 2, (size_t)256 * 256 * 2, (size_t)256 * 2, T / 256, PW / 256, (T / 256) * (PW / 256), G, bx};
        EpiPool2 E{POOL2, pscale};
        pg8::gemm_phase(lds + RING_OFF, wave, 256, PW, 256, Sc, E);
    }
    SEAM(3);
    if (IN(4)) {
        { pg8::SchedStd Sc{(const char*)Ob, (const char*)WT_BA, (size_t)256 * FW, (size_t)256 * FW, 0, T / 256, DM / 256, (T / 256) * (DM / 256), G, bx};
          EpiBranch<0> E{TMP, MERGED, Gt, 1.f / (att::O8_SCALE * W8_SCALE)};
          pg8::gemm_phase<true>(lds + RING_OFF, wave, FW / 2, FW / 2, FW / 2, Sc, E); }
        { pg8::SchedStd Sc{(const char*)POOL2, (const char*)WT_BP, (size_t)256 * FW * 2, (size_t)256 * FW * 2, 0, T / 256, DM / 256, (T / 256) * (DM / 256), G, bx};
          EpiBranch<1> E{TMP, MERGED, Gt, 1.f};
          pg8::gemm_phase(lds + RING_OFF, wave, FW, FW, FW, Sc, E); }
    }
    SEAM(4);
    if (IN(5)) {
        pg8::SchedStd Sc{(const char*)MERGED, (const char*)WT_OUT, (size_t)256 * DM * 2, (size_t)256 * DM * 2, 0, T / 256, DM / 256, (T / 256) * (DM / 256), G, bx};
        EpiOut E{x, XG, SSQ};
        pg8::gemm_phase(lds + RING_OFF, wave, DM, DM, DM, Sc, E);
    }
    SEAM(5);
    if (IN(6)) {
        pg8::SchedStd Sc{(const char*)XG, (const char*)WT_Q, (size_t)256 * DM * 2, (size_t)256 * DM * 2, 0, T / 256, DM / 256, (T / 256) * (DM / 256), G, bx};
        EpiBf16 E{QP, DM};
        pg8::gemm_phase(lds + RING_OFF, wave, DM, DM, DM, Sc, E);
    }
    SEAM(6);

    if (IN(7)) {
        const int lane = lane_now(), tid = wave * 64 + lane, r32 = lane & 31, hi = lane >> 5, h = vcu & 7;
#pragma unroll
        for (int i = 0; i < 8; ++i) { const int idx = tid + 512 * i, le = idx & 63, ks = (idx >> 6) & 7, tile = (idx >> 9) & 3, f = idx >> 11;
            const u32x4 v = *(const u32x4*)(SK + ((size_t)(h * 256 + f * 128 + 32 * tile + (le & 31)) * 128 + 16 * ks + 8 * (le >> 5)));
            *(LAS u32x4*)(lds + idx * 16) = v; }
        __syncthreads();
        LAS unsigned* scr = (LAS unsigned*)(lds + peer::SCR_OFF + wave * 8192) + lane;
        const unsigned nh4 = (unsigned)(1 - hi) << 2; const float NEGINF = -__builtin_inff();
        int* IDX = (int*)(ws + WS_IDX); float* GATE = (float*)(ws + WS_GATE);
        for (int tl = vcu >> 3; tl < T / 256; tl += G >> 3) {
            const int tok = tl * 256 + wave * 32 + r32;
            bf16x8 qf[2][8];
#pragma unroll
            for (int f = 0; f < 2; ++f)
#pragma unroll
                for (int ks = 0; ks < 8; ++ks) qf[f][ks] = *(const bf16x8*)(QP + (size_t)tok * DM + h * 256 + f * 128 + 16 * ks + 8 * hi);
            float tot = 0.f;
#pragma unroll
            for (int i = 0; i < 8; ++i) { const f32x4 v = *(const f32x4*)(SSQ + (size_t)tok * 32 + 4 * i); tot += (v[0] + v[1]) + (v[2] + v[3]); }
            const float rstd = rsqrtf(tot * (1.f / DM) + EPS);
            float KL[2][16];
#pragma unroll
            for (int f = 0; f < 2; ++f) {
                float L[16];
#pragma unroll
                for (int i = 0; i < 16; ++i) L[i] = NEGINF;
#pragma unroll
                for (int tile = 0; tile < 4; ++tile) {
                    peer::f32x16 acc = {};
#pragma unroll
                    for (int ks = 0; ks < 8; ++ks) acc = __builtin_amdgcn_mfma_f32_32x32x16_bf16(*(const LAS bf16x8*)(lds + (((f * 4 + tile) * 8 + ks) * 64 + lane) * 16), qf[f][ks], acc, 0, 0, 0);
                    float Sk[16];
#pragma unroll
                    for (int r = 0; r < 16; ++r) { const unsigned cp = (unsigned)(127 - 32 * tile - (r & 3) - 8 * (r >> 2) - 4);
                        Sk[r] = __uint_as_float(((__float_as_uint(acc[r]) & 0xffffff80u) | nh4) | cp); }
                    peer::sort16_desc(Sk);
                    if (tile == 0) {
#pragma unroll
                        for (int i = 0; i < 16; ++i) L[i] = Sk[i]; }
                    else peer::merge16(L, Sk);
                }
                peer::merge_partner(L, hi == 0);
#pragma unroll
                for (int i = 0; i < 16; ++i) KL[f][i] = L[i];
            }
            float Tt[16];
#pragma unroll
            for (int i = 0; i < 16; ++i) Tt[i] = NEGINF;
#pragma unroll
            for (int i = 0; i < 16; ++i)
#pragma unroll
                for (int j = 0; j < 16; ++j) if ((i + 1) * (j + 1) <= 16) {
                    const float sm = __uint_as_float(__float_as_uint(KL[0][i]) & 0xffffff80u) + __uint_as_float(__float_as_uint(KL[1][j]) & 0xffffff80u);
                    peer::insert16(Tt, __uint_as_float((__float_as_uint(sm) & 0xffffff00u) | (unsigned)(255 - (16 * i + j)))); }
#pragma unroll
            for (int k = 0; k < 16; ++k) { scr[k * 64] = __float_as_uint(KL[0][k]); scr[(16 + k) * 64] = __float_as_uint(KL[1][k]); }
            LDS_WAIT();
            int ex[16]; float gt[16]; float gs = 0.f;
            const float s0 = __uint_as_float(__float_as_uint(Tt[0]) & 0xffffff00u) * rstd;
#pragma unroll
            for (int r = 0; r < 16; ++r) { const unsigned tb = __float_as_uint(Tt[r]), pos = 255u - (tb & 255u), ci = pos >> 4, cj = pos & 15u;
                const unsigned a = scr[ci * 64], b = scr[(16 + cj) * 64];
                ex[r] = (int)((127u - (a & 127u)) * 128u + (127u - (b & 127u)));
                gt[r] = __expf(__uint_as_float(tb & 0xffffff00u) * rstd - s0); gs += gt[r]; }
            const float ginv = 1.f / gs;
            if (hi == 0) { int* o = IDX + (size_t)tok * 128 + h * 16;
#pragma unroll
                for (int q4 = 0; q4 < 4; ++q4) *(int4*)(o + 4 * q4) = make_int4(ex[4 * q4], ex[4 * q4 + 1], ex[4 * q4 + 2], ex[4 * q4 + 3]); }
            else { float* o = GATE + (size_t)tok * 128 + h * 16;
#pragma unroll
                for (int q4 = 0; q4 < 4; ++q4) *(f32x4*)(o + 4 * q4) = (f32x4){gt[4 * q4] * ginv, gt[4 * q4 + 1] * ginv, gt[4 * q4 + 2] * ginv, gt[4 * q4 + 3] * ginv}; }
            LDS_WAIT();
        }
    }
    SEAM(7);
    bf16_t* PA = (bf16_t*)(ws + WS_MERGED); float* HS = (float*)(ws + WS_QP);
    if (IN(8)) {
        const int lane = lane_now(), l8 = lane & 7, lg = lane >> 3, grp = bx & 7, nwv = (G >> 3) * NWAVES, wg = (bx >> 3) * NWAVES + wave;
        const int* IDX = (const int*)(ws + WS_IDX); const unsigned char* EU8 = (const unsigned char*)(ws + WS_EU);
#define P8_IDX(E, tk) do { const int* ip_ = IDX + (size_t)((tk) < T ? (tk) : T - 1) * 128 + lane; E[0] = ip_[0]; E[1] = ip_[64]; } while (0)
#define P8_ROWS(R, E, XA, XB, tk) do { _Pragma("unroll") for (int i = 0; i < 16; ++i) { const int e_ = __shfl(E[i >> 3], ((8 * i) & 63) + lg); R[i] = *(const u32x4*)(EU8 + (unsigned)(e_ * 128 + coffT)); } \
            const bf16_t* xp_ = XG + (size_t)((tk) < T ? (tk) : T - 1) * DM + coff; XA = *(const u32x4*)xp_; XB = *(const u32x4*)(xp_ + 8); } while (0)
#define P8_DPP(x, ctrl) __uint_as_float(__builtin_amdgcn_update_dpp(0u, __float_as_uint(x), ctrl, 0xf, 0xf, false))
#define P8_COMP(R, XA, XB, tk) do { f32x2 xf[8]; \
            _Pragma("unroll") for (int d = 0; d < 4; ++d) { xf[d] = (f32x2){__uint_as_float(XA[d] << 16), __uint_as_float(XA[d] & 0xffff0000u)}; xf[4 + d] = (f32x2){__uint_as_float(XB[d] << 16), __uint_as_float(XB[d] & 0xffff0000u)}; } \
            float sd[16]; \
            _Pragma("unroll") for (int i = 0; i < 16; ++i) { f32x2 a2 = {0.f, 0.f}; \
                _Pragma("unroll") for (int d = 0; d < 4; ++d) { a2 += __builtin_amdgcn_cvt_pk_f32_fp8((int)R[i][d], false) * xf[2 * d]; a2 += __builtin_amdgcn_cvt_pk_f32_fp8((int)R[i][d], true) * xf[2 * d + 1]; } \
                sd[i] = a2[0] + a2[1]; } \
              \
            float s8[8], s4[4], s2_[2]; \
            _Pragma("unroll") for (int k = 0; k < 8; ++k) { const float keep = q2 ? sd[k + 8] : sd[k], give = q2 ? sd[k] : sd[k + 8]; s8[k] = keep + P8_DPP(give, 0x141); }     \
            _Pragma("unroll") for (int k = 0; k < 4; ++k) { const float keep = q1 ? s8[k + 4] : s8[k], give = q1 ? s8[k] : s8[k + 4]; s4[k] = keep + P8_DPP(give, 0x4E); }      \
            _Pragma("unroll") for (int k = 0; k < 2; ++k) { const float keep = q0 ? s4[k + 2] : s4[k], give = q0 ? s4[k] : s4[k + 2]; s2_[k] = keep + P8_DPP(give, 0xB1); }     \
            if ((tk) < T) *(unsigned*)(PA + ((size_t)(tk) * 16 + c) * 128 + 2 * lane) = cvt_pk_bf16(s2_[0], s2_[1]); } while (0)
        const bool q2 = (lane & 4) != 0, q1 = (lane & 2) != 0, q0 = (lane & 1) != 0;
        LAS unsigned* wq = (LAS unsigned*)(lds + MISC_OFF + 128);
        if (lane == 0 && wave == 0) { wq[0] = 0u; wq[1] = 0u; }
        __syncthreads();
        const int tok0 = (bx >> 3) * NWAVES, npair = (T / nwv) * NWAVES / 2;
#define WQ_NEXT(slot) __builtin_amdgcn_readfirstlane((int)(lane == 0 ? __hip_atomic_fetch_add(wq + (slot), 1u, __ATOMIC_RELAXED, __HIP_MEMORY_SCOPE_WORKGROUP) : 0u))
#define WQ_TOK(p, k) ((p) < npair ? tok0 + ((2 * (p) + (k)) & 7) + nwv * ((2 * (p) + (k)) >> 3) : T)
        for (int c = grp, pass = 0; c < 16; c += 8, ++pass) {
            const int coff = 128 * c + 16 * l8, coffT = c * NEXP * 128 + 16 * l8;
            int eA[2], eB[2]; u32x4 rA[16], rB[16]; u32x4 xA0, xA1, xB0, xB1;
            int p = WQ_NEXT(pass); int ta = WQ_TOK(p, 0), tb = WQ_TOK(p, 1);
            P8_IDX(eA, ta); P8_ROWS(rA, eA, xA0, xA1, ta); P8_IDX(eB, tb);
#pragma unroll 1
            while (p < npair) {
                const int pn = WQ_NEXT(pass); const int na = WQ_TOK(pn, 0), nb = WQ_TOK(pn, 1);
                P8_ROWS(rB, eB, xB0, xB1, tb); P8_IDX(eA, na);
                P8_COMP(rA, xA0, xA1, ta);
                P8_ROWS(rA, eA, xA0, xA1, na); P8_IDX(eB, nb);
                P8_COMP(rB, xB0, xB1, tb);
                p = pn; ta = na; tb = nb;
            }
        }
#undef P8_IDX
#undef P8_ROWS
#undef P8_COMP
#undef P8_DPP
    }
    SEAM(8);
    if (IN(9)) {
        const int lane = lane_now();
        const int* IDX = (const int*)(ws + WS_IDX); const float* GATE = (const float*)(ws + WS_GATE); const float* ESC = (const float*)(ws + WS_EV);
        for (int t = gw; t < T; t += NGW) {
            const float pss = lane < 32 ? SSQ[(size_t)t * 32 + lane] : 0.f;
            const float rstd = rsqrtf(wave_sum(pss) * (1.f / DM) + EPS);
#pragma unroll
            for (int hh = 0; hh < 2; ++hh) { const int j = 64 * hh + lane; float a = 0.f;
#pragma unroll
                for (int c = 0; c < 16; ++c) a += bf2f(PA[((size_t)t * 16 + c) * 128 + (j & 7) * 16 + (j >> 3)]);
                const int e = IDX[(size_t)t * 128 + j];
                a *= ESC[e] * rstd;
                const float ge = 0.5f * a * (1.f + tanhf(0.7978845608028654f * (a + 0.044715f * a * a * a)));
                HS[(size_t)t * 128 + j] = ge * GATE[(size_t)t * 128 + j] * ESC[NEXP + e]; }
        }
    }
    SEAM(9);
    if (IN(10)) {
        const int lane = lane_now(), l8 = lane & 7, lg = lane >> 3, grp = bx & 7, nwv = (G >> 3) * NWAVES, wg = (bx >> 3) * NWAVES + wave;
        const int* IDX = (const int*)(ws + WS_IDX); const unsigned char* EV8 = (const unsigned char*)(ws + WS_EU) + (size_t)NEXP * DM;
        float* outp = args.out;
        const bool b16 = (lane & 16) != 0, b8 = (lane & 8) != 0;
#define P10_LOADE(E, tk) do { const int* ip_ = IDX + (size_t)((tk) < T ? (tk) : T - 1) * 128 + lane; E[0] = ip_[0]; E[1] = ip_[64]; } while (0)
#define P10_LOADH(H, tk) do { const float* hp_ = HS + (size_t)((tk) < T ? (tk) : T - 1) * 128 + lane; H[0] = hp_[0]; H[1] = hp_[64]; } while (0)
#define P10_ROWS(R, E, O, tk) do { _Pragma("unroll") for (int i = 0; i < 16; ++i) { const int e_ = __shfl(E[i >> 3], ((8 * i) & 63) + lg); R[i] = *(const u32x4*)(EV8 + (unsigned)(e_ * 128 + coffT)); } \
            { const unsigned w_ = *(const unsigned*)(XG + (size_t)((tk) < T ? (tk) : T - 1) * DM + coff + 2 * lg); O = (f32x2){__uint_as_float(w_ << 16), __uint_as_float(w_ & 0xffff0000u)}; } } while (0)
#define P10_COMP(R, H, O, tk) do { f32x2 acc[8]; \
            _Pragma("unroll") for (int d = 0; d < 8; ++d) acc[d] = (f32x2){0.f, 0.f}; \
            _Pragma("unroll") for (int i = 0; i < 16; ++i) { const float h_ = __shfl(H[i >> 3], ((8 * i) & 63) + lg); _Pragma("unroll") for (int d = 0; d < 4; ++d) { \
                acc[2 * d] += __builtin_amdgcn_cvt_pk_f32_fp8((int)R[i][d], false) * h_; acc[2 * d + 1] += __builtin_amdgcn_cvt_pk_f32_fp8((int)R[i][d], true) * h_; } } \
              \
            float f8[8], f4[4], f2[2]; \
            _Pragma("unroll") for (int k = 0; k < 8; ++k) { auto r_ = __builtin_amdgcn_permlane32_swap(__float_as_uint(acc[k >> 1][k & 1]), __float_as_uint(acc[(k + 8) >> 1][k & 1]), false, false); f8[k] = __uint_as_float(r_[0]) + __uint_as_float(r_[1]); } \
            _Pragma("unroll") for (int k = 0; k < 4; ++k) { const float keep = b16 ? f8[k + 4] : f8[k], give = b16 ? f8[k] : f8[k + 4]; f4[k] = keep + __shfl_xor(give, 16); } \
            _Pragma("unroll") for (int k = 0; k < 2; ++k) { const float keep = b8 ? f4[k + 2] : f4[k], give = b8 ? f4[k] : f4[k + 2]; f2[k] = keep + __shfl_xor(give, 8); } \
            if ((tk) < T) { f32x2 v_ = O; v_[0] += f2[0]; v_[1] += f2[1]; *(f32x2*)(outp + (size_t)(tk) * DM + coff + 2 * lg) = v_; } } while (0)
        LAS unsigned* wq = (LAS unsigned*)(lds + MISC_OFF + 128);
        if (lane == 0 && wave == 0) { wq[2] = 0u; wq[3] = 0u; }
        __syncthreads();
        const int tok0 = (bx >> 3) * NWAVES, npair = (T / nwv) * NWAVES / 2;
        for (int c = grp, pass = 0; c < 16; c += 8, ++pass) {
            const int coff = 128 * c + 16 * l8, coffT = c * NEXP * 128 + 16 * l8;
            int e[2]; float hA[2], hB[2]; u32x4 rA[16], rB[16]; f32x2 oA, oB;
            int p = WQ_NEXT(2 + pass); int ta = WQ_TOK(p, 0), tb = WQ_TOK(p, 1);
            P10_LOADE(e, ta); P10_ROWS(rA, e, oA, ta); P10_LOADH(hA, ta); P10_LOADE(e, tb);
#pragma unroll 1
            while (p < npair) {
                const int pn = WQ_NEXT(2 + pass); const int na = WQ_TOK(pn, 0), nb = WQ_TOK(pn, 1);
                P10_ROWS(rB, e, oB, tb); P10_LOADH(hB, tb); P10_LOADE(e, na);
                P10_COMP(rA, hA, oA, ta);
                P10_ROWS(rA, e, oA, na); P10_LOADH(hA, na); P10_LOADE(e, nb);
                P10_COMP(rB, hB, oB, tb);
                p = pn; ta = na; tb = nb;
            }
        }
#undef WQ_NEXT
#undef WQ_TOK
#undef P10_LOADE
#undef P10_LOADH
#undef P10_ROWS
#undef P10_COMP
    }
#undef IN
#undef SEAM
}

static int g_grid = 0;
static void launch_mega(const Args& a0, int lo, int hi, hipStream_t stream) {
    Args a = a0; a.ph_lo = lo; a.ph_hi = hi;
    hipLaunchKernelGGL(mega, dim3(g_grid), dim3(NTHR), LDS_BYTES, stream, a);
}

extern "C" void kernel_launch(void* const* d_in, const int* in_sizes, int n_in, void* d_out, int out_size, void* d_ws, size_t ws_size, hipStream_t stream) {
    if (n_in != 17 || out_size != T * DM || ws_size < 512 * MiB) { fprintf(stderr, "kernel_launch: unexpected shapes n_in=%d out=%d ws=%zu\n", n_in, out_size, ws_size); return; }
    if (g_grid == 0) {
        int dev = 0, cus = 0;
        if (hipGetDevice(&dev) != hipSuccess || hipDeviceGetAttribute(&cus, hipDeviceAttributeMultiprocessorCount, dev) != hipSuccess) { fprintf(stderr, "kernel_launch: device query failed\n"); g_grid = -1; return; }
        if (hipFuncSetAttribute((const void*)mega, hipFuncAttributeMaxDynamicSharedMemorySize, LDS_BYTES) != hipSuccess) { fprintf(stderr, "kernel_launch: hipFuncSetAttribute failed\n"); g_grid = -1; return; }
        if (cus < 256) { fprintf(stderr, "kernel_launch: this kernel needs 256 co-resident workgroups (one per CU); the device has %d CUs\n", cus); g_grid = -1; return; }
        g_grid = 256;
    }
    if (g_grid < 0) return;
    char* ws = (char*)d_ws; float* out = (float*)d_out;
    (void)hipMemsetAsync(ws + WS_CTL + CW_BAR * 4, 0, XCD_BAR_WORDS * 4, stream);
    Args a{}; for (int i = 0; i < 17; ++i) a.in[i] = (const float*)d_in[i]; a.out = out; a.ws = (unsigned char*)d_ws;
    launch_mega(a, 0, N_PHASES, stream);
}
```

```cpp
#include <hip/hip_runtime.h>
#include <cstdio>
#include <cstdint>

typedef unsigned short bf16_t;
constexpr int Bn = 4, S = 4096, DM = 2048, T = Bn * S, NH = 8, HD = 128, FW = 1024, PW = 1024;
constexpr int INC = 8200, NPROJ = 8192;
constexpr int PH = 8, PK = 128, PQD = 256, TOPK = 16, NEXP = 16384;
constexpr float EPS = 1e-6f;
constexpr float SCALE = 0.08838834764831845f;
constexpr float INV_SCALE = 11.313708498984761f;
constexpr size_t MiB = 1u << 20;
constexpr size_t WS_WT_PG = 1 * MiB, WS_WT_BA = 2 * MiB, WS_WT_BP = 6 * MiB, WS_WT_OUT = 10 * MiB, WS_WT_Q = 18 * MiB, WS_SK = 26 * MiB, WS_SKB = 27 * MiB,
                 WS_CS = 28 * MiB, WS_LOGF = 29 * MiB, WS_SSQ = 30 * MiB, WS_IDX = 32 * MiB, WS_GATE = 40 * MiB,
                 WS_Q = 48 * MiB, WS_K = 80 * MiB, WS_V = 112 * MiB, WS_PIN = 144 * MiB, WS_G = 176 * MiB, WS_EU = 304 * MiB, WS_EV = 368 * MiB, WS_XG = 432 * MiB,
                 WS_TMP = 48 * MiB, WS_MERGED = 112 * MiB, WS_QP = 48 * MiB, WS_RAWQ = 304 * MiB, WS_RAWK = 368 * MiB, WS_SC = 176 * MiB;
constexpr size_t DO_H1 = 0, DO_WT_IN = 64 * MiB, DO_O = 0, DO_POOLED = 32 * MiB, DO_POOL2 = 64 * MiB;

__device__ __forceinline__ float bf2f(bf16_t v) { return __uint_as_float(((unsigned)v) << 16); }
__device__ __forceinline__ bf16_t f2bf(float f) { unsigned u = __float_as_uint(f); return (bf16_t)((u + 0x7fffu + ((u >> 16) & 1u)) >> 16); }


#define LAS __attribute__((address_space(3)))
#define GAS __attribute__((address_space(1)))
typedef short bf16x8 __attribute__((ext_vector_type(8)));
typedef float f32x4 __attribute__((ext_vector_type(4)));
typedef float f32x2 __attribute__((ext_vector_type(2)));
typedef unsigned u32x4 __attribute__((ext_vector_type(4)));
typedef unsigned u32x2 __attribute__((ext_vector_type(2)));
typedef int v8i_t __attribute__((ext_vector_type(8)));
typedef int i32x4_t __attribute__((ext_vector_type(4)));
constexpr int NWAVES = 8, NTHR = 512;
constexpr int RING_OFF = 0, RING_BYTES = 131072, EPI_OFF = 131072, EPI_BYTES = 16384, MISC_OFF = EPI_OFF + EPI_BYTES, LDS_BYTES = MISC_OFF + 512;
constexpr size_t WS_CTL = 0, CTL_ZERO_BYTES = 65536;
constexpr int CW_BAR = 1024;

__device__ __forceinline__ unsigned cvt_pk_bf16(float lo, float hi) { unsigned r; asm volatile("s_nop 0\n\tv_cvt_pk_bf16_f32 %0, %1, %2" : "=v"(r) : "v"(lo), "v"(hi)); return r; }
__device__ __forceinline__ float wave_sum(float v) {
#pragma unroll
    for (int o = 1; o < 64; o <<= 1) v += __shfl_xor(v, o);
    return v;
}
__device__ __forceinline__ int lane_now() { int l; asm volatile("v_mbcnt_lo_u32_b32 %0, -1, 0\n\tv_mbcnt_hi_u32_b32 %0, -1, %0" : "=v"(l)); return l; }
#define LDS_WAIT() asm volatile("s_waitcnt lgkmcnt(0)" ::: "memory")
#define VM_WAIT() asm volatile("s_waitcnt vmcnt(0)" ::: "memory")

namespace pg8 {
constexpr int BM = 256, BK = 64, HALF = 128, HTB = HALF * BK * 2, STAGE_BYTES = 8 * HTB, NXCD = 8, WGM = 8;
__host__ __device__ __forceinline__ int lds_byte(int r, int c) { const int st = (r >> 4) * 2 + (c >> 5), rr = r & 15, cc = c & 31, ob = rr * 64 + cc * 2; return st * 1024 + (ob ^ (((ob >> 9) & 1) << 5)); }
__host__ __device__ __forceinline__ void stage_rc(int b, int& R, int& C) { const int st = b / 1024, sb = b % 1024, swz = sb ^ (((sb >> 9) & 1) << 5); R = (st >> 1) * 16 + swz / 64; C = (st & 1) * 32 + (swz % 64) / 2; }
__host__ __device__ __forceinline__ int perm32(int rho) { const int n = rho >> 4, i = rho & 15; return 8 * (i >> 2) + 4 * n + (i & 3); }
struct Unit { int pm, pn, aux; };
__device__ __forceinline__ void order_map(int L, int nM, int nN, int nwg, Unit& u) {
    int wgid = L; { const int q = nwg / NXCD, r = nwg % NXCD, xcd = wgid % NXCD, off = wgid / NXCD; wgid = (xcd < r ? xcd * (q + 1) : r * (q + 1) + (xcd - r) * q) + off; }
    const int nig = WGM * nN, gid = wgid / nig, fm = gid * WGM, gsz = (nM - fm) < WGM ? (nM - fm) : WGM;
    u.pm = fm + ((wgid % nig) % gsz); u.pn = (wgid % nig) / gsz; u.aux = 0;
}
struct SchedStd {
    const char* A; const char* Bt; size_t a_tile, b_tile, a_kstride; int nM, nN, nwg, G, c;
    __device__ __forceinline__ bool next(int i, Unit& u) const { const long L = (long)i * G + c; if (L >= nwg) return false; order_map((int)L, nM, nN, nwg, u); return true; }
    __device__ __forceinline__ const char* a_ptr(const Unit& u) const { return A + (size_t)u.pm * a_tile + (size_t)u.pn * a_kstride; }
    __device__ __forceinline__ const char* b_ptr(const Unit& u) const { return Bt + (size_t)u.pn * b_tile; }
};
struct SchedPair {
    const char* A0; const char* A1; const char* B0; const char* B1; size_t a_tile, b_tile; int nM, nN, nwg, G, c;
    __device__ __forceinline__ bool next(int i, Unit& u) const { const long L = (long)(i >> 1) * G + c; if (L >= nwg) return false; order_map((int)L, nM, nN, nwg, u); u.aux = i & 1; return true; }
    __device__ __forceinline__ const char* a_ptr(const Unit& u) const { return (u.aux ? A1 : A0) + (size_t)u.pm * a_tile; }
    __device__ __forceinline__ const char* b_ptr(const Unit& u) const { return (u.aux ? B1 : B0) + (size_t)u.pn * b_tile; }
};
typedef f32x4 Acc[2][2][4][2];

template <bool FP8 = false, class Epi, class Sched>
__device__ __forceinline__ void gemm_phase(LAS unsigned char* lds, const int wid, const int K, const int lda, const int ldb, const Sched& S, const Epi& E) {
    const int lane = lane_now(), tid = wid * 64 + lane, wr = wid >> 2, wc = wid & 3, fr = lane & 15, fq = lane >> 4;
    const int nt = K / BK;
    unsigned voffA[2], voffB[2];
#pragma unroll
    for (int i = 0; i < 2; ++i) { int R, C; stage_rc(tid * 16 + i * 8192, R, C); const int Rb = (R & ~31) + perm32(R & 31);
        voffA[i] = (unsigned)(R * lda + C) * 2u; voffB[i] = (unsigned)(Rb * ldb + C) * 2u; }
    const size_t kstep = (size_t)(BK * 2);
    const size_t hstepA = (size_t)HALF * lda * 2, hstepB = (size_t)HALF * ldb * 2;
    const unsigned ldsw = (unsigned)wid * 1024u;
    const int aoff = lds_byte(wr * 64 + fr, fq * 8), boff = lds_byte(wc * 32 + fr, fq * 8);
#define PG8_SA(b, h) (((b) * 2 + (h)) * HTB)
#define PG8_SB(b, h) ((4 + (b) * 2 + (h)) * HTB)
#define PG8_STAGE(bufoff, gbase, voff) do { _Pragma("unroll") for (int _i = 0; _i < 2; ++_i) \
        __builtin_amdgcn_global_load_lds((const unsigned*)((const char*)(gbase) + (voff)[_i]), (LAS unsigned*)(lds + (bufoff) + ldsw + _i * 8192), 16, 0, 0); } while (0)
#define PG8_LDA(dst, b, h) do { if constexpr (FP8) { _Pragma("unroll") for (int m = 0; m < 4; ++m) dst##8[m] = __builtin_shufflevector(*(const LAS i32x4_t*)(lds + PG8_SA(b, h) + aoff + m * 2048), *(const LAS i32x4_t*)(lds + PG8_SA(b, h) + aoff + m * 2048 + 1024), 0, 1, 2, 3, 4, 5, 6, 7); } \
        else { _Pragma("unroll") for (int m = 0; m < 4; ++m) _Pragma("unroll") for (int k = 0; k < 2; ++k) dst[m][k] = *(const LAS bf16x8*)(lds + PG8_SA(b, h) + aoff + m * 2048 + k * 1024); } } while (0)
#define PG8_LDB(dst, b, h) do { if constexpr (FP8) { _Pragma("unroll") for (int n = 0; n < 2; ++n) dst##8[n] = __builtin_shufflevector(*(const LAS i32x4_t*)(lds + PG8_SB(b, h) + boff + n * 2048), *(const LAS i32x4_t*)(lds + PG8_SB(b, h) + boff + n * 2048 + 1024), 0, 1, 2, 3, 4, 5, 6, 7); } \
        else { _Pragma("unroll") for (int n = 0; n < 2; ++n) _Pragma("unroll") for (int k = 0; k < 2; ++k) dst[n][k] = *(const LAS bf16x8*)(lds + PG8_SB(b, h) + boff + n * 2048 + k * 1024); } } while (0)
#define PG8_MMA(ai, bj, At, Bt) do { if constexpr (!FP8) __builtin_amdgcn_s_setprio(1);     \
        if constexpr (FP8) { _Pragma("unroll") for (int m = 0; m < 4; ++m) _Pragma("unroll") for (int n = 0; n < 2; ++n) \
            acc[ai][bj][m][n] = __builtin_amdgcn_mfma_scale_f32_16x16x128_f8f6f4(Bt##8[n], At##8[m], acc[ai][bj][m][n], 0, 0, 0, 0x7f7f7f7f, 0, 0x7f7f7f7f); } \
        else { _Pragma("unroll") for (int m = 0; m < 4; ++m) _Pragma("unroll") for (int n = 0; n < 2; ++n) _Pragma("unroll") for (int k = 0; k < 2; ++k) \
            acc[ai][bj][m][n] = __builtin_amdgcn_mfma_f32_16x16x32_bf16(Bt[n][k], At[m][k], acc[ai][bj][m][n], 0, 0, 0); } \
        __builtin_amdgcn_s_setprio(0); } while (0)
#define PG8_WAIT_V(n) asm volatile("s_waitcnt vmcnt(" #n ")" ::: "memory")
#define PG8_WAIT_L(n) asm volatile("s_waitcnt lgkmcnt(" #n ")" ::: "memory")
#define PG8_BAR __builtin_amdgcn_s_barrier()
#define PG8_SCHED __builtin_amdgcn_sched_barrier(0)
    Unit cur, nxt; int ui = 0;
    if (!S.next(0, cur)) return;
    Acc acc;
#pragma unroll
    for (int a = 0; a < 2; ++a)
#pragma unroll
        for (int b = 0; b < 2; ++b)
#pragma unroll
            for (int m = 0; m < 4; ++m)
#pragma unroll
                for (int n = 0; n < 2; ++n) acc[a][b][m][n] = (f32x4){0.f, 0.f, 0.f, 0.f};
    bf16x8 At[4][2], B0[2][2], B1[2][2]; v8i_t At8[4], B08[2], B18[2];
    const char* cA = S.a_ptr(cur); const char* cB = S.b_ptr(cur);
    PG8_STAGE(PG8_SB(0, 0), cB, voffB); PG8_STAGE(PG8_SB(0, 1), cB + hstepB, voffB); PG8_STAGE(PG8_SA(0, 0), cA, voffA); PG8_STAGE(PG8_SA(0, 1), cA + hstepA, voffA);
    if (wr == 1) PG8_BAR;
    PG8_WAIT_V(2); PG8_BAR;
    PG8_STAGE(PG8_SB(1, 0), cB + kstep, voffB); PG8_STAGE(PG8_SA(1, 0), cA + kstep, voffA); PG8_STAGE(PG8_SB(1, 1), cB + hstepB + kstep, voffB);
    PG8_WAIT_V(6); PG8_BAR;
#pragma unroll 1
    for (;;) {
        const bool has_next = S.next(ui + 1, nxt);
        const char* nA = has_next ? S.a_ptr(nxt) : cA; const char* nB = has_next ? S.b_ptr(nxt) : cB;
#pragma unroll 1
        for (int t = 0; t < nt; t += 2) {
            const bool last = (t == nt - 2);
            const char* a1 = cA + (size_t)(t + 1) * kstep;
            const char* a2 = last ? nA : cA + (size_t)(t + 2) * kstep; const char* b2 = last ? nB : cB + (size_t)(t + 2) * kstep;
            const char* a3 = a2 + kstep; const char* b3 = b2 + kstep;
            PG8_LDB(B0, 0, 0); PG8_LDB(B1, 0, 1); PG8_SCHED; PG8_LDA(At, 0, 0); PG8_STAGE(PG8_SA(1, 1), a1 + hstepA, voffA);
            PG8_WAIT_V(8); PG8_WAIT_L(0); PG8_BAR; PG8_MMA(0, 0, At, B0); PG8_MMA(0, 1, At, B1); PG8_BAR; PG8_SCHED;
            PG8_LDA(At, 0, 1); PG8_STAGE(PG8_SB(0, 0), b2, voffB); PG8_STAGE(PG8_SB(0, 1), b2 + hstepB, voffB); PG8_STAGE(PG8_SA(0, 0), a2, voffA);
            PG8_WAIT_V(8); PG8_WAIT_L(0); PG8_BAR; PG8_MMA(1, 0, At, B0); PG8_MMA(1, 1, At, B1); PG8_BAR; PG8_SCHED;
            PG8_LDB(B0, 1, 0); PG8_LDB(B1, 1, 1); PG8_SCHED; PG8_LDA(At, 1, 0); PG8_STAGE(PG8_SA(0, 1), a2 + hstepA, voffA);
            PG8_WAIT_V(8); PG8_WAIT_L(0); PG8_BAR; PG8_MMA(0, 0, At, B0); PG8_MMA(0, 1, At, B1); PG8_BAR; PG8_SCHED;
            PG8_LDA(At, 1, 1); PG8_STAGE(PG8_SB(1, 0), b3, voffB); PG8_STAGE(PG8_SB(1, 1), b3 + hstepB, voffB); PG8_STAGE(PG8_SA(1, 0), a3, voffA);
            PG8_WAIT_V(8); PG8_WAIT_L(0); PG8_BAR; PG8_MMA(1, 0, At, B0); PG8_MMA(1, 1, At, B1); PG8_BAR; PG8_SCHED;
        }
        if (wr == 0) PG8_BAR;
        E(acc, cur, ui, wid);
        if (!has_next) break;
#pragma unroll
        for (int a = 0; a < 2; ++a)
#pragma unroll
            for (int b = 0; b < 2; ++b)
#pragma unroll
                for (int m = 0; m < 4; ++m)
#pragma unroll
                    for (int n = 0; n < 2; ++n) acc[a][b][m][n] = (f32x4){0.f, 0.f, 0.f, 0.f};
        cur = nxt; cA = nA; cB = nB; ++ui;
        if (wr == 1) PG8_BAR;
    }
    PG8_WAIT_V(0);
    PG8_BAR;
#undef PG8_SA
#undef PG8_SB
#undef PG8_STAGE
#undef PG8_LDA
#undef PG8_LDB
#undef PG8_MMA
#undef PG8_WAIT_V
#undef PG8_WAIT_L
#undef PG8_BAR
#undef PG8_SCHED
}
}

using pg8::Acc; using pg8::Unit;
__device__ __forceinline__ u32x4 pack8(const f32x4 a, const f32x4 b) { u32x4 w; w.x = cvt_pk_bf16(a[0], a[1]); w.y = cvt_pk_bf16(a[2], a[3]); w.z = cvt_pk_bf16(b[0], b[1]); w.w = cvt_pk_bf16(b[2], b[3]); return w; }
__device__ __forceinline__ void unpack8(const u32x4 w, f32x4& a, f32x4& b) {
    a[0] = __uint_as_float(w.x << 16); a[1] = __uint_as_float(w.x & 0xffff0000u); a[2] = __uint_as_float(w.y << 16); a[3] = __uint_as_float(w.y & 0xffff0000u);
    b[0] = __uint_as_float(w.z << 16); b[1] = __uint_as_float(w.z & 0xffff0000u); b[2] = __uint_as_float(w.w << 16); b[3] = __uint_as_float(w.w & 0xffff0000u);
}
__device__ __forceinline__ float sigmoidf_fast(float v) { return __builtin_amdgcn_rcpf(1.f + __builtin_amdgcn_exp2f(-1.4426950408889634f * v)); }

__device__ __forceinline__ unsigned long long pack8_u8(const f32x4 a, const f32x4 b) {
    unsigned w0 = 0u, w1 = 0u;
#pragma unroll
    for (int e = 0; e < 4; ++e) { w0 |= (unsigned)(a[e] * 255.f + 0.5f) << (8 * e); w1 |= (unsigned)(b[e] * 255.f + 0.5f) << (8 * e); }
    return (unsigned long long)w0 | ((unsigned long long)w1 << 32); }
__device__ __forceinline__ void unpack8_u8(const unsigned long long w, f32x4& a, f32x4& b) {
    const unsigned w0 = (unsigned)w, w1 = (unsigned)(w >> 32);
#pragma unroll
    for (int e = 0; e < 4; ++e) { a[e] = (float)((w0 >> (8 * e)) & 0xffu) * (1.f / 255.f); b[e] = (float)((w1 >> (8 * e)) & 0xffu) * (1.f / 255.f); } }
__device__ __forceinline__ unsigned long long pack8_f8(const f32x4 a, const f32x4 b) {
    int p0 = 0, p1 = 0;
    p0 = __builtin_amdgcn_cvt_pk_fp8_f32(a[0], a[1], p0, false); p0 = __builtin_amdgcn_cvt_pk_fp8_f32(a[2], a[3], p0, true);
    p1 = __builtin_amdgcn_cvt_pk_fp8_f32(b[0], b[1], p1, false); p1 = __builtin_amdgcn_cvt_pk_fp8_f32(b[2], b[3], p1, true);
    return (unsigned long long)(unsigned)p0 | ((unsigned long long)(unsigned)p1 << 32); }
__device__ __forceinline__ void unpack8_f8(const unsigned long long w, f32x4& a, f32x4& b) {
    const int w0 = (int)(unsigned)w, w1 = (int)(unsigned)(w >> 32);
    const f32x2 a0 = __builtin_amdgcn_cvt_pk_f32_fp8(w0, false), a1 = __builtin_amdgcn_cvt_pk_f32_fp8(w0, true), b0 = __builtin_amdgcn_cvt_pk_f32_fp8(w1, false), b1 = __builtin_amdgcn_cvt_pk_f32_fp8(w1, true);
    a = (f32x4){a0[0], a0[1], a1[0], a1[1]}; b = (f32x4){b0[0], b0[1], b1[0], b1[1]}; }
struct EpiProj {
    bf16_t* Q; bf16_t* Kt; bf16_t* V; bf16_t* PIN; bf16_t* G; const float* gq; const float* gk; LAS float* P; float inv;
    __device__ __forceinline__ void operator()(const Acc& acc, const Unit& u, int ui, int wid) const {
        const int lane = lane_now(), wr = wid >> 2, wc = wid & 3, fr = lane & 15, fq = lane >> 4;
        const int pn = u.pn, c8 = wc * 32 + fq * 8;
        if (pn < 8) {
            LAS float* Pb = P + (ui & 1) * 2048;
#pragma unroll
            for (int ai = 0; ai < 2; ++ai)
#pragma unroll
                for (int m = 0; m < 4; ++m)
#pragma unroll
                    for (int bj = 0; bj < 2; ++bj) { const f32x4 a = acc[ai][bj][m][0] * inv, b = acc[ai][bj][m][1] * inv;
                        float s = (a[0] * a[0] + a[1] * a[1]) + (a[2] * a[2] + a[3] * a[3]) + (b[0] * b[0] + b[1] * b[1]) + (b[2] * b[2] + b[3] * b[3]);
                        s += __shfl_xor(s, 16); s += __shfl_xor(s, 32);
                        if (fq == 0) Pb[((ai * 128 + wr * 64 + m * 16 + fr) * 2 + bj) * 4 + wc] = s; }
            LDS_WAIT(); __builtin_amdgcn_s_barrier(); asm volatile("" ::: "memory");
            const float* g = (pn < 4) ? gq : gk; bf16_t* dst = (pn < 4) ? Q : Kt; const int h0 = (pn & 3) * 2;
            const f32x4 g0 = *(const f32x4*)(g + c8), g1 = *(const f32x4*)(g + c8 + 4);
#pragma unroll
            for (int ai = 0; ai < 2; ++ai)
#pragma unroll
                for (int m = 0; m < 4; ++m) { const int rl = ai * 128 + wr * 64 + m * 16 + fr, row = u.pm * 256 + rl, bb = row >> 12, s = row & 4095;
#pragma unroll
                    for (int bj = 0; bj < 2; ++bj) { const f32x4 p = *(const LAS f32x4*)(Pb + (rl * 2 + bj) * 4);
                        const float rstd = rsqrtf(((p[0] + p[1]) + (p[2] + p[3])) * (1.f / 128.f) + EPS);
                        const f32x4 a = acc[ai][bj][m][0] * inv * rstd * g0, b = acc[ai][bj][m][1] * inv * rstd * g1;
                        *(u32x4*)(dst + (((size_t)bb * NH + h0 + bj) * S + s) * HD + c8) = pack8(a, b); } }
        } else if (pn < 12) {
            const int h0 = (pn - 8) * 2;
#pragma unroll
            for (int ai = 0; ai < 2; ++ai)
#pragma unroll
                for (int m = 0; m < 4; ++m) { const int row = u.pm * 256 + ai * 128 + wr * 64 + m * 16 + fr, bb = row >> 12, s = row & 4095;
#pragma unroll
                    for (int bj = 0; bj < 2; ++bj) *(u32x4*)(V + (((size_t)bb * NH + h0 + bj) * S + s) * HD + c8) = pack8(acc[ai][bj][m][0] * inv, acc[ai][bj][m][1] * inv); }
        } else if (pn < 16) {
#pragma unroll
            for (int ai = 0; ai < 2; ++ai)
#pragma unroll
                for (int m = 0; m < 4; ++m) { const int row = u.pm * 256 + ai * 128 + wr * 64 + m * 16 + fr;
#pragma unroll
                    for (int bj = 0; bj < 2; ++bj) *(u32x4*)(PIN + (size_t)row * PW + (pn - 12) * 256 + bj * 128 + c8) = pack8(acc[ai][bj][m][0] * inv, acc[ai][bj][m][1] * inv); }
        } else {
#pragma unroll
            for (int ai = 0; ai < 2; ++ai)
#pragma unroll
                for (int m = 0; m < 4; ++m) { const int row = u.pm * 256 + ai * 128 + wr * 64 + m * 16 + fr;
#pragma unroll
                    for (int bj = 0; bj < 2; ++bj) { f32x4 a = acc[ai][bj][m][0] * inv, b = acc[ai][bj][m][1] * inv;
#pragma unroll
                        for (int e = 0; e < 4; ++e) { a[e] = sigmoidf_fast(a[e]); b[e] = sigmoidf_fast(b[e]); }
                        *(unsigned long long*)((unsigned char*)G + (size_t)row * 4096 + (pn - 16) * 256 + bj * 128 + c8) = pack8_u8(a, b); } }
        }
    }
};
struct EpiGate {
    bf16_t* G; float inv;
    __device__ __forceinline__ void operator()(const Acc& acc, const Unit& u, int ui, int wid) const {
        const int lane = lane_now(), wr = wid >> 2, wc = wid & 3, fr = lane & 15, fq = lane >> 4;
        const int c8 = wc * 32 + fq * 8;
#pragma unroll
        for (int ai = 0; ai < 2; ++ai)
#pragma unroll
            for (int m = 0; m < 4; ++m) { const int row = u.pm * 256 + ai * 128 + wr * 64 + m * 16 + fr;
#pragma unroll
                for (int bj = 0; bj < 2; ++bj) { f32x4 a = acc[ai][bj][m][0] * inv, b = acc[ai][bj][m][1] * inv;
#pragma unroll
                    for (int e = 0; e < 4; ++e) { a[e] = sigmoidf_fast(a[e]); b[e] = sigmoidf_fast(b[e]); }
                    *(u32x4*)(G + (size_t)row * 4096 + u.pn * 256 + bj * 128 + c8) = pack8(a, b); } }
    }
};
struct EpiPool2 {
    bf16_t* O; const float* scale;
    __device__ __forceinline__ void operator()(const Acc& acc, const Unit& u, int ui, int wid) const {
        const int lane = lane_now(), wr = wid >> 2, wc = wid & 3, fr = lane & 15, fq = lane >> 4;
        const int c8 = wc * 32 + fq * 8;
#pragma unroll
        for (int bj = 0; bj < 2; ++bj) { const int col = u.pn * 256 + bj * 128 + c8; const f32x4 s0 = *(const f32x4*)(scale + col), s1 = *(const f32x4*)(scale + col + 4);
#pragma unroll
            for (int ai = 0; ai < 2; ++ai)
#pragma unroll
                for (int m = 0; m < 4; ++m) { const int row = u.pm * 256 + ai * 128 + wr * 64 + m * 16 + fr;
                    *(u32x4*)(O + (size_t)row * PW + col) = pack8(acc[ai][bj][m][0] * s0, acc[ai][bj][m][1] * s1); } }
    }
};
constexpr float TMP8_SCALE = 64.f;
template <int AUX>
struct EpiBranch {
    bf16_t* TMP; bf16_t* MERGED; const bf16_t* G; float inv;
    __device__ __forceinline__ void operator()(const Acc& acc, const Unit& u, int ui, int wid) const {
        const int lane = lane_now(), wr = wid >> 2, wc = wid & 3, fr = lane & 15, fq = lane >> 4;
        const int c8 = wc * 32 + fq * 8;
#pragma unroll
        for (int ai = 0; ai < 2; ++ai)
#pragma unroll
            for (int m = 0; m < 4; ++m) { const int row = u.pm * 256 + ai * 128 + wr * 64 + m * 16 + fr;
#pragma unroll
                for (int bj = 0; bj < 2; ++bj) { const int col = u.pn * 256 + bj * 128 + c8;
                    f32x4 ga, gb; unpack8_u8(*(const unsigned long long*)((const unsigned char*)G + (size_t)row * 4096 + AUX * 2048 + col), ga, gb);
                    f32x4 a = acc[ai][bj][m][0] * inv * ga, b = acc[ai][bj][m][1] * inv * gb;
                    if (AUX == 0) { *(unsigned long long*)((unsigned char*)TMP + (size_t)row * DM + col) = pack8_f8(a * TMP8_SCALE, b * TMP8_SCALE); }
                    else { f32x4 ta, tb; unpack8_f8(*(const unsigned long long*)((const unsigned char*)TMP + (size_t)row * DM + col), ta, tb);
                        *(u32x4*)(MERGED + (size_t)row * DM + col) = pack8(a + ta * (1.f / TMP8_SCALE), b + tb * (1.f / TMP8_SCALE)); } } }
    }
};
struct EpiOut {
    const float* x; bf16_t* XG; float* SSQ;
    __device__ __forceinline__ void operator()(const Acc& acc, const Unit& u, int ui, int wid) const {
        const int lane = lane_now(), wr = wid >> 2, wc = wid & 3, fr = lane & 15, fq = lane >> 4;
        const int c8 = wc * 32 + fq * 8;
#pragma unroll
        for (int ai = 0; ai < 2; ++ai)
#pragma unroll
            for (int m = 0; m < 4; ++m) { const int row = u.pm * 256 + ai * 128 + wr * 64 + m * 16 + fr; float ss = 0.f;
#pragma unroll
                for (int bj = 0; bj < 2; ++bj) { const size_t off = (size_t)row * DM + u.pn * 256 + bj * 128 + c8;
                    const f32x4 a = acc[ai][bj][m][0] + *(const f32x4*)(x + off), b = acc[ai][bj][m][1] + *(const f32x4*)(x + off + 4);
                    ss += (a[0] * a[0] + a[1] * a[1]) + (a[2] * a[2] + a[3] * a[3]) + (b[0] * b[0] + b[1] * b[1]) + (b[2] * b[2] + b[3] * b[3]);
                    *(u32x4*)(XG + off) = pack8(a, b); }
                ss += __shfl_xor(ss, 16); ss += __shfl_xor(ss, 32);
                if (fq == 0) SSQ[(size_t)row * 32 + u.pn * 4 + wc] = ss; }
    }
};
struct EpiBf16 {
    bf16_t* O; int ldc;
    __device__ __forceinline__ void operator()(const Acc& acc, const Unit& u, int ui, int wid) const {
        const int lane = lane_now(), wr = wid >> 2, wc = wid & 3, fr = lane & 15, fq = lane >> 4;
        const int c8 = wc * 32 + fq * 8;
#pragma unroll
        for (int ai = 0; ai < 2; ++ai)
#pragma unroll
            for (int m = 0; m < 4; ++m) { const int row = u.pm * 256 + ai * 128 + wr * 64 + m * 16 + fr;
#pragma unroll
                for (int bj = 0; bj < 2; ++bj) *(u32x4*)(O + (size_t)row * ldc + u.pn * 256 + bj * 128 + c8) = pack8(acc[ai][bj][m][0], acc[ai][bj][m][1]); }
    }
};

#define XB_TMO      128
#define XB_XCNT(j)  (256  + 64 * (j))
#define XB_XSUB(j)  (1280 + 64 * (j))
#define XB_XGEN(j)  (2304 + 64 * (j))
#define XB_TOP      3328
#define XB_TOPGEN   3392
#define XCD_BAR_WORDS 3456
#define XB_SPIN_CAP (1u << 18)
__device__ __forceinline__ unsigned xb_ld(unsigned* p)              { return __hip_atomic_load(p, __ATOMIC_RELAXED, __HIP_MEMORY_SCOPE_AGENT); }
__device__ __forceinline__ unsigned xb_add(unsigned* p, unsigned v) { return __hip_atomic_fetch_add(p, v, __ATOMIC_RELAXED, __HIP_MEMORY_SCOPE_AGENT); }
__device__ __forceinline__ unsigned xb_xcc_id() { return (unsigned)__builtin_amdgcn_s_getreg((3 << 11) | 20) & 0xFu; }
#define XB_SPIN(cond, bar) do { unsigned _sp = 0; while (cond) { __builtin_amdgcn_s_sleep(1); \
    if ((++_sp & 255u) == 0u) { if (xb_ld(&(bar)[XB_TMO])) break; if (_sp > XB_SPIN_CAP) { atomicAdd(&(bar)[XB_TMO], 1u); break; } } } } while (0)
struct XcdBarrier { unsigned* bar; unsigned x; volatile LAS unsigned* st; };
__device__ __forceinline__ XcdBarrier xcd_barrier_post(unsigned* bar, volatile LAS unsigned* st) {
    XcdBarrier b; b.bar = bar; b.x = xb_xcc_id(); b.st = st;
    if (threadIdx.x == 0) (void)xb_add(&bar[XB_XCNT(b.x)], 1u);
    return b;
}
__device__ __forceinline__ void xcd_barrier_complete(unsigned* bar, unsigned x, unsigned& nloc, unsigned& nx) {
    const unsigned G = gridDim.x * gridDim.y * gridDim.z;
    unsigned sum, cnt, mine, sp = 0u;
    for (;;) {
        sum = 0u; cnt = 0u; mine = 0u;
#pragma unroll
        for (unsigned j = 0; j < 16; ++j) { const unsigned c = xb_ld(&bar[XB_XCNT(j)]); sum += c; cnt += (c > 0u) ? 1u : 0u; mine = (j == x) ? c : mine; }
        if (sum == G) break;
        __builtin_amdgcn_s_sleep(1);
        if ((++sp & 255u) == 0u) { if (xb_ld(&bar[XB_TMO])) break; if (sp > XB_SPIN_CAP) { atomicAdd(&bar[XB_TMO], 1u); break; } }
    }
    nloc = mine > 0u ? mine : 1u; nx = cnt > 0u ? cnt : 1u;
}
__device__ __forceinline__ void xcd_barrier(const XcdBarrier& b) {
    asm volatile("s_waitcnt vmcnt(0)" ::: "memory");
    __syncthreads();
    if (threadIdx.x == 0) {
        unsigned* bar = b.bar;
        __builtin_amdgcn_s_waitcnt(0);
        unsigned nloc = b.st[0], nx = b.st[1];
        if (nloc == 0u) { xcd_barrier_complete(bar, b.x, nloc, nx); b.st[0] = nloc; b.st[1] = nx; }
        const unsigned old = xb_add(&bar[XB_XSUB(b.x)], 1u);
        const unsigned gen = old / nloc;
        if (old + 1u == (gen + 1u) * nloc) {
            __builtin_amdgcn_fence(__ATOMIC_RELEASE, "agent");
            asm volatile("s_waitcnt vmcnt(0)" ::: "memory");
            const unsigned og = xb_add(&bar[XB_TOP], 1u);
            const unsigned tg = og / nx;
            if (og + 1u == (tg + 1u) * nx) xb_add(&bar[XB_TOPGEN], 1u);
            else XB_SPIN(xb_ld(&bar[XB_TOPGEN]) == tg, bar);
            __builtin_amdgcn_fence(__ATOMIC_ACQUIRE, "agent");
            xb_add(&bar[XB_XGEN(b.x)], 1u);
            asm volatile("s_waitcnt vmcnt(0)" ::: "memory");
        } else {
            XB_SPIN(xb_ld(&bar[XB_XGEN(b.x)]) == gen, bar);
            __builtin_amdgcn_fence(__ATOMIC_ACQUIRE, "agent");
            asm volatile("s_waitcnt vmcnt(0)" ::: "memory");
        }
    }
    __syncthreads();
}

__device__ __forceinline__ unsigned pk2(float lo, float hi) { return (unsigned)f2bf(lo) | ((unsigned)f2bf(hi) << 16); }
__device__ __forceinline__ void p0_transpose_item(const float* W, int K, int N, bf16_t* WT, int row0, int src_col0, int k0, LAS float* scr, int lane, const float* kscale = nullptr) {
#pragma unroll 8
    for (int i = 0; i < 32; ++i) { const int kk = 2 * i + (lane >> 5); scr[kk * 33 + (lane & 31)] = W[(size_t)(k0 + kk) * N + src_col0 + (lane & 31)] * (kscale ? kscale[k0 + kk] : 1.f); }
    LDS_WAIT(); asm volatile("" ::: "memory");
    const int c = lane & 7;
#pragma unroll
    for (int j = 0; j < 4; ++j) { const int n = (lane >> 3) + 8 * j; const LAS float* s = scr + (8 * c) * 33 + n;
        u32x4 o; o.x = pk2(s[0 * 33], s[1 * 33]); o.y = pk2(s[2 * 33], s[3 * 33]); o.z = pk2(s[4 * 33], s[5 * 33]); o.w = pk2(s[6 * 33], s[7 * 33]);
        *(u32x4*)(WT + (size_t)(row0 + n) * K + k0 + 8 * c) = o; }
    LDS_WAIT(); asm volatile("" ::: "memory");
}


namespace att {
typedef short s16x4 __attribute__((ext_vector_type(4)));
typedef float f32x16 __attribute__((ext_vector_type(16)));
constexpr int D = 128, NW = 8, QBLK = 32, KVBLK = 64, QB = NW * QBLK;
constexpr int SHM_V = KVBLK * D * 2, SHM_K = KVBLK * D * 2;
constexpr int LDS_WS = 2 * SHM_V + 2 * SHM_K, LDS_CB = LDS_WS + NW * 64 * 4, LDS_ATT_BYTES = LDS_CB + 2 * 64 * 4;
constexpr float THR = 8.f;
constexpr float O8_SCALE = 32.f;
constexpr int OSTR = FW;
#define KSWZ(row, colB) ((row) * 256 + ((colB) ^ (((row) & 7) << 4)))
#define SBAR() __builtin_amdgcn_sched_barrier(0)
__device__ __forceinline__ int v_st(int k, int c) { const int kk = (k & ~0xC) | ((k & 4) << 1) | ((k & 8) >> 1); return ((kk >> 3) * 4 + (c >> 5)) * 512 + ((kk & 7) * 32 + (c & 31)) * 2; }
__device__ __forceinline__ int v_rd_base(int lane) { return ((lane & 3) << 3) | (((lane >> 2) & 3) << 6) | (((lane >> 4) & 1) << 5) | (((lane >> 5) & 1) << 8); }
constexpr int v_rd_off(int d0, int ks, int half) { return d0 * 512 + ks * 4096 + half * 2048; }
__device__ __forceinline__ int crow(int r, int hi) { return (r & 3) + 8 * (r >> 2) + 4 * hi; }
__device__ __forceinline__ unsigned cvtpk(float lo, float hi) { unsigned r; asm volatile("s_nop 0\n\tv_cvt_pk_bf16_f32 %0, %1, %2" : "=v"(r) : "v"(lo), "v"(hi)); return r; }
__device__ __forceinline__ bf16x8 load8(const bf16_t* p) { return *reinterpret_cast<const bf16x8*>(p); }
__device__ __forceinline__ void mask_tile(f32x16& p0, f32x16& p1, int dq) {
    const float NEG = -__builtin_inff();
#pragma unroll
    for (int r = 0; r < 16; ++r) { const int c = (r & 3) + 8 * (r >> 2);
        if (dq - c < 0) p0[r] = NEG;
        if (dq - c - 32 < 0) p1[r] = NEG; }
}
__device__ __forceinline__ void partialSM(f32x16& p0, f32x16& p1, float& m_reg, float& mn, float& alpha) {
    float pmax = p0[0];
#pragma unroll
    for (int r = 1; r < 16; ++r) pmax = fmaxf(pmax, p0[r]);
#pragma unroll
    for (int r = 0; r < 16; ++r) pmax = fmaxf(pmax, p1[r]);
    { auto rr = __builtin_amdgcn_permlane32_swap(__float_as_uint(pmax), __float_as_uint(pmax), false, false);
      pmax = fmaxf(__uint_as_float(rr[0]), __uint_as_float(rr[1])); }
    constexpr float C2 = 1.4426950408889634f * SCALE;
    if (__builtin_expect(__all((pmax - m_reg) * SCALE <= THR), 1)) { mn = m_reg; alpha = 1.f; }
    else { mn = fmaxf(m_reg, pmax); alpha = __builtin_amdgcn_exp2f((m_reg - mn) * C2); m_reg = mn; }
    const float mnL = -mn * C2;
#pragma unroll
    for (int r = 0; r < 16; ++r) p0[r] = fmaf(p0[r], C2, mnL);
#pragma unroll
    for (int r = 0; r < 16; ++r) p1[r] = fmaf(p1[r], C2, mnL);
#pragma unroll
    for (int r = 0; r < 16; ++r) p0[r] = __builtin_amdgcn_exp2f(p0[r]);
}
__device__ __forceinline__ void finishSM(f32x16& p0, f32x16& p1, float alpha, float& l_reg, bf16x8& pa0, bf16x8& pa1, bf16x8& pa2, bf16x8& pa3) {
#pragma unroll
    for (int r = 0; r < 16; ++r) p1[r] = __builtin_amdgcn_exp2f(p1[r]);
    float ps = 0;
#pragma unroll
    for (int r = 0; r < 16; ++r) ps += p0[r];
#pragma unroll
    for (int r = 0; r < 16; ++r) ps += p1[r];
    { auto rr = __builtin_amdgcn_permlane32_swap(__float_as_uint(ps), __float_as_uint(ps), false, false);
      ps = __uint_as_float(rr[0]) + __uint_as_float(rr[1]); }
    l_reg = l_reg * alpha + ps;
#define PK4(P, B_, OUT) do { unsigned a0 = cvtpk(P[B_+0], P[B_+1]), a1 = cvtpk(P[B_+2], P[B_+3]);                          \
        unsigned b0 = cvtpk(P[B_+4], P[B_+5]), b1 = cvtpk(P[B_+6], P[B_+7]);                                             \
        auto r0 = __builtin_amdgcn_permlane32_swap(a0, b0, false, false); auto r1 = __builtin_amdgcn_permlane32_swap(a1, b1, false, false); \
        u32x4 w = {r0[0], r1[0], r0[1], r1[1]}; OUT = *reinterpret_cast<bf16x8*>(&w); } while (0)
    PK4(p0, 0, pa0); PK4(p0, 8, pa1); PK4(p1, 0, pa2); PK4(p1, 8, pa3);
#undef PK4
}
template <int KB>
__device__ __forceinline__ void qkt(f32x16& p0, f32x16& p1, const char* K_lds, const float* CB, int r32, int hi, const bf16x8* qr, float cq) {
    const float* cb = CB + KB * 64 + 4 * hi;
#pragma unroll
    for (int g = 0; g < 4; ++g) { const f32x4 c0 = *(const f32x4*)(cb + 8 * g), c1 = *(const f32x4*)(cb + 32 + 8 * g);
#pragma unroll
        for (int e = 0; e < 4; ++e) { p0[4 * g + e] = cq - c0[e]; p1[4 * g + e] = cq - c1[e]; } }
    const char* kb[4];
#pragma unroll
    for (int dd = 0; dd < 4; ++dd) kb[dd] = K_lds + KB * SHM_K + KSWZ(r32, (dd * 16 + hi * 8) * 2);
#pragma unroll
    for (int d0 = 0; d0 < 8; ++d0) { const char* a = kb[d0 & 3] + (d0 >> 2) * 128;
        bf16x8 b0 = *reinterpret_cast<const bf16x8*>(a);
        bf16x8 b1 = *reinterpret_cast<const bf16x8*>(a + 32 * 256);
        p0 = __builtin_amdgcn_mfma_f32_32x32x16_bf16(b0, qr[d0], p0, 0, 0, 0);
        p1 = __builtin_amdgcn_mfma_f32_32x32x16_bf16(b1, qr[d0], p1, 0, 0, 0); }
}
template <int VB>
__device__ __forceinline__ void pv_tile(f32x16* o, int vb0, bf16x8 pa0, bf16x8 pa1, bf16x8 pa2, bf16x8 pa3) {
#define TRRD(dst, off) asm volatile("ds_read_b64_tr_b16 %0, %1 offset:%2" : "=&v"(dst) : "v"(vb0), "i"(off) : "memory")
#define PV_D0(d0) do { s16x4 l0, l1, l2, l3, h0, h1, h2, h3; constexpr int b_ = VB * SHM_V + v_rd_off(d0, 0, 0); \
        TRRD(l0, b_); TRRD(h0, b_ + 2048); TRRD(l1, b_ + 4096); TRRD(h1, b_ + 6144); TRRD(l2, b_ + 8192); TRRD(h2, b_ + 10240); TRRD(l3, b_ + 12288); TRRD(h3, b_ + 14336); \
        asm volatile("s_waitcnt lgkmcnt(0)" ::: "memory"); SBAR();   \
        o[d0] = __builtin_amdgcn_mfma_f32_32x32x16_bf16(pa0, (bf16x8){l0[0], l0[1], l0[2], l0[3], h0[0], h0[1], h0[2], h0[3]}, o[d0], 0, 0, 0);   \
        o[d0] = __builtin_amdgcn_mfma_f32_32x32x16_bf16(pa1, (bf16x8){l1[0], l1[1], l1[2], l1[3], h1[0], h1[1], h1[2], h1[3]}, o[d0], 0, 0, 0);   \
        o[d0] = __builtin_amdgcn_mfma_f32_32x32x16_bf16(pa2, (bf16x8){l2[0], l2[1], l2[2], l2[3], h2[0], h2[1], h2[2], h2[3]}, o[d0], 0, 0, 0);   \
        o[d0] = __builtin_amdgcn_mfma_f32_32x32x16_bf16(pa3, (bf16x8){l3[0], l3[1], l3[2], l3[3], h3[0], h3[1], h3[2], h3[3]}, o[d0], 0, 0, 0); } while (0)
    PV_D0(0); PV_D0(1); PV_D0(2); PV_D0(3);
#undef PV_D0
#undef TRRD
}
struct BlockRef { const bf16_t* Q; const bf16_t* K; const bf16_t* V; const float* C; unsigned char* O; int P0; int jlo; };
struct Seam { bf16x8 qr[8]; bf16x8 st_v0, st_v1, st_k0, st_k1; float st_c; float cq; };
#define ROW(p, k0, rr) ((p) + (size_t)((k0) + (rr)) * D + sc)
#define VMW() asm volatile("s_waitcnt vmcnt(0)" ::: "memory")
#define VMWN(n) asm volatile("s_waitcnt vmcnt(%0)" :: "i"(n) : "memory")
#define SLOAD_H(Kp, Vp, Cp, k0) do { S.st_v0 = load8(ROW(Vp, k0, sr)); S.st_v1 = load8(ROW(Vp, k0, 32 + sr));              \
                         S.st_k0 = load8(ROW(Kp, k0, sr)); S.st_k1 = load8(ROW(Kp, k0, 32 + sr)); S.st_c = (Cp)[(k0) + (tid & 63)]; } while (0)
#define SWRITE_HK(bf) do { *(bf16x8*)(K_lds + (bf) * SHM_K + kws) = S.st_k0; *(bf16x8*)(K_lds + (bf) * SHM_K + kws + 32 * 256) = S.st_k1; if (wid == 0) CB[(bf) * 64 + lane] = S.st_c; } while (0)
#define SWRITE_HV(bf) do { *(bf16x8*)(V_lds + (bf) * SHM_V + vst0) = S.st_v0; *(bf16x8*)(V_lds + (bf) * SHM_V + vst1) = S.st_v1; } while (0)
#define SWRITE_H(bf) do { SWRITE_HV(bf); SWRITE_HK(bf); } while (0)
__device__ __forceinline__ void attn_prime(const BlockRef& cur, char* lds, Seam& S, int wid) {
    const int lane = lane_now(), tid = wid * 64 + lane, r32 = lane & 31, hi = lane >> 5;
    const int sr = tid >> 4, sc = (tid & 15) * 8, kws = KSWZ(sr, sc * 2); char* K_lds = lds + 2 * SHM_V; float* CB = (float*)(lds + LDS_CB);
#pragma unroll
    for (int d0 = 0; d0 < 8; ++d0) S.qr[d0] = load8(cur.Q + (size_t)(wid * QBLK + r32) * D + d0 * 16 + hi * 8);
    S.cq = cur.C[cur.P0 + wid * QBLK + r32];
    SLOAD_H(cur.K, cur.V, cur.C, cur.jlo * KVBLK); VMW(); SWRITE_HK(0);
    __syncthreads();
}
__device__ __forceinline__ void attn_block(const BlockRef& cur, const BlockRef& nxt, char* lds, Seam& S, int wid) {
    const int lane = lane_now(), tid = wid * 64 + lane, r32 = lane & 31, hi = lane >> 5;
    const int NT = (cur.P0 + QB) / KVBLK - cur.jlo;
    const int qlo = cur.P0 + wid * QBLK, qm = qlo + r32 - 4 * hi;
    char* V_lds = lds; char* K_lds = lds + 2 * SHM_V; float* CB = (float*)(lds + LDS_CB);
    float* ws = (float*)(lds + LDS_WS) + wid * 64; float* li_l = ws, * al_l = ws + 32;
    float m_reg = -1e30f, l_reg = 0; f32x16 o[4] = {};
    const int sr = tid >> 4, sc = (tid & 15) * 8, vst0 = v_st(sr, sc), vst1 = v_st(32 + sr, sc), kws = KSWZ(sr, sc * 2);
    const int vb0 = (int)(uintptr_t)V_lds + v_rd_base(lane);
    const bf16_t* Kh = cur.K; const bf16_t* Vh = cur.V; const float* Ch = cur.C; const float cq = S.cq;
#define RESC(a) do { if (__any((a) < 1.f)) { if (hi == 0) al_l[r32] = (a); asm volatile("s_waitcnt lgkmcnt(0)" ::: "memory");              \
                     for (int d_ = 0; d_ < 4; ++d_) for (int r = 0; r < 16; ++r) o[d_][r] *= al_l[crow(r, hi)]; } } while (0)
#define KBASE(t) ((cur.jlo + (t)) * KVBLK)
#define MASKT(P0_, P1_, t) do { const int kb_ = KBASE(t); if (kb_ + KVBLK - 1 > qlo) mask_tile(P0_, P1_, qm - kb_); } while (0)
    constexpr int NQL = 9;
#define SEAM_K0() do { VMWN(NQL); SWRITE_HK(0); SBAR(); } while (0)
    f32x16 pA0, pA1, pB0, pB1; float mnA, mnB, alA, alB; bf16x8 pa0, pa1, pa2, pa3;
    SWRITE_HV(0); SBAR();
    if (NT > 1) { SLOAD_H(Kh, Vh, Ch, KBASE(1)); }
    SBAR(); qkt<0>(pA0, pA1, K_lds, CB, r32, hi, S.qr, cq);
    MASKT(pA0, pA1, 0); partialSM(pA0, pA1, m_reg, mnA, alA);
    if (NT > 1) { VMW(); SWRITE_H(1); }
    __syncthreads();
#define HALF_STEP(PX0, PX1, mnX, alX, PY0, PY1, alY, t, KB, VB, SB) do {                                                      \
        SBAR(); qkt<KB>(PX0, PX1, K_lds, CB, r32, hi, S.qr, cq);                                             \
        finishSM(PY0, PY1, alY, l_reg, pa0, pa1, pa2, pa3); SBAR();                                                           \
        if ((t) + 1 < NT) { SLOAD_H(Kh, Vh, Ch, KBASE((t) + 1)); SBAR(); }                                               \
        pv_tile<VB>(o, vb0, pa0, pa1, pa2, pa3); MASKT(PX0, PX1, (t)); partialSM(PX0, PX1, m_reg, mnX, alX);                                        \
        __syncthreads();                                                                                                      \
        if ((t) + 1 < NT) { VMW(); SWRITE_H(SB); }                                                                          \
        RESC(alX); __syncthreads(); } while (0)
    for (int t = 1; t + 1 < NT; t += 2) {
        HALF_STEP(pB0, pB1, mnB, alB, pA0, pA1, alA, t, 1, 0, 0);
        HALF_STEP(pA0, pA1, mnA, alA, pB0, pB1, alB, t + 1, 0, 1, 1);
    }
    const bool even = (NT & 1) == 0;
    if (even) { SBAR(); qkt<1>(pB0, pB1, K_lds, CB, r32, hi, S.qr, cq); SBAR(); }
    { SLOAD_H(nxt.K, nxt.V, nxt.C, nxt.jlo * KVBLK); SBAR();
#pragma unroll
      for (int d0 = 0; d0 < 8; ++d0) S.qr[d0] = load8(nxt.Q + (size_t)(wid * QBLK + r32) * D + d0 * 16 + hi * 8);
      S.cq = nxt.C[nxt.P0 + wid * QBLK + r32]; }
    SBAR();
    finishSM(pA0, pA1, alA, l_reg, pa0, pa1, pa2, pa3); SBAR();
    pv_tile<0>(o, vb0, pa0, pa1, pa2, pa3);
    if (even) { MASKT(pB0, pB1, NT - 1); partialSM(pB0, pB1, m_reg, mnB, alB); __syncthreads(); RESC(alB);
        finishSM(pB0, pB1, alB, l_reg, pa0, pa1, pa2, pa3); SBAR(); pv_tile<1>(o, vb0, pa0, pa1, pa2, pa3); }
    SBAR(); SEAM_K0();
    if (hi == 0) li_l[r32] = l_reg; asm volatile("s_waitcnt lgkmcnt(0)" ::: "memory");
    float rli[16];
#pragma unroll
    for (int r = 0; r < 16; ++r) rli[r] = __builtin_amdgcn_rcpf(li_l[crow(r, hi)]);
    unsigned char* Ow = cur.O + (size_t)(wid * QBLK) * OSTR;
#pragma unroll
    for (int r = 0; r < 16; ++r) { const int orow = crow(r, hi);
#pragma unroll
        for (int d0 = 0; d0 < 4; ++d0) { const float v = o[d0][r] * (rli[r] * O8_SCALE);
            const float vn = __shfl_xor(v, 1);
            const int p = __builtin_amdgcn_cvt_pk_fp8_f32(v, vn, 0, false);
            const int p2 = __shfl_xor(p, 2);
            if ((r32 & 3) == 0) *(unsigned*)(Ow + (size_t)orow * OSTR + d0 * 32 + r32) = ((unsigned)p & 0xffffu) | ((unsigned)p2 << 16); } }
    __syncthreads();
#undef RESC
#undef KBASE
#undef MASKT
#undef SEAM_K0
#undef HALF_STEP
}
#undef ROW
#undef VMW
#undef VMWN
#undef SLOAD_H
#undef SWRITE_HK
#undef SWRITE_HV
#undef SWRITE_H
#undef SBAR
}

typedef __bf16 bf16x2_t __attribute__((ext_vector_type(2)));

__device__ __forceinline__ float dot2bf(unsigned a, unsigned b, float c) {
    bf16x2_t av, bv; __builtin_memcpy(&av, &a, 4); __builtin_memcpy(&bv, &b, 4); return __builtin_amdgcn_fdot2_f32_bf16(av, bv, c, false); }
__device__ __forceinline__ float dot2bf_s(unsigned s_uniform, unsigned b, float c) { return dot2bf(s_uniform, b, c); }
namespace peer {
typedef float f32x16 __attribute__((ext_vector_type(16)));
__device__ __forceinline__ float fmaxs(float a, float b) { float r; asm("v_max_f32_e32 %0, %1, %2" : "=v"(r) : "v"(a), "v"(b)); return r; }
__device__ __forceinline__ float fmins(float a, float b) { float r; asm("v_min_f32_e32 %0, %1, %2" : "=v"(r) : "v"(a), "v"(b)); return r; }
#define CE(a, b) do { const float _h = fmaxs(a, b), _l = fmins(a, b); a = _h; b = _l; } while (0)
__device__ __forceinline__ void insert16(float (&L)[16], float x) {
#pragma unroll
    for (int i = 0; i < 16; ++i) { const float h = fmaxs(L[i], x); x = fmins(L[i], x); L[i] = h; }
}
__device__ __forceinline__ void sort16_desc(float (&v)[16]) {
#pragma unroll
    for (int k = 2; k <= 16; k <<= 1)
#pragma unroll
        for (int j = k >> 1; j >= 1; j >>= 1)
#pragma unroll
            for (int i = 0; i < 16; ++i) { const int l = i ^ j; if (l > i) { const bool desc = (i & k) == 0; const float hi_ = fmaxs(v[i], v[l]), lo_ = fmins(v[i], v[l]); v[i] = desc ? hi_ : lo_; v[l] = desc ? lo_ : hi_; } }
}
__device__ __forceinline__ void merge16(float (&L)[16], const float (&S)[16]) {
#pragma unroll
    for (int i = 0; i < 16; ++i) L[i] = fmaxs(L[i], S[15 - i]);
#pragma unroll
    for (int d = 8; d >= 1; d >>= 1)
#pragma unroll
        for (int i = 0; i < 16; ++i) if ((i & d) == 0) CE(L[i], L[i + d]);
}
__device__ __forceinline__ void merge_partner(float (&L)[16], const bool lo_half) {
    float B[16];
#pragma unroll
    for (int i = 0; i < 16; ++i) { auto r = __builtin_amdgcn_permlane32_swap(__float_as_uint(L[i]), __float_as_uint(L[i]), false, false);
        B[i] = __uint_as_float(lo_half ? r[1] : r[0]); }
#pragma unroll
    for (int i = 0; i < 16; ++i) L[i] = fmaxs(L[i], B[15 - i]);
#pragma unroll
    for (int d = 8; d >= 1; d >>= 1)
#pragma unroll
        for (int i = 0; i < 16; ++i) if ((i & d) == 0) CE(L[i], L[i + d]);
}
constexpr int KEYS_BYTES = 65536, SCR_OFF = 65536;
}

__device__ __forceinline__ void p0_transpose_item_fp8(const float* W, int K, int N, unsigned char* WT8, int row0, int src_col0, int k0, LAS float* scr, int lane, float sc) {
#pragma unroll 8
    for (int i = 0; i < 32; ++i) { const int kk = 2 * i + (lane >> 5); scr[kk * 33 + (lane & 31)] = W[(size_t)(k0 + kk) * N + src_col0 + (lane & 31)]; }
    LDS_WAIT(); asm volatile("" ::: "memory");
    const int c = lane & 3;
#pragma unroll
    for (int j = 0; j < 2; ++j) { const int n = (lane >> 2) + 16 * j; const LAS float* sp = scr + (16 * c) * 33 + n; u32x4 o;
#pragma unroll
        for (int q = 0; q < 4; ++q) { int p = 0; p = __builtin_amdgcn_cvt_pk_fp8_f32(sp[(4 * q) * 33] * sc, sp[(4 * q + 1) * 33] * sc, p, false); p = __builtin_amdgcn_cvt_pk_fp8_f32(sp[(4 * q + 2) * 33] * sc, sp[(4 * q + 3) * 33] * sc, p, true); o[q] = (unsigned)p; }
        *(u32x4*)(WT8 + (size_t)(row0 + n) * K + k0 + 16 * c) = o; }
    LDS_WAIT(); asm volatile("" ::: "memory");
}
constexpr float H8_SCALE = 16.f, W8_SCALE = 512.f;
constexpr size_t DO_W8 = 80 * MiB, DO_H8 = 96 * MiB;

struct Args { const float* in[17]; float* out; unsigned char* ws; int ph_lo, ph_hi; };
constexpr int N_PHASES = 11;

__global__ void __launch_bounds__(NTHR, 2) mega(Args args) {
    extern __shared__ __attribute__((aligned(16))) unsigned char lds_raw[];
    LAS unsigned char* lds = (LAS unsigned char*)lds_raw;
    volatile LAS unsigned* MISC = (volatile LAS unsigned*)(lds + MISC_OFF);
    const int wave = __builtin_amdgcn_readfirstlane((int)threadIdx.x >> 6);
    const int G = gridDim.x, bx = blockIdx.x, vcu = (G % 8 == 0) ? (bx % 8) * (G / 8) + bx / 8 : bx;
    unsigned char* ws = args.ws; char* dob = (char*)args.out;
    const float* x = args.in[0]; const float* g1 = args.in[1]; const float* w_in = args.in[2]; const float* fbias = args.in[3];
    const float* gq = args.in[4]; const float* gk = args.in[5]; const float* pgw = args.in[6]; const float* pscale = args.in[7];
    const float* wba = args.in[8]; const float* wbp = args.in[9]; const float* wout = args.in[10]; const float* g2 = args.in[11];
    const float* wq = args.in[12]; const float* sk1 = args.in[13]; const float* sk2 = args.in[14]; const float* eu = args.in[15]; const float* ev = args.in[16];
    bf16_t* WT_IN = (bf16_t*)(dob + DO_WT_IN); unsigned char* W8 = (unsigned char*)(dob + DO_W8); unsigned char* H8 = (unsigned char*)(dob + DO_H8); bf16_t* H1 = (bf16_t*)(dob + DO_H1); bf16_t* Ob = (bf16_t*)(dob + DO_O); bf16_t* POOLED = (bf16_t*)(dob + DO_POOLED); bf16_t* POOL2 = (bf16_t*)(dob + DO_POOL2);
    bf16_t* WT_PG = (bf16_t*)(ws + WS_WT_PG); bf16_t* WT_BA = (bf16_t*)(ws + WS_WT_BA); bf16_t* WT_BP = (bf16_t*)(ws + WS_WT_BP); bf16_t* WT_OUT = (bf16_t*)(ws + WS_WT_OUT); bf16_t* WT_Q = (bf16_t*)(ws + WS_WT_Q);
    bf16_t* SK = (bf16_t*)(ws + WS_SK); float* CS = (float*)(ws + WS_CS); float* LOGF = (float*)(ws + WS_LOGF); float* SSQ = (float*)(ws + WS_SSQ);
    bf16_t* Qb = (bf16_t*)(ws + WS_Q); bf16_t* Kb = (bf16_t*)(ws + WS_K); bf16_t* Vb = (bf16_t*)(ws + WS_V); bf16_t* PIN = (bf16_t*)(ws + WS_PIN); bf16_t* Gt = (bf16_t*)(ws + WS_G);
    bf16_t* EU = (bf16_t*)(ws + WS_EU); bf16_t* EV = (bf16_t*)(ws + WS_EV); bf16_t* XG = (bf16_t*)(ws + WS_XG); bf16_t* TMP = (bf16_t*)(ws + WS_TMP); bf16_t* MERGED = (bf16_t*)(ws + WS_MERGED); bf16_t* QP = (bf16_t*)(ws + WS_QP);
    for (int u = threadIdx.x; u < 128; u += NTHR) MISC[u] = 0u;
    __syncthreads();
    const int lo = args.ph_lo, hi = args.ph_hi;
    XcdBarrier bar; bar.bar = (unsigned*)(ws + WS_CTL) + CW_BAR + lo * XCD_BAR_WORDS; bar.x = 0; bar.st = MISC + 8;
    if (hi - lo > 1) bar = xcd_barrier_post(bar.bar, MISC + 8);
#define IN(k) (lo <= (k) && (k) < hi)
#define SEAM(k) do { if (IN(k) && IN((k) + 1)) xcd_barrier(bar); } while (0)
    const int gw = vcu * NWAVES + wave, NGW = G * NWAVES;

    if (IN(0)) {
        const int lane = lane_now(), tid = wave * 64 + lane;
        LAS float* scr = (LAS float*)(lds + RING_OFF + wave * 16384);
        constexpr int I_IN = (DM / 64) * (NPROJ / 32),     I_BA = (FW / 64) * (DM / 32), I_OUT = (DM / 64) * (DM / 32), I_PG = 4 * (256 / 64) * (256 / 32);
        constexpr int NITEMS = I_IN + 2 * I_BA + 2 * I_OUT + I_PG;
        for (int it = gw; it < NITEMS; it += NGW) {
            int r = it;
            if (r < I_IN) { const int nblk = NPROJ / 32, kb = r / nblk, nb = r % nblk, n0 = nb * 32;
                p0_transpose_item_fp8(w_in, DM, INC, W8, n0, n0 + (n0 >= 3072 ? 8 : 0), kb * 64, scr, lane, W8_SCALE);
                continue; } r -= I_IN;
            if (r < I_BA) { const int nblk = DM / 32, kb = r / nblk, nb = r % nblk; p0_transpose_item_fp8(wba, FW, DM, (unsigned char*)WT_BA, nb * 32, nb * 32, kb * 64, scr, lane, W8_SCALE); continue; } r -= I_BA;
            if (r < I_BA) { const int nblk = DM / 32, kb = r / nblk, nb = r % nblk; p0_transpose_item(wbp, PW, DM, WT_BP, nb * 32, nb * 32, kb * 64, scr, lane); continue; } r -= I_BA;
            if (r < I_OUT) { const int nblk = DM / 32, kb = r / nblk, nb = r % nblk; p0_transpose_item(wout, DM, DM, WT_OUT, nb * 32, nb * 32, kb * 64, scr, lane); continue; } r -= I_OUT;
            if (r < I_OUT) { const int nblk = DM / 32, kb = r / nblk, nb = r % nblk; p0_transpose_item(wq, DM, DM, WT_Q, nb * 32, nb * 32, kb * 64, scr, lane, g2); continue; } r -= I_OUT;
            { const int g = r / 32, rr = r % 32, kb = rr / 8, nb = rr % 8; p0_transpose_item(pgw + (size_t)g * 65536, 256, 256, WT_PG, g * 256 + nb * 32, nb * 32, kb * 64, scr, lane); }
        }
        for (int i = gw * 64 + lane; i < 2048 * 128 / 4; i += NGW * 64) { const int e = i * 4, d = e & 127, n = e >> 7, key = n & 127, f = (n >> 7) & 1, h = n >> 8;
            const f32x4 v = *(const f32x4*)((f ? sk2 : sk1) + ((size_t)h * 128 + key) * 128 + d); u32x2 o; o.x = pk2(v[0], v[1]); o.y = pk2(v[2], v[3]); *(u32x2*)(SK + e) = o; }
        { unsigned char* E8 = (unsigned char*)(ws + WS_EU); float* ESC = (float*)(ws + WS_EV);
          for (int r0 = gw; r0 < 2 * NEXP; r0 += 2 * NGW) {
            f32x4 v[2][8];
#pragma unroll
            for (int u = 0; u < 2; ++u) { const int r = r0 + u * NGW; const float* src = (r < NEXP ? eu : ev - (size_t)NEXP * DM) + (size_t)r * DM;
#pragma unroll
                for (int i = 0; i < 2; ++i)
#pragma unroll
                    for (int c = 0; c < 4; ++c) v[u][i * 4 + c] = *(const f32x4*)(src + 1024 * i + 16 * lane + 4 * c); }
#pragma unroll
            for (int u = 0; u < 2; ++u) { const int r = r0 + u * NGW; float am = 0.f;
                if (r < NEXP) {
#pragma unroll
                    for (int i = 0; i < 2; ++i)
#pragma unroll
                        for (int c = 0; c < 4; ++c) v[u][i * 4 + c] = v[u][i * 4 + c] * *(const f32x4*)(g2 + 1024 * i + 16 * lane + 4 * c); }
#pragma unroll
                for (int q = 0; q < 8; ++q) am = fmaxf(am, fmaxf(fmaxf(fabsf(v[u][q][0]), fabsf(v[u][q][1])), fmaxf(fabsf(v[u][q][2]), fabsf(v[u][q][3]))));
#pragma unroll
                for (int o = 1; o < 64; o <<= 1) am = fmaxf(am, __shfl_xor(am, o));
                int ex = (int)((__float_as_uint(am) >> 23) & 0xffu); if (ex < 16) ex = 134;
                const float sc = __uint_as_float((unsigned)(261 - ex) << 23), inv = __uint_as_float((unsigned)(ex - 7) << 23);
#pragma unroll
                for (int i = 0; i < 2; ++i) { u32x4 w;
#pragma unroll
                    for (int c = 0; c < 4; ++c) { const f32x4 t = v[u][i * 4 + c] * sc; int p = 0;
                        p = __builtin_amdgcn_cvt_pk_fp8_f32(t[0], t[1], p, false); p = __builtin_amdgcn_cvt_pk_fp8_f32(t[2], t[3], p, true); w[c] = (unsigned)p; }
                    *(u32x4*)(E8 + (size_t)(r >= NEXP) * NEXP * DM + ((size_t)(8 * i + (lane >> 3)) * NEXP + (r & (NEXP - 1))) * 128 + 16 * (lane & 7)) = w; }
                if (lane == 0) ESC[r] = inv; }
          } }
        __syncthreads();
        LAS f32x4* WfL = (LAS f32x4*)(lds + RING_OFF);
        for (int i = tid; i < 4096; i += NTHR) { const int l = i & 63, half = (i >> 6) & 1, e = (i >> 7) & 3, j = i >> 9, k = 256 * j + 4 * l + e;
            WfL[i] = *(const f32x4*)(w_in + (size_t)k * INC + 3072 + 4 * half); }
        __syncthreads();
        f32x4 gv[8];
#pragma unroll
        for (int j = 0; j < 8; ++j) gv[j] = ((const f32x4*)g1)[64 * j + lane];
        for (int row0 = gw; row0 < T; row0 += 2 * NGW) {
            asm volatile("" ::: "memory");
            f32x4 v[2][8];
#pragma unroll
            for (int u = 0; u < 2; ++u) { const f32x4* xr = (const f32x4*)(x + (size_t)(row0 + u * NGW) * DM) + lane;
#pragma unroll
                for (int j = 0; j < 8; ++j) v[u][j] = xr[64 * j]; }
#pragma unroll
            for (int u = 0; u < 2; ++u) { const int row = row0 + u * NGW; float ss = 0.f;
#pragma unroll
                for (int j = 0; j < 8; ++j) ss += (v[u][j][0] * v[u][j][0] + v[u][j][1] * v[u][j][1]) + (v[u][j][2] * v[u][j][2] + v[u][j][3] * v[u][j][3]);
                const float rstd = rsqrtf(wave_sum(ss) * (1.f / DM) + EPS);
                f32x4 a0 = {0.f, 0.f, 0.f, 0.f}, a1 = {0.f, 0.f, 0.f, 0.f};
#pragma unroll
                for (int j = 0; j < 8; ++j) { const f32x4 hv = v[u][j] * rstd * gv[j];
                    { int p8 = 0; p8 = __builtin_amdgcn_cvt_pk_fp8_f32(hv[0] * H8_SCALE, hv[1] * H8_SCALE, p8, false); p8 = __builtin_amdgcn_cvt_pk_fp8_f32(hv[2] * H8_SCALE, hv[3] * H8_SCALE, p8, true);
                      ((unsigned*)(H8 + (size_t)row * DM))[64 * j + lane] = (unsigned)p8; }
#pragma unroll
                    for (int e = 0; e < 4; ++e) { a0 += WfL[((j * 4 + e) * 2 + 0) * 64 + lane] * hv[e]; a1 += WfL[((j * 4 + e) * 2 + 1) * 64 + lane] * hv[e]; } }
                float z = 0.f;
#pragma unroll
                for (int c = 0; c < 8; ++c) { const float t = wave_sum(c < 4 ? a0[c & 3] : a1[c & 3]); if (lane == c) z = t; }
                if (lane < 8) { z += fbias[lane]; LOGF[(size_t)row * 8 + lane] = fminf(z, 0.f) - log1pf(expf(-fabsf(z))); } }
        }
    }
    SEAM(0);
    if (IN(1)) {
        if (bx < 32) {   const int lane = lane_now(), tid = wave * 64 + lane;
            LAS float* wsum = (LAS float*)(lds + EPI_OFF);
            const int b = bx >> 3, h = bx & 7; float v[8]; float run = 0.f;
#pragma unroll
            for (int i = 0; i < 8; ++i) { run += LOGF[((size_t)(b * S + tid * 8 + i)) * 8 + h]; v[i] = run; }
            float inc = run;
#pragma unroll
            for (int o = 1; o < 64; o <<= 1) { const float t = __shfl_up(inc, o); if (lane >= o) inc += t; }
            if (lane == 63) wsum[wave] = inc;
            __syncthreads();
            float base = inc - run;
            for (int w = 0; w < wave; ++w) base += wsum[w];
#pragma unroll
            for (int i = 0; i < 8; ++i) CS[(size_t)bx * S + tid * 8 + i] = (base + v[i]) * INV_SCALE;
            __syncthreads();
        }
        { pg8::SchedStd Sc{(const char*)H8, (const char*)W8, (size_t)256 * DM, (size_t)256 * DM, 0, T / 256, NPROJ / 256, (T / 256) * (NPROJ / 256), G, bx};
          EpiProj E{Qb, Kb, Vb, PIN, Gt, gq, gk, (LAS float*)(lds + EPI_OFF), 1.f / (H8_SCALE * W8_SCALE)};
          pg8::gemm_phase<true>(lds + RING_OFF, wave, DM / 2, DM / 2, DM / 2, Sc, E); }
    }
    SEAM(1);
    if (IN(2)) {
        const int lane = lane_now(), sub = lane >> 4, l16 = lane & 15;
#define POOL_BODY(W) do { \
            const int s0 = rb * 8, sq = s0 & (S - 1); const bf16_t* pp = PIN + (size_t)s0 * PW + ch; \
            f32x4 Pa[W + 7], Pb[W + 7]; \
            _Pragma("unroll") for (int r = 0; r < W + 7; ++r) { const int rel = r - (W - 1); \
                if (sq + rel >= 0) unpack8(*(const u32x4*)(pp + (long)rel * PW), Pa[r], Pb[r]); else { Pa[r] = (f32x4){0.f, 0.f, 0.f, 0.f}; Pb[r] = Pa[r]; } } \
            f32x4 Sa = {0.f, 0.f, 0.f, 0.f}, Sb = Sa; \
            _Pragma("unroll") for (int r = 0; r < W - 1; ++r) { Sa += Pa[r]; Sb += Pb[r]; } \
            _Pragma("unroll") for (int r = 0; r < 8; ++r) { Sa += Pa[r + W - 1]; Sb += Pb[r + W - 1]; \
                const int cnt = (sq + r + 1 < W) ? sq + r + 1 : W; const float inv = 1.f / (float)cnt; \
                *(u32x4*)(POOLED + (size_t)(s0 + r) * PW + ch) = pack8(Sa * inv - Pa[r + W - 1], Sb * inv - Pb[r + W - 1]); \
                Sa -= Pa[r]; Sb -= Pb[r]; } } while (0)
        for (int itp = gw; itp < 4 * (T / 16); itp += NGW) {
            const int g = itp & 3, rb = (itp >> 2) * 2 + (lane >> 5), ch = g * 256 + (lane & 31) * 8;
            if (g == 0) POOL_BODY(2); else if (g == 1) POOL_BODY(4); else if (g == 2) POOL_BODY(8); else POOL_BODY(16);
        }
#undef POOL_BODY
    }
    SEAM(2);
    if (IN(3)) {
        float bq;
        { const int lane = lane_now(); float a = fmaxf(fabsf(gq[lane]), fabsf(gq[64 + lane])), b2 = fmaxf(fabsf(gk[lane]), fabsf(gk[64 + lane]));
#pragma unroll
          for (int o = 1; o < 64; o <<= 1) { a = fmaxf(a, __shfl_xor(a, o)); b2 = fmaxf(b2, __shfl_xor(b2, o)); }
          bq = 128.f * SCALE * a * b2 + EPS; }
        const float cmargin = (30.f + 2.f * bq) * INV_SCALE;
#define ATT_JLO(Chp, qb) ({ const int lane_ = lane_now(), nte_ = 4 * ((qb) + 1); const float thr_ = (Chp)[(qb) * 256] + cmargin; \
            const float v_ = (lane_ < nte_) ? (Chp)[64 * lane_ + 63] : -3.0e38f; const int n_ = (int)__builtin_popcountll(__ballot(v_ > thr_)); \
            __builtin_amdgcn_readfirstlane(n_ < nte_ - 4 ? n_ : nte_ - 4); })
        for (int L = vcu; L < Bn * NH * 8; L += G) {
            const int bh = L >> 3, xq = L & 7, b = bh >> 3, h = bh & 7;
            const bf16_t* Kh = Kb + (size_t)bh * S * HD; const bf16_t* Vh = Vb + (size_t)bh * S * HD; const float* Ch = CS + (size_t)bh * S;
            const int j0 = ATT_JLO(Ch, xq), j1 = ATT_JLO(Ch, 15 - xq);
            att::BlockRef r0{Qb + ((size_t)bh * S + xq * 256) * HD, Kh, Vh, Ch, (unsigned char*)Ob + ((size_t)(b * S + xq * 256)) * FW + h * HD, xq * 256, j0};
            att::BlockRef r1{Qb + ((size_t)bh * S + (15 - xq) * 256) * HD, Kh, Vh, Ch, (unsigned char*)Ob + ((size_t)(b * S + (15 - xq) * 256)) * FW + h * HD, (15 - xq) * 256, j1};
            att::Seam Sm;
            att::attn_prime(r0, (char*)lds_raw, Sm, wave);
            att::attn_block(r0, r1, (char*)lds_raw, Sm, wave);
            att::attn_block(r1, r1, (char*)lds_raw, Sm, wave);
        }
#undef ATT_JLO
        VM_WAIT(); __syncthreads();
        pg8::SchedStd Sc{(const char*)POOLED, (const char*)WT_PG, (size_t)256 * PW * 2, (size_t)256 * 256 * 2, (size_t)256 * 2, T / 256, PW / 256, (T / 256) * (PW / 256), G, bx};
        EpiPool2 E{POOL2, pscale};
        pg8::gemm_phase(lds + RING_OFF, wave, 256, PW, 256, Sc, E);
    }
    SEAM(3);
    if (IN(4)) {
        { pg8::SchedStd Sc{(const char*)Ob, (const char*)WT_BA, (size_t)256 * FW, (size_t)256 * FW, 0, T / 256, DM / 256, (T / 256) * (DM / 256), G, bx};
          EpiBranch<0> E{TMP, MERGED, Gt, 1.f / (att::O8_SCALE * W8_SCALE)};
          pg8::gemm_phase<true>(lds + RING_OFF, wave, FW / 2, FW / 2, FW / 2, Sc, E); }
        { pg8::SchedStd Sc{(const char*)POOL2, (const char*)WT_BP, (size_t)256 * FW * 2, (size_t)256 * FW * 2, 0, T / 256, DM / 256, (T / 256) * (DM / 256), G, bx};
          EpiBranch<1> E{TMP, MERGED, Gt, 1.f};
          pg8::gemm_phase(lds + RING_OFF, wave, FW, FW, FW, Sc, E); }
    }
    SEAM(4);
    if (IN(5)) {
        pg8::SchedStd Sc{(const char*)MERGED, (const char*)WT_OUT, (size_t)256 * DM * 2, (size_t)256 * DM * 2, 0, T / 256, DM / 256, (T / 256) * (DM / 256), G, bx};
        EpiOut E{x, XG, SSQ};
        pg8::gemm_phase(lds + RING_OFF, wave, DM, DM, DM, Sc, E);
    }
    SEAM(5);
    if (IN(6)) {
        pg8::SchedStd Sc{(const char*)XG, (const char*)WT_Q, (size_t)256 * DM * 2, (size_t)256 * DM * 2, 0, T / 256, DM / 256, (T / 256) * (DM / 256), G, bx};
        EpiBf16 E{QP, DM};
        pg8::gemm_phase(lds + RING_OFF, wave, DM, DM, DM, Sc, E);
    }
    SEAM(6);

    if (IN(7)) {
        const int lane = lane_now(), tid = wave * 64 + lane, r32 = lane & 31, hi = lane >> 5, h = vcu & 7;
#pragma unroll
        for (int i = 0; i < 8; ++i) { const int idx = tid + 512 * i, le = idx & 63, ks = (idx >> 6) & 7, tile = (idx >> 9) & 3, f = idx >> 11;
            const u32x4 v = *(const u32x4*)(SK + ((size_t)(h * 256 + f * 128 + 32 * tile + (le & 31)) * 128 + 16 * ks + 8 * (le >> 5)));
            *(LAS u32x4*)(lds + idx * 16) = v; }
        __syncthreads();
        LAS unsigned* scr = (LAS unsigned*)(lds + peer::SCR_OFF + wave * 8192) + lane;
        const unsigned nh4 = (unsigned)(1 - hi) << 2; const float NEGINF = -__builtin_inff();
        int* IDX = (int*)(ws + WS_IDX); float* GATE = (float*)(ws + WS_GATE);
        for (int tl = vcu >> 3; tl < T / 256; tl += G >> 3) {
            const int tok = tl * 256 + wave * 32 + r32;
            bf16x8 qf[2][8];
#pragma unroll
            for (int f = 0; f < 2; ++f)
#pragma unroll
                for (int ks = 0; ks < 8; ++ks) qf[f][ks] = *(const bf16x8*)(QP + (size_t)tok * DM + h * 256 + f * 128 + 16 * ks + 8 * hi);
            float tot = 0.f;
#pragma unroll
            for (int i = 0; i < 8; ++i) { const f32x4 v = *(const f32x4*)(SSQ + (size_t)tok * 32 + 4 * i); tot += (v[0] + v[1]) + (v[2] + v[3]); }
            const float rstd = rsqrtf(tot * (1.f / DM) + EPS);
            float KL[2][16];
#pragma unroll
            for (int f = 0; f < 2; ++f) {
                float L[16];
#pragma unroll
                for (int i = 0; i < 16; ++i) L[i] = NEGINF;
#pragma unroll
                for (int tile = 0; tile < 4; ++tile) {
                    peer::f32x16 acc = {};
#pragma unroll
                    for (int ks = 0; ks < 8; ++ks) acc = __builtin_amdgcn_mfma_f32_32x32x16_bf16(*(const LAS bf16x8*)(lds + (((f * 4 + tile) * 8 + ks) * 64 + lane) * 16), qf[f][ks], acc, 0, 0, 0);
                    float Sk[16];
#pragma unroll
                    for (int r = 0; r < 16; ++r) { const unsigned cp = (unsigned)(127 - 32 * tile - (r & 3) - 8 * (r >> 2) - 4);
                        Sk[r] = __uint_as_float(((__float_as_uint(acc[r]) & 0xffffff80u) | nh4) | cp); }
                    peer::sort16_desc(Sk);
                    if (tile == 0) {
#pragma unroll
                        for (int i = 0; i < 16; ++i) L[i] = Sk[i]; }
                    else peer::merge16(L, Sk);
                }
                peer::merge_partner(L, hi == 0);
#pragma unroll
                for (int i = 0; i < 16; ++i) KL[f][i] = L[i];
            }
            float Tt[16];
#pragma unroll
            for (int i = 0; i < 16; ++i) Tt[i] = NEGINF;
#pragma unroll
            for (int i = 0; i < 16; ++i)
#pragma unroll
                for (int j = 0; j < 16; ++j) if ((i + 1) * (j + 1) <= 16) {
                    const float sm = __uint_as_float(__float_as_uint(KL[0][i]) & 0xffffff80u) + __uint_as_float(__float_as_uint(KL[1][j]) & 0xffffff80u);
                    peer::insert16(Tt, __uint_as_float((__float_as_uint(sm) & 0xffffff00u) | (unsigned)(255 - (16 * i + j)))); }
#pragma unroll
            for (int k = 0; k < 16; ++k) { scr[k * 64] = __float_as_uint(KL[0][k]); scr[(16 + k) * 64] = __float_as_uint(KL[1][k]); }
            LDS_WAIT();
            int ex[16]; float gt[16]; float gs = 0.f;
            const float s0 = __uint_as_float(__float_as_uint(Tt[0]) & 0xffffff00u) * rstd;
#pragma unroll
            for (int r = 0; r < 16; ++r) { const unsigned tb = __float_as_uint(Tt[r]), pos = 255u - (tb & 255u), ci = pos >> 4, cj = pos & 15u;
                const unsigned a = scr[ci * 64], b = scr[(16 + cj) * 64];
                ex[r] = (int)((127u - (a & 127u)) * 128u + (127u - (b & 127u)));
                gt[r] = __expf(__uint_as_float(tb & 0xffffff00u) * rstd - s0); gs += gt[r]; }
            const float ginv = 1.f / gs;
            if (hi == 0) { int* o = IDX + (size_t)tok * 128 + h * 16;
#pragma unroll
                for (int q4 = 0; q4 < 4; ++q4) *(int4*)(o + 4 * q4) = make_int4(ex[4 * q4], ex[4 * q4 + 1], ex[4 * q4 + 2], ex[4 * q4 + 3]); }
            else { float* o = GATE + (size_t)tok * 128 + h * 16;
#pragma unroll
                for (int q4 = 0; q4 < 4; ++q4) *(f32x4*)(o + 4 * q4) = (f32x4){gt[4 * q4] * ginv, gt[4 * q4 + 1] * ginv, gt[4 * q4 + 2] * ginv, gt[4 * q4 + 3] * ginv}; }
            LDS_WAIT();
        }
    }
    SEAM(7);
    bf16_t* PA = (bf16_t*)(ws + WS_MERGED); float* HS = (float*)(ws + WS_QP);
    if (IN(8)) {
        const int lane = lane_now(), l8 = lane & 7, lg = lane >> 3, grp = bx & 7, nwv = (G >> 3) * NWAVES, wg = (bx >> 3) * NWAVES + wave;
        const int* IDX = (const int*)(ws + WS_IDX); const unsigned char* EU8 = (const unsigned char*)(ws + WS_EU);
#define P8_IDX(E, tk) do { const int* ip_ = IDX + (size_t)((tk) < T ? (tk) : T - 1) * 128 + lane; E[0] = ip_[0]; E[1] = ip_[64]; } while (0)
#define P8_ROWS(R, E, XA, XB, tk) do { _Pragma("unroll") for (int i = 0; i < 16; ++i) { const int e_ = __shfl(E[i >> 3], ((8 * i) & 63) + lg); R[i] = *(const u32x4*)(EU8 + (unsigned)(e_ * 128 + coffT)); } \
            const bf16_t* xp_ = XG + (size_t)((tk) < T ? (tk) : T - 1) * DM + coff; XA = *(const u32x4*)xp_; XB = *(const u32x4*)(xp_ + 8); } while (0)
#define P8_DPP(x, ctrl) __uint_as_float(__builtin_amdgcn_update_dpp(0u, __float_as_uint(x), ctrl, 0xf, 0xf, false))
#define P8_COMP(R, XA, XB, tk) do { f32x2 xf[8]; \
            _Pragma("unroll") for (int d = 0; d < 4; ++d) { xf[d] = (f32x2){__uint_as_float(XA[d] << 16), __uint_as_float(XA[d] & 0xffff0000u)}; xf[4 + d] = (f32x2){__uint_as_float(XB[d] << 16), __uint_as_float(XB[d] & 0xffff0000u)}; } \
            float sd[16]; \
            _Pragma("unroll") for (int i = 0; i < 16; ++i) { f32x2 a2 = {0.f, 0.f}; \
                _Pragma("unroll") for (int d = 0; d < 4; ++d) { a2 += __builtin_amdgcn_cvt_pk_f32_fp8((int)R[i][d], false) * xf[2 * d]; a2 += __builtin_amdgcn_cvt_pk_f32_fp8((int)R[i][d], true) * xf[2 * d + 1]; } \
                sd[i] = a2[0] + a2[1]; } \
              \
            float s8[8], s4[4], s2_[2]; \
            _Pragma("unroll") for (int k = 0; k < 8; ++k) { const float keep = q2 ? sd[k + 8] : sd[k], give = q2 ? sd[k] : sd[k + 8]; s8[k] = keep + P8_DPP(give, 0x141); }     \
            _Pragma("unroll") for (int k = 0; k < 4; ++k) { const float keep = q1 ? s8[k + 4] : s8[k], give = q1 ? s8[k] : s8[k + 4]; s4[k] = keep + P8_DPP(give, 0x4E); }      \
            _Pragma("unroll") for (int k = 0; k < 2; ++k) { const float keep = q0 ? s4[k + 2] : s4[k], give = q0 ? s4[k] : s4[k + 2]; s2_[k] = keep + P8_DPP(give, 0xB1); }     \
            if ((tk) < T) *(unsigned*)(PA + ((size_t)(tk) * 16 + c) * 128 + 2 * lane) = cvt_pk_bf16(s2_[0], s2_[1]); } while (0)
        const bool q2 = (lane & 4) != 0, q1 = (lane & 2) != 0, q0 = (lane & 1) != 0;
        LAS unsigned* wq = (LAS unsigned*)(lds + MISC_OFF + 128);
        if (lane == 0 && wave == 0) { wq[0] = 0u; wq[1] = 0u; }
        __syncthreads();
        const int tok0 = (bx >> 3) * NWAVES, npair = (T / nwv) * NWAVES / 2;
#define WQ_NEXT(slot) __builtin_amdgcn_readfirstlane((int)(lane == 0 ? __hip_atomic_fetch_add(wq + (slot), 1u, __ATOMIC_RELAXED, __HIP_MEMORY_SCOPE_WORKGROUP) : 0u))
#define WQ_TOK(p, k) ((p) < npair ? tok0 + ((2 * (p) + (k)) & 7) + nwv * ((2 * (p) + (k)) >> 3) : T)
        for (int c = grp, pass = 0; c < 16; c += 8, ++pass) {
            const int coff = 128 * c + 16 * l8, coffT = c * NEXP * 128 + 16 * l8;
            int eA[2], eB[2]; u32x4 rA[16], rB[16]; u32x4 xA0, xA1, xB0, xB1;
            int p = WQ_NEXT(pass); int ta = WQ_TOK(p, 0), tb = WQ_TOK(p, 1);
            P8_IDX(eA, ta); P8_ROWS(rA, eA, xA0, xA1, ta); P8_IDX(eB, tb);
#pragma unroll 1
            while (p < npair) {
                const int pn = WQ_NEXT(pass); const int na = WQ_TOK(pn, 0), nb = WQ_TOK(pn, 1);
                P8_ROWS(rB, eB, xB0, xB1, tb); P8_IDX(eA, na);
                P8_COMP(rA, xA0, xA1, ta);
                P8_ROWS(rA, eA, xA0, xA1, na); P8_IDX(eB, nb);
                P8_COMP(rB, xB0, xB1, tb);
                p = pn; ta = na; tb = nb;
            }
        }
#undef P8_IDX
#undef P8_ROWS
#undef P8_COMP
#undef P8_DPP
    }
    SEAM(8);
    if (IN(9)) {
        const int lane = lane_now();
        const int* IDX = (const int*)(ws + WS_IDX); const float* GATE = (const float*)(ws + WS_GATE); const float* ESC = (const float*)(ws + WS_EV);
        for (int t = gw; t < T; t += NGW) {
            const float pss = lane < 32 ? SSQ[(size_t)t * 32 + lane] : 0.f;
            const float rstd = rsqrtf(wave_sum(pss) * (1.f / DM) + EPS);
#pragma unroll
            for (int hh = 0; hh < 2; ++hh) { const int j = 64 * hh + lane; float a = 0.f;
#pragma unroll
                for (int c = 0; c < 16; ++c) a += bf2f(PA[((size_t)t * 16 + c) * 128 + (j & 7) * 16 + (j >> 3)]);
                const int e = IDX[(size_t)t * 128 + j];
                a *= ESC[e] * rstd;
                const float ge = 0.5f * a * (1.f + tanhf(0.7978845608028654f * (a + 0.044715f * a * a * a)));
                HS[(size_t)t * 128 + j] = ge * GATE[(size_t)t * 128 + j] * ESC[NEXP + e]; }
        }
    }
    SEAM(9);
    if (IN(10)) {
        const int lane = lane_now(), l8 = lane & 7, lg = lane >> 3, grp = bx & 7, nwv = (G >> 3) * NWAVES, wg = (bx >> 3) * NWAVES + wave;
        const int* IDX = (const int*)(ws + WS_IDX); const unsigned char* EV8 = (const unsigned char*)(ws + WS_EU) + (size_t)NEXP * DM;
        float* outp = args.out;
        const bool b16 = (lane & 16) != 0, b8 = (lane & 8) != 0;
#define P10_LOADE(E, tk) do { const int* ip_ = IDX + (size_t)((tk) < T ? (tk) : T - 1) * 128 + lane; E[0] = ip_[0]; E[1] = ip_[64]; } while (0)
#define P10_LOADH(H, tk) do { const float* hp_ = HS + (size_t)((tk) < T ? (tk) : T - 1) * 128 + lane; H[0] = hp_[0]; H[1] = hp_[64]; } while (0)
#define P10_ROWS(R, E, O, tk) do { _Pragma("unroll") for (int i = 0; i < 16; ++i) { const int e_ = __shfl(E[i >> 3], ((8 * i) & 63) + lg); R[i] = *(const u32x4*)(EV8 + (unsigned)(e_ * 128 + coffT)); } \
            { const unsigned w_ = *(const unsigned*)(XG + (size_t)((tk) < T ? (tk) : T - 1) * DM + coff + 2 * lg); O = (f32x2){__uint_as_float(w_ << 16), __uint_as_float(w_ & 0xffff0000u)}; } } while (0)
#define P10_COMP(R, H, O, tk) do { f32x2 acc[8]; \
            _Pragma("unroll") for (int d = 0; d < 8; ++d) acc[d] = (f32x2){0.f, 0.f}; \
            _Pragma("unroll") for (int i = 0; i < 16; ++i) { const float h_ = __shfl(H[i >> 3], ((8 * i) & 63) + lg); _Pragma("unroll") for (int d = 0; d < 4; ++d) { \
                acc[2 * d] += __builtin_amdgcn_cvt_pk_f32_fp8((int)R[i][d], false) * h_; acc[2 * d + 1] += __builtin_amdgcn_cvt_pk_f32_fp8((int)R[i][d], true) * h_; } } \
              \
            float f8[8], f4[4], f2[2]; \
            _Pragma("unroll") for (int k = 0; k < 8; ++k) { auto r_ = __builtin_amdgcn_permlane32_swap(__float_as_uint(acc[k >> 1][k & 1]), __float_as_uint(acc[(k + 8) >> 1][k & 1]), false, false); f8[k] = __uint_as_float(r_[0]) + __uint_as_float(r_[1]); } \
            _Pragma("unroll") for (int k = 0; k < 4; ++k) { const float keep = b16 ? f8[k + 4] : f8[k], give = b16 ? f8[k] : f8[k + 4]; f4[k] = keep + __shfl_xor(give, 16); } \
            _Pragma("unroll") for (int k = 0; k < 2; ++k) { const float keep = b8 ? f4[k + 2] : f4[k], give = b8 ? f4[k] : f4[k + 2]; f2[k] = keep + __shfl_xor(give, 8); } \
            if ((tk) < T) { f32x2 v_ = O; v_[0] += f2[0]; v_[1] += f2[1]; *(f32x2*)(outp + (size_t)(tk) * DM + coff + 2 * lg) = v_; } } while (0)
        LAS unsigned* wq = (LAS unsigned*)(lds + MISC_OFF + 128);
        if (lane == 0 && wave == 0) { wq[2] = 0u; wq[3] = 0u; }
        __syncthreads();
        const int tok0 = (bx >> 3) * NWAVES, npair = (T / nwv) * NWAVES / 2;
        for (int c = grp, pass = 0; c < 16; c += 8, ++pass) {
            const int coff = 128 * c + 16 * l8, coffT = c * NEXP * 128 + 16 * l8;
            int e[2]; float hA[2], hB[2]; u32x4 rA[16], rB[16]; f32x2 oA, oB;
            int p = WQ_NEXT(2 + pass); int ta = WQ_TOK(p, 0), tb = WQ_TOK(p, 1);
            P10_LOADE(e, ta); P10_ROWS(rA, e, oA, ta); P10_LOADH(hA, ta); P10_LOADE(e, tb);
#pragma unroll 1
            while (p < npair) {
                const int pn = WQ_NEXT(2 + pass); const int na = WQ_TOK(pn, 0), nb = WQ_TOK(pn, 1);
                P10_ROWS(rB, e, oB, tb); P10_LOADH(hB, tb); P10_LOADE(e, na);
                P10_COMP(rA, hA, oA, ta);
                P10_ROWS(rA, e, oA, na); P10_LOADH(hA, na); P10_LOADE(e, nb);
                P10_COMP(rB, hB, oB, tb);
                p = pn; ta = na; tb = nb;
            }
        }
#undef WQ_NEXT
#undef WQ_TOK
#undef P10_LOADE
#undef P10_LOADH
#undef P10_ROWS
#undef P10_COMP
    }
#undef IN
#undef SEAM
}

static int g_grid = 0;
static void launch_mega(const Args& a0, int lo, int hi, hipStream_t stream) {
    Args a = a0; a.ph_lo = lo; a.ph_hi = hi;
    hipLaunchKernelGGL(mega, dim3(g_grid), dim3(NTHR), LDS_BYTES, stream, a);
}

extern "C" void kernel_launch(void* const* d_in, const int* in_sizes, int n_in, void* d_out, int out_size, void* d_ws, size_t ws_size, hipStream_t stream) {
    if (n_in != 17 || out_size != T * DM || ws_size < 512 * MiB) { fprintf(stderr, "kernel_launch: unexpected shapes n_in=%d out=%d ws=%zu\n", n_in, out_size, ws_size); return; }
    if (g_grid == 0) {
        int dev = 0, cus = 0;
        if (hipGetDevice(&dev) != hipSuccess || hipDeviceGetAttribute(&cus, hipDeviceAttributeMultiprocessorCount, dev) != hipSuccess) { fprintf(stderr, "kernel_launch: device query failed\n"); g_grid = -1; return; }
        if (hipFuncSetAttribute((const void*)mega, hipFuncAttributeMaxDynamicSharedMemorySize, LDS_BYTES) != hipSuccess) { fprintf(stderr, "kernel_launch: hipFuncSetAttribute failed\n"); g_grid = -1; return; }
        if (cus < 256) { fprintf(stderr, "kernel_launch: this kernel needs 256 co-resident workgroups (one per CU); the device has %d CUs\n", cus); g_grid = -1; return; }
        g_grid = 256;
    }
    if (g_grid < 0) return;
    char* ws = (char*)d_ws; float* out = (float*)d_out;
    (void)hipMemsetAsync(ws + WS_CTL + CW_BAR * 4, 0, XCD_BAR_WORDS * 4, stream);
    Args a{}; for (int i = 0; i < 17; ++i) a.in[i] = (const float*)d_in[i]; a.out = out; a.ws = (unsigned char*)d_ws;
    launch_mega(a, 0, N_PHASES, stream);
}
```

```cpp
#include <hip/hip_runtime.h>
#include <cstdio>
#include <cstdint>

typedef unsigned short bf16_t;
constexpr int Bn = 4, S = 4096, DM = 2048, T = Bn * S, NH = 8, HD = 128, FW = 1024, PW = 1024;
constexpr int INC = 8200, NPROJ = 8192;
constexpr int PH = 8, PK = 128, PQD = 256, TOPK = 16, NEXP = 16384;
constexpr float EPS = 1e-6f;
constexpr float SCALE = 0.08838834764831845f;
constexpr float INV_SCALE = 11.313708498984761f;
constexpr size_t MiB = 1u << 20;
constexpr size_t WS_WT_PG = 1 * MiB, WS_WT_BA = 2 * MiB, WS_WT_BP = 6 * MiB, WS_WT_OUT = 10 * MiB, WS_WT_Q = 18 * MiB, WS_SK = 26 * MiB, WS_SKB = 27 * MiB,
                 WS_CS = 28 * MiB, WS_LOGF = 29 * MiB, WS_SSQ = 30 * MiB, WS_IDX = 32 * MiB, WS_GATE = 40 * MiB,
                 WS_Q = 48 * MiB, WS_K = 80 * MiB, WS_V = 112 * MiB, WS_PIN = 144 * MiB, WS_G = 176 * MiB, WS_EU = 304 * MiB, WS_EV = 368 * MiB, WS_XG = 432 * MiB,
                 WS_TMP = 48 * MiB, WS_MERGED = 112 * MiB, WS_QP = 48 * MiB, WS_RAWQ = 304 * MiB, WS_RAWK = 368 * MiB, WS_SC = 176 * MiB;
constexpr size_t DO_H1 = 0, DO_WT_IN = 64 * MiB, DO_O = 0, DO_POOLED = 32 * MiB, DO_POOL2 = 64 * MiB;

__device__ __forceinline__ float bf2f(bf16_t v) { return __uint_as_float(((unsigned)v) << 16); }
__device__ __forceinline__ bf16_t f2bf(float f) { unsigned u = __float_as_uint(f); return (bf16_t)((u + 0x7fffu + ((u >> 16) & 1u)) >> 16); }


#define LAS __attribute__((address_space(3)))
#define GAS __attribute__((address_space(1)))
typedef short bf16x8 __attribute__((ext_vector_type(8)));
typedef float f32x4 __attribute__((ext_vector_type(4)));
typedef float f32x2 __attribute__((ext_vector_type(2)));
typedef unsigned u32x4 __attribute__((ext_vector_type(4)));
typedef unsigned u32x2 __attribute__((ext_vector_type(2)));
typedef int v8i_t __attribute__((ext_vector_type(8)));
typedef int i32x4_t __attribute__((ext_vector_type(4)));
constexpr int NWAVES = 8, NTHR = 512;
constexpr int RING_OFF = 0, RING_BYTES = 131072, EPI_OFF = 131072, EPI_BYTES = 16384, MISC_OFF = EPI_OFF + EPI_BYTES, LDS_BYTES = MISC_OFF + 512;
constexpr size_t WS_CTL = 0, CTL_ZERO_BYTES = 65536;
constexpr int CW_BAR = 1024;

__device__ __forceinline__ unsigned cvt_pk_bf16(float lo, float hi) { unsigned r; asm volatile("s_nop 0\n\tv_cvt_pk_bf16_f32 %0, %1, %2" : "=v"(r) : "v"(lo), "v"(hi)); return r; }
__device__ __forceinline__ float wave_sum(float v) {
#pragma unroll
    for (int o = 1; o < 64; o <<= 1) v += __shfl_xor(v, o);
    return v;
}
__device__ __forceinline__ int lane_now() { int l; asm volatile("v_mbcnt_lo_u32_b32 %0, -1, 0\n\tv_mbcnt_hi_u32_b32 %0, -1, %0" : "=v"(l)); return l; }
#define LDS_WAIT() asm volatile("s_waitcnt lgkmcnt(0)" ::: "memory")
#define VM_WAIT() asm volatile("s_waitcnt vmcnt(0)" ::: "memory")

namespace pg8 {
constexpr int BM = 256, BK = 64, HALF = 128, HTB = HALF * BK * 2, STAGE_BYTES = 8 * HTB, NXCD = 8, WGM = 8;
__host__ __device__ __forceinline__ int lds_byte(int r, int c) { const int st = (r >> 4) * 2 + (c >> 5), rr = r & 15, cc = c & 31, ob = rr * 64 + cc * 2; return st * 1024 + (ob ^ (((ob >> 9) & 1) << 5)); }
__host__ __device__ __forceinline__ void stage_rc(int b, int& R, int& C) { const int st = b / 1024, sb = b % 1024, swz = sb ^ (((sb >> 9) & 1) << 5); R = (st >> 1) * 16 + swz / 64; C = (st & 1) * 32 + (swz % 64) / 2; }
__host__ __device__ __forceinline__ int perm32(int rho) { const int n = rho >> 4, i = rho & 15; return 8 * (i >> 2) + 4 * n + (i & 3); }
struct Unit { int pm, pn, aux; };
__device__ __forceinline__ void order_map(int L, int nM, int nN, int nwg, Unit& u) {
    int wgid = L; { const int q = nwg / NXCD, r = nwg % NXCD, xcd = wgid % NXCD, off = wgid / NXCD; wgid = (xcd < r ? xcd * (q + 1) : r * (q + 1) + (xcd - r) * q) + off; }
    const int nig = WGM * nN, gid = wgid / nig, fm = gid * WGM, gsz = (nM - fm) < WGM ? (nM - fm) : WGM;
    u.pm = fm + ((wgid % nig) % gsz); u.pn = (wgid % nig) / gsz; u.aux = 0;
}
struct SchedStd {
    const char* A; const char* Bt; size_t a_tile, b_tile, a_kstride; int nM, nN, nwg, G, c;
    __device__ __forceinline__ bool next(int i, Unit& u) const { const long L = (long)i * G + c; if (L >= nwg) return false; order_map((int)L, nM, nN, nwg, u); return true; }
    __device__ __forceinline__ const char* a_ptr(const Unit& u) const { return A + (size_t)u.pm * a_tile + (size_t)u.pn * a_kstride; }
    __device__ __forceinline__ const char* b_ptr(const Unit& u) const { return Bt + (size_t)u.pn * b_tile; }
};
struct SchedPair {
    const char* A0; const char* A1; const char* B0; const char* B1; size_t a_tile, b_tile; int nM, nN, nwg, G, c;
    __device__ __forceinline__ bool next(int i, Unit& u) const { const long L = (long)(i >> 1) * G + c; if (L >= nwg) return false; order_map((int)L, nM, nN, nwg, u); u.aux = i & 1; return true; }
    __device__ __forceinline__ const char* a_ptr(const Unit& u) const { return (u.aux ? A1 : A0) + (size_t)u.pm * a_tile; }
    __device__ __forceinline__ const char* b_ptr(const Unit& u) const { return (u.aux ? B1 : B0) + (size_t)u.pn * b_tile; }
};
typedef f32x4 Acc[2][2][4][2];

template <bool FP8 = false, class Epi, class Sched>
__device__ __forceinline__ void gemm_phase(LAS unsigned char* lds, const int wid, const int K, const int lda, const int ldb, const Sched& S, const Epi& E) {
    const int lane = lane_now(), tid = wid * 64 + lane, wr = wid >> 2, wc = wid & 3, fr = lane & 15, fq = lane >> 4;
    const int nt = K / BK;
    unsigned voffA[2], voffB[2];
#pragma unroll
    for (int i = 0; i < 2; ++i) { int R, C; stage_rc(tid * 16 + i * 8192, R, C); const int Rb = (R & ~31) + perm32(R & 31);
        voffA[i] = (unsigned)(R * lda + C) * 2u; voffB[i] = (unsigned)(Rb * ldb + C) * 2u; }
    const size_t kstep = (size_t)(BK * 2);
    const size_t hstepA = (size_t)HALF * lda * 2, hstepB = (size_t)HALF * ldb * 2;
    const unsigned ldsw = (unsigned)wid * 1024u;
    const int aoff = lds_byte(wr * 64 + fr, fq * 8), boff = lds_byte(wc * 32 + fr, fq * 8);
#define PG8_SA(b, h) (((b) * 2 + (h)) * HTB)
#define PG8_SB(b, h) ((4 + (b) * 2 + (h)) * HTB)
#define PG8_STAGE(bufoff, gbase, voff) do { _Pragma("unroll") for (int _i = 0; _i < 2; ++_i) \
        __builtin_amdgcn_global_load_lds((const unsigned*)((const char*)(gbase) + (voff)[_i]), (LAS unsigned*)(lds + (bufoff) + ldsw + _i * 8192), 16, 0, 0); } while (0)
#define PG8_LDA(dst, b, h) do { if constexpr (FP8) { _Pragma("unroll") for (int m = 0; m < 4; ++m) dst##8[m] = __builtin_shufflevector(*(const LAS i32x4_t*)(lds + PG8_SA(b, h) + aoff + m * 2048), *(const LAS i32x4_t*)(lds + PG8_SA(b, h) + aoff + m * 2048 + 1024), 0, 1, 2, 3, 4, 5, 6, 7); } \
        else { _Pragma("unroll") for (int m = 0; m < 4; ++m) _Pragma("unroll") for (int k = 0; k < 2; ++k) dst[m][k] = *(const LAS bf16x8*)(lds + PG8_SA(b, h) + aoff + m * 2048 + k * 1024); } } while (0)
#define PG8_LDB(dst, b, h) do { if constexpr (FP8) { _Pragma("unroll") for (int n = 0; n < 2; ++n) dst##8[n] = __builtin_shufflevector(*(const LAS i32x4_t*)(lds + PG8_SB(b, h) + boff + n * 2048), *(const LAS i32x4_t*)(lds + PG8_SB(b, h) + boff + n * 2048 + 1024), 0, 1, 2, 3, 4, 5, 6, 7); } \
        else { _Pragma("unroll") for (int n = 0; n < 2; ++n) _Pragma("unroll") for (int k = 0; k < 2; ++k) dst[n][k] = *(const LAS bf16x8*)(lds + PG8_SB(b, h) + boff + n * 2048 + k * 1024); } } while (0)
#define PG8_MMA(ai, bj, At, Bt) do { if constexpr (!FP8) __builtin_amdgcn_s_setprio(1);     \
        if constexpr (FP8) { _Pragma("unroll") for (int m = 0; m < 4; ++m) _Pragma("unroll") for (int n = 0; n < 2; ++n) \
            acc[ai][bj][m][n] = __builtin_amdgcn_mfma_scale_f32_16x16x128_f8f6f4(Bt##8[n], At##8[m], acc[ai][bj][m][n], 0, 0, 0, 0x7f7f7f7f, 0, 0x7f7f7f7f); } \
        else { _Pragma("unroll") for (int m = 0; m < 4; ++m) _Pragma("unroll") for (int n = 0; n < 2; ++n) _Pragma("unroll") for (int k = 0; k < 2; ++k) \
            acc[ai][bj][m][n] = __builtin_amdgcn_mfma_f32_16x16x32_bf16(Bt[n][k], At[m][k], acc[ai][bj][m][n], 0, 0, 0); } \
        __builtin_amdgcn_s_setprio(0); } while (0)
#define PG8_WAIT_V(n) asm volatile("s_waitcnt vmcnt(" #n ")" ::: "memory")
#define PG8_WAIT_L(n) asm volatile("s_waitcnt lgkmcnt(" #n ")" ::: "memory")
#define PG8_BAR __builtin_amdgcn_s_barrier()
#define PG8_SCHED __builtin_amdgcn_sched_barrier(0)
    Unit cur, nxt; int ui = 0;
    if (!S.next(0, cur)) return;
    Acc acc;
#pragma unroll
    for (int a = 0; a < 2; ++a)
#pragma unroll
        for (int b = 0; b < 2; ++b)
#pragma unroll
            for (int m = 0; m < 4; ++m)
#pragma unroll
                for (int n = 0; n < 2; ++n) acc[a][b][m][n] = (f32x4){0.f, 0.f, 0.f, 0.f};
    bf16x8 At[4][2], B0[2][2], B1[2][2]; v8i_t At8[4], B08[2], B18[2];
    const char* cA = S.a_ptr(cur); const char* cB = S.b_ptr(cur);
    PG8_STAGE(PG8_SB(0, 0), cB, voffB); PG8_STAGE(PG8_SB(0, 1), cB + hstepB, voffB); PG8_STAGE(PG8_SA(0, 0), cA, voffA); PG8_STAGE(PG8_SA(0, 1), cA + hstepA, voffA);
    if (wr == 1) PG8_BAR;
    PG8_WAIT_V(2); PG8_BAR;
    PG8_STAGE(PG8_SB(1, 0), cB + kstep, voffB); PG8_STAGE(PG8_SA(1, 0), cA + kstep, voffA); PG8_STAGE(PG8_SB(1, 1), cB + hstepB + kstep, voffB);
    PG8_WAIT_V(6); PG8_BAR;
#pragma unroll 1
    for (;;) {
        const bool has_next = S.next(ui + 1, nxt);
        const char* nA = has_next ? S.a_ptr(nxt) : cA; const char* nB = has_next ? S.b_ptr(nxt) : cB;
#pragma unroll 1
        for (int t = 0; t < nt; t += 2) {
            const bool last = (t == nt - 2);
            const char* a1 = cA + (size_t)(t + 1) * kstep;
            const char* a2 = last ? nA : cA + (size_t)(t + 2) * kstep; const char* b2 = last ? nB : cB + (size_t)(t + 2) * kstep;
            const char* a3 = a2 + kstep; const char* b3 = b2 + kstep;
            PG8_LDB(B0, 0, 0); PG8_LDB(B1, 0, 1); PG8_SCHED; PG8_LDA(At, 0, 0); PG8_STAGE(PG8_SA(1, 1), a1 + hstepA, voffA);
            PG8_WAIT_V(8); PG8_WAIT_L(0); PG8_BAR; PG8_MMA(0, 0, At, B0); PG8_MMA(0, 1, At, B1); PG8_BAR; PG8_SCHED;
            PG8_LDA(At, 0, 1); PG8_STAGE(PG8_SB(0, 0), b2, voffB); PG8_STAGE(PG8_SB(0, 1), b2 + hstepB, voffB); PG8_STAGE(PG8_SA(0, 0), a2, voffA);
            PG8_WAIT_V(8); PG8_WAIT_L(0); PG8_BAR; PG8_MMA(1, 0, At, B0); PG8_MMA(1, 1, At, B1); PG8_BAR; PG8_SCHED;
            PG8_LDB(B0, 1, 0); PG8_LDB(B1, 1, 1); PG8_SCHED; PG8_LDA(At, 1, 0); PG8_STAGE(PG8_SA(0, 1), a2 + hstepA, voffA);
            PG8_WAIT_V(8); PG8_WAIT_L(0); PG8_BAR; PG8_MMA(0, 0, At, B0); PG8_MMA(0, 1, At, B1); PG8_BAR; PG8_SCHED;
            PG8_LDA(At, 1, 1); PG8_STAGE(PG8_SB(1, 0), b3, voffB); PG8_STAGE(PG8_SB(1, 1), b3 + hstepB, voffB); PG8_STAGE(PG8_SA(1, 0), a3, voffA);
            PG8_WAIT_V(8); PG8_WAIT_L(0); PG8_BAR; PG8_MMA(1, 0, At, B0); PG8_MMA(1, 1, At, B1); PG8_BAR; PG8_SCHED;
        }
        if (wr == 0) PG8_BAR;
        E(acc, cur, ui, wid);
        if (!has_next) break;
#pragma unroll
        for (int a = 0; a < 2; ++a)
#pragma unroll
            for (int b = 0; b < 2; ++b)
#pragma unroll
                for (int m = 0; m < 4; ++m)
#pragma unroll
                    for (int n = 0; n < 2; ++n) acc[a][b][m][n] = (f32x4){0.f, 0.f, 0.f, 0.f};
        cur = nxt; cA = nA; cB = nB; ++ui;
        if (wr == 1) PG8_BAR;
    }
    PG8_WAIT_V(0);
    PG8_BAR;
#undef PG8_SA
#undef PG8_SB
#undef PG8_STAGE
#undef PG8_LDA
#undef PG8_LDB
#undef PG8_MMA
#undef PG8_WAIT_V
#undef PG8_WAIT_L
#undef PG8_BAR
#undef PG8_SCHED
}
}

using pg8::Acc; using pg8::Unit;
__device__ __forceinline__ u32x4 pack8(const f32x4 a, const f32x4 b) { u32x4 w; w.x = cvt_pk_bf16(a[0], a[1]); w.y = cvt_pk_bf16(a[2], a[3]); w.z = cvt_pk_bf16(b[0], b[1]); w.w = cvt_pk_bf16(b[2], b[3]); return w; }
__device__ __forceinline__ void unpack8(const u32x4 w, f32x4& a, f32x4& b) {
    a[0] = __uint_as_float(w.x << 16); a[1] = __uint_as_float(w.x & 0xffff0000u); a[2] = __uint_as_float(w.y << 16); a[3] = __uint_as_float(w.y & 0xffff0000u);
    b[0] = __uint_as_float(w.z << 16); b[1] = __uint_as_float(w.z & 0xffff0000u); b[2] = __uint_as_float(w.w << 16); b[3] = __uint_as_float(w.w & 0xffff0000u);
}
__device__ __forceinline__ float sigmoidf_fast(float v) { return __builtin_amdgcn_rcpf(1.f + __builtin_amdgcn_exp2f(-1.4426950408889634f * v)); }

__device__ __forceinline__ unsigned long long pack8_u8(const f32x4 a, const f32x4 b) {
    unsigned w0 = 0u, w1 = 0u;
#pragma unroll
    for (int e = 0; e < 4; ++e) { w0 |= (unsigned)(a[e] * 255.f + 0.5f) << (8 * e); w1 |= (unsigned)(b[e] * 255.f + 0.5f) << (8 * e); }
    return (unsigned long long)w0 | ((unsigned long long)w1 << 32); }
__device__ __forceinline__ void unpack8_u8(const unsigned long long w, f32x4& a, f32x4& b) {
    const unsigned w0 = (unsigned)w, w1 = (unsigned)(w >> 32);
#pragma unroll
    for (int e = 0; e < 4; ++e) { a[e] = (float)((w0 >> (8 * e)) & 0xffu) * (1.f / 255.f); b[e] = (float)((w1 >> (8 * e)) & 0xffu) * (1.f / 255.f); } }
__device__ __forceinline__ unsigned long long pack8_f8(const f32x4 a, const f32x4 b) {
    int p0 = 0, p1 = 0;
    p0 = __builtin_amdgcn_cvt_pk_fp8_f32(a[0], a[1], p0, false); p0 = __builtin_amdgcn_cvt_pk_fp8_f32(a[2], a[3], p0, true);
    p1 = __builtin_amdgcn_cvt_pk_fp8_f32(b[0], b[1], p1, false); p1 = __builtin_amdgcn_cvt_pk_fp8_f32(b[2], b[3], p1, true);
    return (unsigned long long)(unsigned)p0 | ((unsigned long long)(unsigned)p1 << 32); }
__device__ __forceinline__ void unpack8_f8(const unsigned long long w, f32x4& a, f32x4& b) {
    const int w0 = (int)(unsigned)w, w1 = (int)(unsigned)(w >> 32);
    const f32x2 a0 = __builtin_amdgcn_cvt_pk_f32_fp8(w0, false), a1 = __builtin_amdgcn_cvt_pk_f32_fp8(w0, true), b0 = __builtin_amdgcn_cvt_pk_f32_fp8(w1, false), b1 = __builtin_amdgcn_cvt_pk_f32_fp8(w1, true);
    a = (f32x4){a0[0], a0[1], a1[0], a1[1]}; b = (f32x4){b0[0], b0[1], b1[0], b1[1]}; }
struct EpiProj {
    bf16_t* Q; bf16_t* Kt; bf16_t* V; bf16_t* PIN; bf16_t* G; const float* gq; const float* gk; LAS float* P; float inv;
    __device__ __forceinline__ void operator()(const Acc& acc, const Unit& u, int ui, int wid) const {
        const int lane = lane_now(), wr = wid >> 2, wc = wid & 3, fr = lane & 15, fq = lane >> 4;
        const int pn = u.pn, c8 = wc * 32 + fq * 8;
        if (pn < 8) {
            LAS float* Pb = P + (ui & 1) * 2048;
#pragma unroll
            for (int ai = 0; ai < 2; ++ai)
#pragma unroll
                for (int m = 0; m < 4; ++m)
#pragma unroll
                    for (int bj = 0; bj < 2; ++bj) { const f32x4 a = acc[ai][bj][m][0] * inv, b = acc[ai][bj][m][1] * inv;
                        float s = (a[0] * a[0] + a[1] * a[1]) + (a[2] * a[2] + a[3] * a[3]) + (b[0] * b[0] + b[1] * b[1]) + (b[2] * b[2] + b[3] * b[3]);
                        s += __shfl_xor(s, 16); s += __shfl_xor(s, 32);
                        if (fq == 0) Pb[((ai * 128 + wr * 64 + m * 16 + fr) * 2 + bj) * 4 + wc] = s; }
            LDS_WAIT(); __builtin_amdgcn_s_barrier(); asm volatile("" ::: "memory");
            const float* g = (pn < 4) ? gq : gk; bf16_t* dst = (pn < 4) ? Q : Kt; const int h0 = (pn & 3) * 2;
            const f32x4 g0 = *(const f32x4*)(g + c8), g1 = *(const f32x4*)(g + c8 + 4);
#pragma unroll
            for (int ai = 0; ai < 2; ++ai)
#pragma unroll
                for (int m = 0; m < 4; ++m) { const int rl = ai * 128 + wr * 64 + m * 16 + fr, row = u.pm * 256 + rl, bb = row >> 12, s = row & 4095;
#pragma unroll
                    for (int bj = 0; bj < 2; ++bj) { const f32x4 p = *(const LAS f32x4*)(Pb + (rl * 2 + bj) * 4);
                        const float rstd = rsqrtf(((p[0] + p[1]) + (p[2] + p[3])) * (1.f / 128.f) + EPS);
                        const f32x4 a = acc[ai][bj][m][0] * inv * rstd * g0, b = acc[ai][bj][m][1] * inv * rstd * g1;
                        *(u32x4*)(dst + (((size_t)bb * NH + h0 + bj) * S + s) * HD + c8) = pack8(a, b); } }
        } else if (pn < 12) {
            const int h0 = (pn - 8) * 2;
#pragma unroll
            for (int ai = 0; ai < 2; ++ai)
#pragma unroll
                for (int m = 0; m < 4; ++m) { const int row = u.pm * 256 + ai * 128 + wr * 64 + m * 16 + fr, bb = row >> 12, s = row & 4095;
#pragma unroll
                    for (int bj = 0; bj < 2; ++bj) *(u32x4*)(V + (((size_t)bb * NH + h0 + bj) * S + s) * HD + c8) = pack8(acc[ai][bj][m][0] * inv, acc[ai][bj][m][1] * inv); }
        } else if (pn < 16) {
#pragma unroll
            for (int ai = 0; ai < 2; ++ai)
#pragma unroll
                for (int m = 0; m < 4; ++m) { const int row = u.pm * 256 + ai * 128 + wr * 64 + m * 16 + fr;
#pragma unroll
                    for (int bj = 0; bj < 2; ++bj) *(u32x4*)(PIN + (size_t)row * PW + (pn - 12) * 256 + bj * 128 + c8) = pack8(acc[ai][bj][m][0] * inv, acc[ai][bj][m][1] * inv); }
        } else {
#pragma unroll
            for (int ai = 0; ai < 2; ++ai)
#pragma unroll
                for (int m = 0; m < 4; ++m) { const int row = u.pm * 256 + ai * 128 + wr * 64 + m * 16 + fr;
#pragma unroll
                    for (int bj = 0; bj < 2; ++bj) { f32x4 a = acc[ai][bj][m][0] * inv, b = acc[ai][bj][m][1] * inv;
#pragma unroll
                        for (int e = 0; e < 4; ++e) { a[e] = sigmoidf_fast(a[e]); b[e] = sigmoidf_fast(b[e]); }
                        *(unsigned long long*)((unsigned char*)G + (size_t)row * 4096 + (pn - 16) * 256 + bj * 128 + c8) = pack8_u8(a, b); } }
        }
    }
};
struct EpiGate {
    bf16_t* G; float inv;
    __device__ __forceinline__ void operator()(const Acc& acc, const Unit& u, int ui, int wid) const {
        const int lane = lane_now(), wr = wid >> 2, wc = wid & 3, fr = lane & 15, fq = lane >> 4;
        const int c8 = wc * 32 + fq * 8;
#pragma unroll
        for (int ai = 0; ai < 2; ++ai)
#pragma unroll
            for (int m = 0; m < 4; ++m) { const int row = u.pm * 256 + ai * 128 + wr * 64 + m * 16 + fr;
#pragma unroll
                for (int bj = 0; bj < 2; ++bj) { f32x4 a = acc[ai][bj][m][0] * inv, b = acc[ai][bj][m][1] * inv;
#pragma unroll
                    for (int e = 0; e < 4; ++e) { a[e] = sigmoidf_fast(a[e]); b[e] = sigmoidf_fast(b[e]); }
                    *(u32x4*)(G + (size_t)row * 4096 + u.pn * 256 + bj * 128 + c8) = pack8(a, b); } }
    }
};
struct EpiPool2 {
    bf16_t* O; const float* scale;
    __device__ __forceinline__ void operator()(const Acc& acc, const Unit& u, int ui, int wid) const {
        const int lane = lane_now(), wr = wid >> 2, wc = wid & 3, fr = lane & 15, fq = lane >> 4;
        const int c8 = wc * 32 + fq * 8;
#pragma unroll
        for (int bj = 0; bj < 2; ++bj) { const int col = u.pn * 256 + bj * 128 + c8; const f32x4 s0 = *(const f32x4*)(scale + col), s1 = *(const f32x4*)(scale + col + 4);
#pragma unroll
            for (int ai = 0; ai < 2; ++ai)
#pragma unroll
                for (int m = 0; m < 4; ++m) { const int row = u.pm * 256 + ai * 128 + wr * 64 + m * 16 + fr;
                    *(u32x4*)(O + (size_t)row * PW + col) = pack8(acc[ai][bj][m][0] * s0, acc[ai][bj][m][1] * s1); } }
    }
};
constexpr float TMP8_SCALE = 64.f;
template <int AUX>
struct EpiBranch {
    bf16_t* TMP; bf16_t* MERGED; const bf16_t* G; float inv;
    __device__ __forceinline__ void operator()(const Acc& acc, const Unit& u, int ui, int wid) const {
        const int lane = lane_now(), wr = wid >> 2, wc = wid & 3, fr = lane & 15, fq = lane >> 4;
        const int c8 = wc * 32 + fq * 8;
#pragma unroll
        for (int ai = 0; ai < 2; ++ai)
#pragma unroll
            for (int m = 0; m < 4; ++m) { const int row = u.pm * 256 + ai * 128 + wr * 64 + m * 16 + fr;
#pragma unroll
                for (int bj = 0; bj < 2; ++bj) { const int col = u.pn * 256 + bj * 128 + c8;
                    f32x4 ga, gb; unpack8_u8(*(const unsigned long long*)((const unsigned char*)G + (size_t)row * 4096 + AUX * 2048 + col), ga, gb);
                    f32x4 a = acc[ai][bj][m][0] * inv * ga, b = acc[ai][bj][m][1] * inv * gb;
                    if (AUX == 0) { *(unsigned long long*)((unsigned char*)TMP + (size_t)row * DM + col) = pack8_f8(a * TMP8_SCALE, b * TMP8_SCALE); }
                    else { f32x4 ta, tb; unpack8_f8(*(const unsigned long long*)((const unsigned char*)TMP + (size_t)row * DM + col), ta, tb);
                        *(u32x4*)(MERGED + (size_t)row * DM + col) = pack8(a + ta * (1.f / TMP8_SCALE), b + tb * (1.f / TMP8_SCALE)); } } }
    }
};
struct EpiOut {
    const float* x; bf16_t* XG; float* SSQ;
    __device__ __forceinline__ void operator()(const Acc& acc, const Unit& u, int ui, int wid) const {
        const int lane = lane_now(), wr = wid >> 2, wc = wid & 3, fr = lane & 15, fq = lane >> 4;
        const int c8 = wc * 32 + fq * 8;
#pragma unroll
        for (int ai = 0; ai < 2; ++ai)
#pragma unroll
            for (int m = 0; m < 4; ++m) { const int row = u.pm * 256 + ai * 128 + wr * 64 + m * 16 + fr; float ss = 0.f;
#pragma unroll
                for (int bj = 0; bj < 2; ++bj) { const size_t off = (size_t)row * DM + u.pn * 256 + bj * 128 + c8;
                    const f32x4 a = acc[ai][bj][m][0] + *(const f32x4*)(x + off), b = acc[ai][bj][m][1] + *(const f32x4*)(x + off + 4);
                    ss += (a[0] * a[0] + a[1] * a[1]) + (a[2] * a[2] + a[3] * a[3]) + (b[0] * b[0] + b[1] * b[1]) + (b[2] * b[2] + b[3] * b[3]);
                    *(u32x4*)(XG + off) = pack8(a, b); }
                ss += __shfl_xor(ss, 16); ss += __shfl_xor(ss, 32);
                if (fq == 0) SSQ[(size_t)row * 32 + u.pn * 4 + wc] = ss; }
    }
};
struct EpiBf16 {
    bf16_t* O; int ldc;
    __device__ __forceinline__ void operator()(const Acc& acc, const Unit& u, int ui, int wid) const {
        const int lane = lane_now(), wr = wid >> 2, wc = wid & 3, fr = lane & 15, fq = lane >> 4;
        const int c8 = wc * 32 + fq * 8;
#pragma unroll
        for (int ai = 0; ai < 2; ++ai)
#pragma unroll
            for (int m = 0; m < 4; ++m) { const int row = u.pm * 256 + ai * 128 + wr * 64 + m * 16 + fr;
#pragma unroll
                for (int bj = 0; bj < 2; ++bj) *(u32x4*)(O + (size_t)row * ldc + u.pn * 256 + bj * 128 + c8) = pack8(acc[ai][bj][m][0], acc[ai][bj][m][1]); }
    }
};

#define XB_TMO      128
#define XB_XCNT(j)  (256  + 64 * (j))
#define XB_XSUB(j)  (1280 + 64 * (j))
#define XB_XGEN(j)  (2304 + 64 * (j))
#define XB_TOP      3328
#define XB_TOPGEN   3392
#define XCD_BAR_WORDS 3456
#define XB_SPIN_CAP (1u << 18)
__device__ __forceinline__ unsigned xb_ld(unsigned* p)              { return __hip_atomic_load(p, __ATOMIC_RELAXED, __HIP_MEMORY_SCOPE_AGENT); }
__device__ __forceinline__ unsigned xb_add(unsigned* p, unsigned v) { return __hip_atomic_fetch_add(p, v, __ATOMIC_RELAXED, __HIP_MEMORY_SCOPE_AGENT); }
__device__ __forceinline__ unsigned xb_xcc_id() { return (unsigned)__builtin_amdgcn_s_getreg((3 << 11) | 20) & 0xFu; }
#define XB_SPIN(cond, bar) do { unsigned _sp = 0; while (cond) { __builtin_amdgcn_s_sleep(1); \
    if ((++_sp & 255u) == 0u) { if (xb_ld(&(bar)[XB_TMO])) break; if (_sp > XB_SPIN_CAP) { atomicAdd(&(bar)[XB_TMO], 1u); break; } } } } while (0)
struct XcdBarrier { unsigned* bar; unsigned x; volatile LAS unsigned* st; };
__device__ __forceinline__ XcdBarrier xcd_barrier_post(unsigned* bar, volatile LAS unsigned* st) {
    XcdBarrier b; b.bar = bar; b.x = xb_xcc_id(); b.st = st;
    if (threadIdx.x == 0) (void)xb_add(&bar[XB_XCNT(b.x)], 1u);
    return b;
}
__device__ __forceinline__ void xcd_barrier_complete(unsigned* bar, unsigned x, unsigned& nloc, unsigned& nx) {
    const unsigned G = gridDim.x * gridDim.y * gridDim.z;
    unsigned sum, cnt, mine, sp = 0u;
    for (;;) {
        sum = 0u; cnt = 0u; mine = 0u;
#pragma unroll
        for (unsigned j = 0; j < 16; ++j) { const unsigned c = xb_ld(&bar[XB_XCNT(j)]); sum += c; cnt += (c > 0u) ? 1u : 0u; mine = (j == x) ? c : mine; }
        if (sum == G) break;
        __builtin_amdgcn_s_sleep(1);
        if ((++sp & 255u) == 0u) { if (xb_ld(&bar[XB_TMO])) break; if (sp > XB_SPIN_CAP) { atomicAdd(&bar[XB_TMO], 1u); break; } }
    }
    nloc = mine > 0u ? mine : 1u; nx = cnt > 0u ? cnt : 1u;
}
__device__ __forceinline__ void xcd_barrier(const XcdBarrier& b) {
    asm volatile("s_waitcnt vmcnt(0)" ::: "memory");
    __syncthreads();
    if (threadIdx.x == 0) {
        unsigned* bar = b.bar;
        __builtin_amdgcn_s_waitcnt(0);
        unsigned nloc = b.st[0], nx = b.st[1];
        if (nloc == 0u) { xcd_barrier_complete(bar, b.x, nloc, nx); b.st[0] = nloc; b.st[1] = nx; }
        const unsigned old = xb_add(&bar[XB_XSUB(b.x)], 1u);
        const unsigned gen = old / nloc;
        if (old + 1u == (gen + 1u) * nloc) {
            __builtin_amdgcn_fence(__ATOMIC_RELEASE, "agent");
            asm volatile("s_waitcnt vmcnt(0)" ::: "memory");
            const unsigned og = xb_add(&bar[XB_TOP], 1u);
            const unsigned tg = og / nx;
            if (og + 1u == (tg + 1u) * nx) xb_add(&bar[XB_TOPGEN], 1u);
            else XB_SPIN(xb_ld(&bar[XB_TOPGEN]) == tg, bar);
            __builtin_amdgcn_fence(__ATOMIC_ACQUIRE, "agent");
            xb_add(&bar[XB_XGEN(b.x)], 1u);
            asm volatile("s_waitcnt vmcnt(0)" ::: "memory");
        } else {
            XB_SPIN(xb_ld(&bar[XB_XGEN(b.x)]) == gen, bar);
            __builtin_amdgcn_fence(__ATOMIC_ACQUIRE, "agent");
            asm volatile("s_waitcnt vmcnt(0)" ::: "memory");
        }
    }
    __syncthreads();
}

__device__ __forceinline__ unsigned pk2(float lo, float hi) { return (unsigned)f2bf(lo) | ((unsigned)f2bf(hi) << 16); }
__device__ __forceinline__ void p0_transpose_item(const float* W, int K, int N, bf16_t* WT, int row0, int src_col0, int k0, LAS float* scr, int lane, const float* kscale = nullptr) {
#pragma unroll 8
    for (int i = 0; i < 32; ++i) { const int kk = 2 * i + (lane >> 5); scr[kk * 33 + (lane & 31)] = W[(size_t)(k0 + kk) * N + src_col0 + (lane & 31)] * (kscale ? kscale[k0 + kk] : 1.f); }
    LDS_WAIT(); asm volatile("" ::: "memory");
    const int c = lane & 7;
#pragma unroll
    for (int j = 0; j < 4; ++j) { const int n = (lane >> 3) + 8 * j; const LAS float* s = scr + (8 * c) * 33 + n;
        u32x4 o; o.x = pk2(s[0 * 33], s[1 * 33]); o.y = pk2(s[2 * 33], s[3 * 33]); o.z = pk2(s[4 * 33], s[5 * 33]); o.w = pk2(s[6 * 33], s[7 * 33]);
        *(u32x4*)(WT + (size_t)(row0 + n) * K + k0 + 8 * c) = o; }
    LDS_WAIT(); asm volatile("" ::: "memory");
}


namespace att {
typedef short s16x4 __attribute__((ext_vector_type(4)));
typedef float f32x16 __attribute__((ext_vector_type(16)));
constexpr int D = 128, NW = 8, QBLK = 32, KVBLK = 64, QB = NW * QBLK;
constexpr int SHM_V = KVBLK * D * 2, SHM_K = KVBLK * D * 2;
constexpr int LDS_WS = 2 * SHM_V + 2 * SHM_K, LDS_CB = LDS_WS + NW * 64 * 4, LDS_ATT_BYTES = LDS_CB + 2 * 64 * 4;
constexpr float THR = 8.f;
constexpr float O8_SCALE = 32.f;
constexpr int OSTR = FW;
#define KSWZ(row, colB) ((row) * 256 + ((colB) ^ (((row) & 7) << 4)))
#define SBAR() __builtin_amdgcn_sched_barrier(0)
__device__ __forceinline__ int v_st(int k, int c) { const int kk = (k & ~0xC) | ((k & 4) << 1) | ((k & 8) >> 1); return ((kk >> 3) * 4 + (c >> 5)) * 512 + ((kk & 7) * 32 + (c & 31)) * 2; }
__device__ __forceinline__ int v_rd_base(int lane) { return ((lane & 3) << 3) | (((lane >> 2) & 3) << 6) | (((lane >> 4) & 1) << 5) | (((lane >> 5) & 1) << 8); }
constexpr int v_rd_off(int d0, int ks, int half) { return d0 * 512 + ks * 4096 + half * 2048; }
__device__ __forceinline__ int crow(int r, int hi) { return (r & 3) + 8 * (r >> 2) + 4 * hi; }
__device__ __forceinline__ unsigned cvtpk(float lo, float hi) { unsigned r; asm volatile("s_nop 0\n\tv_cvt_pk_bf16_f32 %0, %1, %2" : "=v"(r) : "v"(lo), "v"(hi)); return r; }
__device__ __forceinline__ bf16x8 load8(const bf16_t* p) { return *reinterpret_cast<const bf16x8*>(p); }
__device__ __forceinline__ void mask_tile(f32x16& p0, f32x16& p1, int dq) {
    const float NEG = -__builtin_inff();
#pragma unroll
    for (int r = 0; r < 16; ++r) { const int c = (r & 3) + 8 * (r >> 2);
        if (dq - c < 0) p0[r] = NEG;
        if (dq - c - 32 < 0) p1[r] = NEG; }
}
__device__ __forceinline__ void partialSM(f32x16& p0, f32x16& p1, float& m_reg, float& mn, float& alpha) {
    float pmax = p0[0];
#pragma unroll
    for (int r = 1; r < 16; ++r) pmax = fmaxf(pmax, p0[r]);
#pragma unroll
    for (int r = 0; r < 16; ++r) pmax = fmaxf(pmax, p1[r]);
    { auto rr = __builtin_amdgcn_permlane32_swap(__float_as_uint(pmax), __float_as_uint(pmax), false, false);
      pmax = fmaxf(__uint_as_float(rr[0]), __uint_as_float(rr[1])); }
    constexpr float C2 = 1.4426950408889634f * SCALE;
    if (__builtin_expect(__all((pmax - m_reg) * SCALE <= THR), 1)) { mn = m_reg; alpha = 1.f; }
    else { mn = fmaxf(m_reg, pmax); alpha = __builtin_amdgcn_exp2f((m_reg - mn) * C2); m_reg = mn; }
    const float mnL = -mn * C2;
#pragma unroll
    for (int r = 0; r < 16; ++r) p0[r] = fmaf(p0[r], C2, mnL);
#pragma unroll
    for (int r = 0; r < 16; ++r) p1[r] = fmaf(p1[r], C2, mnL);
#pragma unroll
    for (int r = 0; r < 16; ++r) p0[r] = __builtin_amdgcn_exp2f(p0[r]);
}
__device__ __forceinline__ void finishSM(f32x16& p0, f32x16& p1, float alpha, float& l_reg, bf16x8& pa0, bf16x8& pa1, bf16x8& pa2, bf16x8& pa3) {
#pragma unroll
    for (int r = 0; r < 16; ++r) p1[r] = __builtin_amdgcn_exp2f(p1[r]);
    float ps = 0;
#pragma unroll
    for (int r = 0; r < 16; ++r) ps += p0[r];
#pragma unroll
    for (int r = 0; r < 16; ++r) ps += p1[r];
    { auto rr = __builtin_amdgcn_permlane32_swap(__float_as_uint(ps), __float_as_uint(ps), false, false);
      ps = __uint_as_float(rr[0]) + __uint_as_float(rr[1]); }
    l_reg = l_reg * alpha + ps;
#define PK4(P, B_, OUT) do { unsigned a0 = cvtpk(P[B_+0], P[B_+1]), a1 = cvtpk(P[B_+2], P[B_+3]);                          \
        unsigned b0 = cvtpk(P[B_+4], P[B_+5]), b1 = cvtpk(P[B_+6], P[B_+7]);                                             \
        auto r0 = __builtin_amdgcn_permlane32_swap(a0, b0, false, false); auto r1 = __builtin_amdgcn_permlane32_swap(a1, b1, false, false); \
        u32x4 w = {r0[0], r1[0], r0[1], r1[1]}; OUT = *reinterpret_cast<bf16x8*>(&w); } while (0)
    PK4(p0, 0, pa0); PK4(p0, 8, pa1); PK4(p1, 0, pa2); PK4(p1, 8, pa3);
#undef PK4
}
template <int KB>
__device__ __forceinline__ void qkt(f32x16& p0, f32x16& p1, const char* K_lds, const float* CB, int r32, int hi, const bf16x8* qr, float cq) {
    const float* cb = CB + KB * 64 + 4 * hi;
#pragma unroll
    for (int g = 0; g < 4; ++g) { const f32x4 c0 = *(const f32x4*)(cb + 8 * g), c1 = *(const f32x4*)(cb + 32 + 8 * g);
#pragma unroll
        for (int e = 0; e < 4; ++e) { p0[4 * g + e] = cq - c0[e]; p1[4 * g + e] = cq - c1[e]; } }
    const char* kb[4];
#pragma unroll
    for (int dd = 0; dd < 4; ++dd) kb[dd] = K_lds + KB * SHM_K + KSWZ(r32, (dd * 16 + hi * 8) * 2);
#pragma unroll
    for (int d0 = 0; d0 < 8; ++d0) { const char* a = kb[d0 & 3] + (d0 >> 2) * 128;
        bf16x8 b0 = *reinterpret_cast<const bf16x8*>(a);
        bf16x8 b1 = *reinterpret_cast<const bf16x8*>(a + 32 * 256);
        p0 = __builtin_amdgcn_mfma_f32_32x32x16_bf16(b0, qr[d0], p0, 0, 0, 0);
        p1 = __builtin_amdgcn_mfma_f32_32x32x16_bf16(b1, qr[d0], p1, 0, 0, 0); }
}
template <int VB>
__device__ __forceinline__ void pv_tile(f32x16* o, int vb0, bf16x8 pa0, bf16x8 pa1, bf16x8 pa2, bf16x8 pa3) {
#define TRRD(dst, off) asm volatile("ds_read_b64_tr_b16 %0, %1 offset:%2" : "=&v"(dst) : "v"(vb0), "i"(off) : "memory")
#define PV_D0(d0) do { s16x4 l0, l1, l2, l3, h0, h1, h2, h3; constexpr int b_ = VB * SHM_V + v_rd_off(d0, 0, 0); \
        TRRD(l0, b_); TRRD(h0, b_ + 2048); TRRD(l1, b_ + 4096); TRRD(h1, b_ + 6144); TRRD(l2, b_ + 8192); TRRD(h2, b_ + 10240); TRRD(l3, b_ + 12288); TRRD(h3, b_ + 14336); \
        asm volatile("s_waitcnt lgkmcnt(0)" ::: "memory"); SBAR();   \
        o[d0] = __builtin_amdgcn_mfma_f32_32x32x16_bf16(pa0, (bf16x8){l0[0], l0[1], l0[2], l0[3], h0[0], h0[1], h0[2], h0[3]}, o[d0], 0, 0, 0);   \
        o[d0] = __builtin_amdgcn_mfma_f32_32x32x16_bf16(pa1, (bf16x8){l1[0], l1[1], l1[2], l1[3], h1[0], h1[1], h1[2], h1[3]}, o[d0], 0, 0, 0);   \
        o[d0] = __builtin_amdgcn_mfma_f32_32x32x16_bf16(pa2, (bf16x8){l2[0], l2[1], l2[2], l2[3], h2[0], h2[1], h2[2], h2[3]}, o[d0], 0, 0, 0);   \
        o[d0] = __builtin_amdgcn_mfma_f32_32x32x16_bf16(pa3, (bf16x8){l3[0], l3[1], l3[2], l3[3], h3[0], h3[1], h3[2], h3[3]}, o[d0], 0, 0, 0); } while (0)
    PV_D0(0); PV_D0(1); PV_D0(2); PV_D0(3);
#undef PV_D0
#undef TRRD
}
struct BlockRef { const bf16_t* Q; const bf16_t* K; const bf16_t* V; const float* C; unsigned char* O; int P0; int jlo; };
struct Seam { bf16x8 qr[8]; bf16x8 st_v0, st_v1, st_k0, st_k1; float st_c; float cq; };
#define ROW(p, k0, rr) ((p) + (size_t)((k0) + (rr)) * D + sc)
#define VMW() asm volatile("s_waitcnt vmcnt(0)" ::: "memory")
#define VMWN(n) asm volatile("s_waitcnt vmcnt(%0)" :: "i"(n) : "memory")
#define SLOAD_H(Kp, Vp, Cp, k0) do { S.st_v0 = load8(ROW(Vp, k0, sr)); S.st_v1 = load8(ROW(Vp, k0, 32 + sr));              \
                         S.st_k0 = load8(ROW(Kp, k0, sr)); S.st_k1 = load8(ROW(Kp, k0, 32 + sr)); S.st_c = (Cp)[(k0) + (tid & 63)]; } while (0)
#define SWRITE_HK(bf) do { *(bf16x8*)(K_lds + (bf) * SHM_K + kws) = S.st_k0; *(bf16x8*)(K_lds + (bf) * SHM_K + kws + 32 * 256) = S.st_k1; if (wid == 0) CB[(bf) * 64 + lane] = S.st_c; } while (0)
#define SWRITE_HV(bf) do { *(bf16x8*)(V_lds + (bf) * SHM_V + vst0) = S.st_v0; *(bf16x8*)(V_lds + (bf) * SHM_V + vst1) = S.st_v1; } while (0)
#define SWRITE_H(bf) do { SWRITE_HV(bf); SWRITE_HK(bf); } while (0)
__device__ __forceinline__ void attn_prime(const BlockRef& cur, char* lds, Seam& S, int wid) {
    const int lane = lane_now(), tid = wid * 64 + lane, r32 = lane & 31, hi = lane >> 5;
    const int sr = tid >> 4, sc = (tid & 15) * 8, kws = KSWZ(sr, sc * 2); char* K_lds = lds + 2 * SHM_V; float* CB = (float*)(lds + LDS_CB);
#pragma unroll
    for (int d0 = 0; d0 < 8; ++d0) S.qr[d0] = load8(cur.Q + (size_t)(wid * QBLK + r32) * D + d0 * 16 + hi * 8);
    S.cq = cur.C[cur.P0 + wid * QBLK + r32];
    SLOAD_H(cur.K, cur.V, cur.C, cur.jlo * KVBLK); VMW(); SWRITE_HK(0);
    __syncthreads();
}
__device__ __forceinline__ void attn_block(const BlockRef& cur, const BlockRef& nxt, char* lds, Seam& S, int wid) {
    const int lane = lane_now(), tid = wid * 64 + lane, r32 = lane & 31, hi = lane >> 5;
    const int NT = (cur.P0 + QB) / KVBLK - cur.jlo;
    const int qlo = cur.P0 + wid * QBLK, qm = qlo + r32 - 4 * hi;
    char* V_lds = lds; char* K_lds = lds + 2 * SHM_V; float* CB = (float*)(lds + LDS_CB);
    float* ws = (float*)(lds + LDS_WS) + wid * 64; float* li_l = ws, * al_l = ws + 32;
    float m_reg = -1e30f, l_reg = 0; f32x16 o[4] = {};
    const int sr = tid >> 4, sc = (tid & 15) * 8, vst0 = v_st(sr, sc), vst1 = v_st(32 + sr, sc), kws = KSWZ(sr, sc * 2);
    const int vb0 = (int)(uintptr_t)V_lds + v_rd_base(lane);
    const bf16_t* Kh = cur.K; const bf16_t* Vh = cur.V; const float* Ch = cur.C; const float cq = S.cq;
#define RESC(a) do { if (__any((a) < 1.f)) { if (hi == 0) al_l[r32] = (a); asm volatile("s_waitcnt lgkmcnt(0)" ::: "memory");              \
                     for (int d_ = 0; d_ < 4; ++d_) for (int r = 0; r < 16; ++r) o[d_][r] *= al_l[crow(r, hi)]; } } while (0)
#define KBASE(t) ((cur.jlo + (t)) * KVBLK)
#define MASKT(P0_, P1_, t) do { const int kb_ = KBASE(t); if (kb_ + KVBLK - 1 > qlo) mask_tile(P0_, P1_, qm - kb_); } while (0)
    constexpr int NQL = 9;
#define SEAM_K0() do { VMWN(NQL); SWRITE_HK(0); SBAR(); } while (0)
    f32x16 pA0, pA1, pB0, pB1; float mnA, mnB, alA, alB; bf16x8 pa0, pa1, pa2, pa3;
    SWRITE_HV(0); SBAR();
    if (NT > 1) { SLOAD_H(Kh, Vh, Ch, KBASE(1)); }
    SBAR(); qkt<0>(pA0, pA1, K_lds, CB, r32, hi, S.qr, cq);
    MASKT(pA0, pA1, 0); partialSM(pA0, pA1, m_reg, mnA, alA);
    if (NT > 1) { VMW(); SWRITE_H(1); }
    __syncthreads();
#define HALF_STEP(PX0, PX1, mnX, alX, PY0, PY1, alY, t, KB, VB, SB) do {                                                      \
        SBAR(); qkt<KB>(PX0, PX1, K_lds, CB, r32, hi, S.qr, cq);                                             \
        finishSM(PY0, PY1, alY, l_reg, pa0, pa1, pa2, pa3); SBAR();                                                           \
        if ((t) + 1 < NT) { SLOAD_H(Kh, Vh, Ch, KBASE((t) + 1)); SBAR(); }                                               \
        pv_tile<VB>(o, vb0, pa0, pa1, pa2, pa3); MASKT(PX0, PX1, (t)); partialSM(PX0, PX1, m_reg, mnX, alX);                                        \
        __syncthreads();                                                                                                      \
        if ((t) + 1 < NT) { VMW(); SWRITE_H(SB); }                                                                          \
        RESC(alX); __syncthreads(); } while (0)
    for (int t = 1; t + 1 < NT; t += 2) {
        HALF_STEP(pB0, pB1, mnB, alB, pA0, pA1, alA, t, 1, 0, 0);
        HALF_STEP(pA0, pA1, mnA, alA, pB0, pB1, alB, t + 1, 0, 1, 1);
    }
    const bool even = (NT & 1) == 0;
    if (even) { SBAR(); qkt<1>(pB0, pB1, K_lds, CB, r32, hi, S.qr, cq); SBAR(); }
    { SLOAD_H(nxt.K, nxt.V, nxt.C, nxt.jlo * KVBLK); SBAR();
#pragma unroll
      for (int d0 = 0; d0 < 8; ++d0) S.qr[d0] = load8(nxt.Q + (size_t)(wid * QBLK + r32) * D + d0 * 16 + hi * 8);
      S.cq = nxt.C[nxt.P0 + wid * QBLK + r32]; }
    SBAR();
    finishSM(pA0, pA1, alA, l_reg, pa0, pa1, pa2, pa3); SBAR();
    pv_tile<0>(o, vb0, pa0, pa1, pa2, pa3);
    if (even) { MASKT(pB0, pB1, NT - 1); partialSM(pB0, pB1, m_reg, mnB, alB); __syncthreads(); RESC(alB);
        finishSM(pB0, pB1, alB, l_reg, pa0, pa1, pa2, pa3); SBAR(); pv_tile<1>(o, vb0, pa0, pa1, pa2, pa3); }
    SBAR(); SEAM_K0();
    if (hi == 0) li_l[r32] = l_reg; asm volatile("s_waitcnt lgkmcnt(0)" ::: "memory");
    float rli[16];
#pragma unroll
    for (int r = 0; r < 16; ++r) rli[r] = __builtin_amdgcn_rcpf(li_l[crow(r, hi)]);
    unsigned char* Ow = cur.O + (size_t)(wid * QBLK) * OSTR;
#pragma unroll
    for (int r = 0; r < 16; ++r) { const int orow = crow(r, hi);
#pragma unroll
        for (int d0 = 0; d0 < 4; ++d0) { const float v = o[d0][r] * (rli[r] * O8_SCALE);
            const float vn = __shfl_xor(v, 1);
            const int p = __builtin_amdgcn_cvt_pk_fp8_f32(v, vn, 0, false);
            const int p2 = __shfl_xor(p, 2);
            if ((r32 & 3) == 0) *(unsigned*)(Ow + (size_t)orow * OSTR + d0 * 32 + r32) = ((unsigned)p & 0xffffu) | ((unsigned)p2 << 16); } }
    __syncthreads();
#undef RESC
#undef KBASE
#undef MASKT
#undef SEAM_K0
#undef HALF_STEP
}
#undef ROW
#undef VMW
#undef VMWN
#undef SLOAD_H
#undef SWRITE_HK
#undef SWRITE_HV
#undef SWRITE_H
#undef SBAR
}

typedef __bf16 bf16x2_t __attribute__((ext_vector_type(2)));

__device__ __forceinline__ float dot2bf(unsigned a, unsigned b, float c) {
    bf16x2_t av, bv; __builtin_memcpy(&av, &a, 4); __builtin_memcpy(&bv, &b, 4); return __builtin_amdgcn_fdot2_f32_bf16(av, bv, c, false); }
__device__ __forceinline__ float dot2bf_s(unsigned s_uniform, unsigned b, float c) { return dot2bf(s_uniform, b, c); }
namespace peer {
typedef float f32x16 __attribute__((ext_vector_type(16)));
__device__ __forceinline__ float fmaxs(float a, float b) { float r; asm("v_max_f32_e32 %0, %1, %2" : "=v"(r) : "v"(a), "v"(b)); return r; }
__device__ __forceinline__ float fmins(float a, float b) { float r; asm("v_min_f32_e32 %0, %1, %2" : "=v"(r) : "v"(a), "v"(b)); return r; }
#define CE(a, b) do { const float _h = fmaxs(a, b), _l = fmins(a, b); a = _h; b = _l; } while (0)
__device__ __forceinline__ void insert16(float (&L)[16], float x) {
#pragma unroll
    for (int i = 0; i < 16; ++i) { const float h = fmaxs(L[i], x); x = fmins(L[i], x); L[i] = h; }
}
__device__ __forceinline__ void sort16_desc(float (&v)[16]) {
#pragma unroll
    for (int k = 2; k <= 16; k <<= 1)
#pragma unroll
        for (int j = k >> 1; j >= 1; j >>= 1)
#pragma unroll
            for (int i = 0; i < 16; ++i) { const int l = i ^ j; if (l > i) { const bool desc = (i & k) == 0; const float hi_ = fmaxs(v[i], v[l]), lo_ = fmins(v[i], v[l]); v[i] = desc ? hi_ : lo_; v[l] = desc ? lo_ : hi_; } }
}
__device__ __forceinline__ void merge16(float (&L)[16], const float (&S)[16]) {
#pragma unroll
    for (int i = 0; i < 16; ++i) L[i] = fmaxs(L[i], S[15 - i]);
#pragma unroll
    for (int d = 8; d >= 1; d >>= 1)
#pragma unroll
        for (int i = 0; i < 16; ++i) if ((i & d) == 0) CE(L[i], L[i + d]);
}
__device__ __forceinline__ void merge_partner(float (&L)[16], const bool lo_half) {
    float B[16];
#pragma unroll
    for (int i = 0; i < 16; ++i) { auto r = __builtin_amdgcn_permlane32_swap(__float_as_uint(L[i]), __float_as_uint(L[i]), false, false);
        B[i] = __uint_as_float(lo_half ? r[1] : r[0]); }
#pragma unroll
    for (int i = 0; i < 16; ++i) L[i] = fmaxs(L[i], B[15 - i]);
#pragma unroll
    for (int d = 8; d >= 1; d >>= 1)
#pragma unroll
        for (int i = 0; i < 16; ++i) if ((i & d) == 0) CE(L[i], L[i + d]);
}
constexpr int KEYS_BYTES = 65536, SCR_OFF = 65536;
}

__device__ __forceinline__ void p0_transpose_item_fp8(const float* W, int K, int N, unsigned char* WT8, int row0, int src_col0, int k0, LAS float* scr, int lane, float sc) {
#pragma unroll 8
    for (int i = 0; i < 32; ++i) { const int kk = 2 * i + (lane >> 5); scr[kk * 33 + (lane & 31)] = W[(size_t)(k0 + kk) * N + src_col0 + (lane & 31)]; }
    LDS_WAIT(); asm volatile("" ::: "memory");
    const int c = lane & 3;
#pragma unroll
    for (int j = 0; j < 2; ++j) { const int n = (lane >> 2) + 16 * j; const LAS float* sp = scr + (16 * c) * 33 + n; u32x4 o;
#pragma unroll
        for (int q = 0; q < 4; ++q) { int p = 0; p = __builtin_amdgcn_cvt_pk_fp8_f32(sp[(4 * q) * 33] * sc, sp[(4 * q + 1) * 33] * sc, p, false); p = __builtin_amdgcn_cvt_pk_fp8_f32(sp[(4 * q + 2) * 33] * sc, sp[(4 * q + 3) * 33] * sc, p, true); o[q] = (unsigned)p; }
        *(u32x4*)(WT8 + (size_t)(row0 + n) * K + k0 + 16 * c) = o; }
    LDS_WAIT(); asm volatile("" ::: "memory");
}
constexpr float H8_SCALE = 16.f, W8_SCALE = 512.f;
constexpr size_t DO_W8 = 80 * MiB, DO_H8 = 96 * MiB;

struct Args { const float* in[17]; float* out; unsigned char* ws; int ph_lo, ph_hi; };
constexpr int N_PHASES = 11;

__global__ void __launch_bounds__(NTHR, 2) mega(Args args) {
    extern __shared__ __attribute__((aligned(16))) unsigned char lds_raw[];
    LAS unsigned char* lds = (LAS unsigned char*)lds_raw;
    volatile LAS unsigned* MISC = (volatile LAS unsigned*)(lds + MISC_OFF);
    const int wave = __builtin_amdgcn_readfirstlane((int)threadIdx.x >> 6);
    const int G = gridDim.x, bx = blockIdx.x, vcu = (G % 8 == 0) ? (bx % 8) * (G / 8) + bx / 8 : bx;
    unsigned char* ws = args.ws; char* dob = (char*)args.out;
    const float* x = args.in[0]; const float* g1 = args.in[1]; const float* w_in = args.in[2]; const float* fbias = args.in[3];
    const float* gq = args.in[4]; const float* gk = args.in[5]; const float* pgw = args.in[6]; const float* pscale = args.in[7];
    const float* wba = args.in[8]; const float* wbp = args.in[9]; const float* wout = args.in[10]; const float* g2 = args.in[11];
    const float* wq = args.in[12]; const float* sk1 = args.in[13]; const float* sk2 = args.in[14]; const float* eu = args.in[15]; const float* ev = args.in[16];
    bf16_t* WT_IN = (bf16_t*)(dob + DO_WT_IN); unsigned char* W8 = (unsigned char*)(dob + DO_W8); unsigned char* H8 = (unsigned char*)(dob + DO_H8); bf16_t* H1 = (bf16_t*)(dob + DO_H1); bf16_t* Ob = (bf16_t*)(dob + DO_O); bf16_t* POOLED = (bf16_t*)(dob + DO_POOLED); bf16_t* POOL2 = (bf16_t*)(dob + DO_POOL2);
    bf16_t* WT_PG = (bf16_t*)(ws + WS_WT_PG); bf16_t* WT_BA = (bf16_t*)(ws + WS_WT_BA); bf16_t* WT_BP = (bf16_t*)(ws + WS_WT_BP); bf16_t* WT_OUT = (bf16_t*)(ws + WS_WT_OUT); bf16_t* WT_Q = (bf16_t*)(ws + WS_WT_Q);
    bf16_t* SK = (bf16_t*)(ws + WS_SK); float* CS = (float*)(ws + WS_CS); float* LOGF = (float*)(ws + WS_LOGF); float* SSQ = (float*)(ws + WS_SSQ);
    bf16_t* Qb = (bf16_t*)(ws + WS_Q); bf16_t* Kb = (bf16_t*)(ws + WS_K); bf16_t* Vb = (bf16_t*)(ws + WS_V); bf16_t* PIN = (bf16_t*)(ws + WS_PIN); bf16_t* Gt = (bf16_t*)(ws + WS_G);
    bf16_t* EU = (bf16_t*)(ws + WS_EU); bf16_t* EV = (bf16_t*)(ws + WS_EV); bf16_t* XG = (bf16_t*)(ws + WS_XG); bf16_t* TMP = (bf16_t*)(ws + WS_TMP); bf16_t* MERGED = (bf16_t*)(ws + WS_MERGED); bf16_t* QP = (bf16_t*)(ws + WS_QP);
    for (int u = threadIdx.x; u < 128; u += NTHR) MISC[u] = 0u;
    __syncthreads();
    const int lo = args.ph_lo, hi = args.ph_hi;
    XcdBarrier bar; bar.bar = (unsigned*)(ws + WS_CTL) + CW_BAR + lo * XCD_BAR_WORDS; bar.x = 0; bar.st = MISC + 8;
    if (hi - lo > 1) bar = xcd_barrier_post(bar.bar, MISC + 8);
#define IN(k) (lo <= (k) && (k) < hi)
#define SEAM(k) do { if (IN(k) && IN((k) + 1)) xcd_barrier(bar); } while (0)
    const int gw = vcu * NWAVES + wave, NGW = G * NWAVES;

    if (IN(0)) {
        const int lane = lane_now(), tid = wave * 64 + lane;
        LAS float* scr = (LAS float*)(lds + RING_OFF + wave * 16384);
        constexpr int I_IN = (DM / 64) * (NPROJ / 32),     I_BA = (FW / 64) * (DM / 32), I_OUT = (DM / 64) * (DM / 32), I_PG = 4 * (256 / 64) * (256 / 32);
        constexpr int NITEMS = I_IN + 2 * I_BA + 2 * I_OUT + I_PG;
        for (int it = gw; it < NITEMS; it += NGW) {
            int r = it;
            if (r < I_IN) { const int nblk = NPROJ / 32, kb = r / nblk, nb = r % nblk, n0 = nb * 32;
                p0_transpose_item_fp8(w_in, DM, INC, W8, n0, n0 + (n0 >= 3072 ? 8 : 0), kb * 64, scr, lane, W8_SCALE);
                continue; } r -= I_IN;
            if (r < I_BA) { const int nblk = DM / 32, kb = r / nblk, nb = r % nblk; p0_transpose_item_fp8(wba, FW, DM, (unsigned char*)WT_BA, nb * 32, nb * 32, kb * 64, scr, lane, W8_SCALE); continue; } r -= I_BA;
            if (r < I_BA) { const int nblk = DM / 32, kb = r / nblk, nb = r % nblk; p0_transpose_item(wbp, PW, DM, WT_BP, nb * 32, nb * 32, kb * 64, scr, lane); continue; } r -= I_BA;
            if (r < I_OUT) { const int nblk = DM / 32, kb = r / nblk, nb = r % nblk; p0_transpose_item(wout, DM, DM, WT_OUT, nb * 32, nb * 32, kb * 64, scr, lane); continue; } r -= I_OUT;
            if (r < I_OUT) { const int nblk = DM / 32, kb = r / nblk, nb = r % nblk; p0_transpose_item(wq, DM, DM, WT_Q, nb * 32, nb * 32, kb * 64, scr, lane, g2); continue; } r -= I_OUT;
            { const int g = r / 32, rr = r % 32, kb = rr / 8, nb = rr % 8; p0_transpose_item(pgw + (size_t)g * 65536, 256, 256, WT_PG, g * 256 + nb * 32, nb * 32, kb * 64, scr, lane); }
        }
        for (int i = gw * 64 + lane; i < 2048 * 128 / 4; i += NGW * 64) { const int e = i * 4, d = e & 127, n = e >> 7, key = n & 127, f = (n >> 7) & 1, h = n >> 8;
            const f32x4 v = *(const f32x4*)((f ? sk2 : sk1) + ((size_t)h * 128 + key) * 128 + d); u32x2 o; o.x = pk2(v[0], v[1]); o.y = pk2(v[2], v[3]); *(u32x2*)(SK + e) = o; }
        { unsigned char* E8 = (unsigned char*)(ws + WS_EU); float* ESC = (float*)(ws + WS_EV);
          for (int r0 = gw; r0 < 2 * NEXP; r0 += 2 * NGW) {
            f32x4 v[2][8];
#pragma unroll
            for (int u = 0; u < 2; ++u) { const int r = r0 + u * NGW; const float* src = (r < NEXP ? eu : ev - (size_t)NEXP * DM) + (size_t)r * DM;
#pragma unroll
                for (int i = 0; i < 2; ++i)
#pragma unroll
                    for (int c = 0; c < 4; ++c) v[u][i * 4 + c] = *(const f32x4*)(src + 1024 * i + 16 * lane + 4 * c); }
#pragma unroll
            for (int u = 0; u < 2; ++u) { const int r = r0 + u * NGW; float am = 0.f;
                if (r < NEXP) {
#pragma unroll
                    for (int i = 0; i < 2; ++i)
#pragma unroll
                        for (int c = 0; c < 4; ++c) v[u][i * 4 + c] = v[u][i * 4 + c] * *(const f32x4*)(g2 + 1024 * i + 16 * lane + 4 * c); }
#pragma unroll
                for (int q = 0; q < 8; ++q) am = fmaxf(am, fmaxf(fmaxf(fabsf(v[u][q][0]), fabsf(v[u][q][1])), fmaxf(fabsf(v[u][q][2]), fabsf(v[u][q][3]))));
#pragma unroll
                for (int o = 1; o < 64; o <<= 1) am = fmaxf(am, __shfl_xor(am, o));
                int ex = (int)((__float_as_uint(am) >> 23) & 0xffu); if (ex < 16) ex = 134;
                const float sc = __uint_as_float((unsigned)(261 - ex) << 23), inv = __uint_as_float((unsigned)(ex - 7) << 23);
#pragma unroll
                for (int i = 0; i < 2; ++i) { u32x4 w;
#pragma unroll
                    for (int c = 0; c < 4; ++c) { const f32x4 t = v[u][i * 4 + c] * sc; int p = 0;
                        p = __builtin_amdgcn_cvt_pk_fp8_f32(t[0], t[1], p, false); p = __builtin_amdgcn_cvt_pk_fp8_f32(t[2], t[3], p, true); w[c] = (unsigned)p; }
                    *(u32x4*)(E8 + (size_t)(r >= NEXP) * NEXP * DM + ((size_t)(8 * i + (lane >> 3)) * NEXP + (r & (NEXP - 1))) * 128 + 16 * (lane & 7)) = w; }
                if (lane == 0) ESC[r] = inv; }
          } }
        __syncthreads();
        LAS f32x4* WfL = (LAS f32x4*)(lds + RING_OFF);
        for (int i = tid; i < 4096; i += NTHR) { const int l = i & 63, half = (i >> 6) & 1, e = (i >> 7) & 3, j = i >> 9, k = 256 * j + 4 * l + e;
            WfL[i] = *(const f32x4*)(w_in + (size_t)k * INC + 3072 + 4 * half); }
        __syncthreads();
        f32x4 gv[8];
#pragma unroll
        for (int j = 0; j < 8; ++j) gv[j] = ((const f32x4*)g1)[64 * j + lane];
        for (int row0 = gw; row0 < T; row0 += 2 * NGW) {
            asm volatile("" ::: "memory");
            f32x4 v[2][8];
#pragma unroll
            for (int u = 0; u < 2; ++u) { const f32x4* xr = (const f32x4*)(x + (size_t)(row0 + u * NGW) * DM) + lane;
#pragma unroll
                for (int j = 0; j < 8; ++j) v[u][j] = xr[64 * j]; }
#pragma unroll
            for (int u = 0; u < 2; ++u) { const int row = row0 + u * NGW; float ss = 0.f;
#pragma unroll
                for (int j = 0; j < 8; ++j) ss += (v[u][j][0] * v[u][j][0] + v[u][j][1] * v[u][j][1]) + (v[u][j][2] * v[u][j][2] + v[u][j][3] * v[u][j][3]);
                const float rstd = rsqrtf(wave_sum(ss) * (1.f / DM) + EPS);
                f32x4 a0 = {0.f, 0.f, 0.f, 0.f}, a1 = {0.f, 0.f, 0.f, 0.f};
#pragma unroll
                for (int j = 0; j < 8; ++j) { const f32x4 hv = v[u][j] * rstd * gv[j];
                    { int p8 = 0; p8 = __builtin_amdgcn_cvt_pk_fp8_f32(hv[0] * H8_SCALE, hv[1] * H8_SCALE, p8, false); p8 = __builtin_amdgcn_cvt_pk_fp8_f32(hv[2] * H8_SCALE, hv[3] * H8_SCALE, p8, true);
                      ((unsigned*)(H8 + (size_t)row * DM))[64 * j + lane] = (unsigned)p8; }
#pragma unroll
                    for (int e = 0; e < 4; ++e) { a0 += WfL[((j * 4 + e) * 2 + 0) * 64 + lane] * hv[e]; a1 += WfL[((j * 4 + e) * 2 + 1) * 64 + lane] * hv[e]; } }
                float z = 0.f;
#pragma unroll
                for (int c = 0; c < 8; ++c) { const float t = wave_sum(c < 4 ? a0[c & 3] : a1[c & 3]); if (lane == c) z = t; }
                if (lane < 8) { z += fbias[lane]; LOGF[(size_t)row * 8 + lane] = fminf(z, 0.f) - log1pf(expf(-fabsf(z))); } }
        }
    }
    SEAM(0);
    if (IN(1)) {
        if (bx < 32) {   const int lane = lane_now(), tid = wave * 64 + lane;
            LAS float* wsum = (LAS float*)(lds + EPI_OFF);
            const int b = bx >> 3, h = bx & 7; float v[8]; float run = 0.f;
#pragma unroll
            for (int i = 0; i < 8; ++i) { run += LOGF[((size_t)(b * S + tid * 8 + i)) * 8 + h]; v[i] = run; }
            float inc = run;
#pragma unroll
            for (int o = 1; o < 64; o <<= 1) { const float t = __shfl_up(inc, o); if (lane >= o) inc += t; }
            if (lane == 63) wsum[wave] = inc;
            __syncthreads();
            float base = inc - run;
            for (int w = 0; w < wave; ++w) base += wsum[w];
#pragma unroll
            for (int i = 0; i < 8; ++i) CS[(size_t)bx * S + tid * 8 + i] = (base + v[i]) * INV_SCALE;
            __syncthreads();
        }
        { pg8::SchedStd Sc{(const char*)H8, (const char*)W8, (size_t)256 * DM, (size_t)256 * DM, 0, T / 256, NPROJ / 256, (T / 256) * (NPROJ / 256), G, bx};
          EpiProj E{Qb, Kb, Vb, PIN, Gt, gq, gk, (LAS float*)(lds + EPI_OFF), 1.f / (H8_SCALE * W8_SCALE)};
          pg8::gemm_phase<true>(lds + RING_OFF, wave, DM / 2, DM / 2, DM / 2, Sc, E); }
    }
    SEAM(1);
    if (IN(2)) {
        const int lane = lane_now(), sub = lane >> 4, l16 = lane & 15;
#define POOL_BODY(W) do { \
            const int s0 = rb * 8, sq = s0 & (S - 1); const bf16_t* pp = PIN + (size_t)s0 * PW + ch; \
            f32x4 Pa[W + 7], Pb[W + 7]; \
            _Pragma("unroll") for (int r = 0; r < W + 7; ++r) { const int rel = r - (W - 1); \
                if (sq + rel >= 0) unpack8(*(const u32x4*)(pp + (long)rel * PW), Pa[r], Pb[r]); else { Pa[r] = (f32x4){0.f, 0.f, 0.f, 0.f}; Pb[r] = Pa[r]; } } \
            f32x4 Sa = {0.f, 0.f, 0.f, 0.f}, Sb = Sa; \
            _Pragma("unroll") for (int r = 0; r < W - 1; ++r) { Sa += Pa[r]; Sb += Pb[r]; } \
            _Pragma("unroll") for (int r = 0; r < 8; ++r) { Sa += Pa[r + W - 1]; Sb += Pb[r + W - 1]; \
                const int cnt = (sq + r + 1 < W) ? sq + r + 1 : W; const float inv = 1.f / (float)cnt; \
                *(u32x4*)(POOLED + (size_t)(s0 + r) * PW + ch) = pack8(Sa * inv - Pa[r + W - 1], Sb * inv - Pb[r + W - 1]); \
                Sa -= Pa[r]; Sb -= Pb[r]; } } while (0)
        for (int itp = gw; itp < 4 * (T / 16); itp += NGW) {
            const int g = itp & 3, rb = (itp >> 2) * 2 + (lane >> 5), ch = g * 256 + (lane & 31) * 8;
            if (g == 0) POOL_BODY(2); else if (g == 1) POOL_BODY(4); else if (g == 2) POOL_BODY(8); else POOL_BODY(16);
        }
#undef POOL_BODY
    }
    SEAM(2);
    if (IN(3)) {
        float bq;
        { const int lane = lane_now(); float a = fmaxf(fabsf(gq[lane]), fabsf(gq[64 + lane])), b2 = fmaxf(fabsf(gk[lane]), fabsf(gk[64 + lane]));
#pragma unroll
          for (int o = 1; o < 64; o <<= 1) { a = fmaxf(a, __shfl_xor(a, o)); b2 = fmaxf(b2, __shfl_xor(b2, o)); }
          bq = 128.f * SCALE * a * b2 + EPS; }
        const float cmargin = (25.f + 2.f * bq) * INV_SCALE;
#define ATT_JLO(Chp, qb) ({ const int lane_ = lane_now(), nte_ = 4 * ((qb) + 1); const float thr_ = (Chp)[(qb) * 256] + cmargin; \
            const float v_ = (lane_ < nte_) ? (Chp)[64 * lane_ + 63] : -3.0e38f; const int n_ = (int)__builtin_popcountll(__ballot(v_ > thr_)); \
            __builtin_amdgcn_readfirstlane(n_ < nte_ - 4 ? n_ : nte_ - 4); })
        LAS int* cst = (LAS int*)(lds + EPI_OFF); LAS int* ord = cst + 512;
        { const int i = threadIdx.x, bh_ = i >> 4, qb_ = i & 15, nte_ = 4 * (qb_ + 1); const float* Chp = CS + (size_t)bh_ * S; const float thr_ = Chp[qb_ * 256] + cmargin;
          int n_ = 0;
          for (int t = 0; t < nte_; ++t) n_ += (Chp[64 * t + 63] > thr_) ? 1 : 0;
          cst[i] = nte_ - (n_ < nte_ - 4 ? n_ : nte_ - 4);
          __syncthreads();
          const int c_ = cst[i]; int r_ = 0;
#pragma unroll 8
          for (int j = 0; j < 512; ++j) { const int cj = cst[j]; r_ += (cj > c_ || (cj == c_ && j < i)) ? 1 : 0; }
          ord[r_] = i;
          __syncthreads(); }
        for (int L = vcu; L < Bn * NH * 8; L += G) {
            const int iA = ord[L], iB = ord[Bn * NH * 16 - 1 - L];
            const int bhA = iA >> 4, xA = iA & 15, bA = bhA >> 3, hA = bhA & 7, bhB = iB >> 4, xB = iB & 15, bB = bhB >> 3, hB = bhB & 7;
            const float* ChA = CS + (size_t)bhA * S; const float* ChB = CS + (size_t)bhB * S;
            const int j0 = ATT_JLO(ChA, xA), j1 = ATT_JLO(ChB, xB);
            att::BlockRef r0{Qb + ((size_t)bhA * S + xA * 256) * HD, Kb + (size_t)bhA * S * HD, Vb + (size_t)bhA * S * HD, ChA, (unsigned char*)Ob + ((size_t)(bA * S + xA * 256)) * FW + hA * HD, xA * 256, j0};
            att::BlockRef r1{Qb + ((size_t)bhB * S + xB * 256) * HD, Kb + (size_t)bhB * S * HD, Vb + (size_t)bhB * S * HD, ChB, (unsigned char*)Ob + ((size_t)(bB * S + xB * 256)) * FW + hB * HD, xB * 256, j1};
            att::Seam Sm;
            att::attn_prime(r0, (char*)lds_raw, Sm, wave);
            att::attn_block(r0, r1, (char*)lds_raw, Sm, wave);
            att::attn_block(r1, r1, (char*)lds_raw, Sm, wave);
        }
#undef ATT_JLO
        VM_WAIT(); __syncthreads();
        pg8::SchedStd Sc{(const char*)POOLED, (const char*)WT_PG, (size_t)256 * PW * 2, (size_t)256 * 256 * 2, (size_t)256 * 2, T / 256, PW / 256, (T / 256) * (PW / 256), G, bx};
        EpiPool2 E{POOL2, pscale};
        pg8::gemm_phase(lds + RING_OFF, wave, 256, PW, 256, Sc, E);
    }
    SEAM(3);
    if (IN(4)) {
        { pg8::SchedStd Sc{(const char*)Ob, (const char*)WT_BA, (size_t)256 * FW, (size_t)256 * FW, 0, T / 256, DM / 256, (T / 256) * (DM / 256), G, bx};
          EpiBranch<0> E{TMP, MERGED, Gt, 1.f / (att::O8_SCALE * W8_SCALE)};
          pg8::gemm_phase<true>(lds + RING_OFF, wave, FW / 2, FW / 2, FW / 2, Sc, E); }
        { pg8::SchedStd Sc{(const char*)POOL2, (const char*)WT_BP, (size_t)256 * FW * 2, (size_t)256 * FW * 2, 0, T / 256, DM / 256, (T / 256) * (DM / 256), G, bx};
          EpiBranch<1> E{TMP, MERGED, Gt, 1.f};
          pg8::gemm_phase(lds + RING_OFF, wave, FW, FW, FW, Sc, E); }
    }
    SEAM(4);
    if (IN(5)) {
        pg8::SchedStd Sc{(const char*)MERGED, (const char*)WT_OUT, (size_t)256 * DM * 2, (size_t)256 * DM * 2, 0, T / 256, DM / 256, (T / 256) * (DM / 256), G, bx};
        EpiOut E{x, XG, SSQ};
        pg8::gemm_phase(lds + RING_OFF, wave, DM, DM, DM, Sc, E);
    }
    SEAM(5);
    if (IN(6)) {
        pg8::SchedStd Sc{(const char*)XG, (const char*)WT_Q, (size_t)256 * DM * 2, (size_t)256 * DM * 2, 0, T / 256, DM / 256, (T / 256) * (DM / 256), G, bx};
        EpiBf16 E{QP, DM};
        pg8::gemm_phase(lds + RING_OFF, wave, DM, DM, DM, Sc, E);
    }
    SEAM(6);

    if (IN(7)) {
        const int lane = lane_now(), tid = wave * 64 + lane, r32 = lane & 31, hi = lane >> 5, h = vcu & 7;
#pragma unroll
        for (int i = 0; i < 8; ++i) { const int idx = tid + 512 * i, le = idx & 63, ks = (idx >> 6) & 7, tile = (idx >> 9) & 3, f = idx >> 11;
            const u32x4 v = *(const u32x4*)(SK + ((size_t)(h * 256 + f * 128 + 32 * tile + (le & 31)) * 128 + 16 * ks + 8 * (le >> 5)));
            *(LAS u32x4*)(lds + idx * 16) = v; }
        __syncthreads();
        LAS unsigned* scr = (LAS unsigned*)(lds + peer::SCR_OFF + wave * 8192) + lane;
        const unsigned nh4 = (unsigned)(1 - hi) << 2; const float NEGINF = -__builtin_inff();
        int* IDX = (int*)(ws + WS_IDX); float* GATE = (float*)(ws + WS_GATE);
        for (int tl = vcu >> 3; tl < T / 256; tl += G >> 3) {
            const int tok = tl * 256 + wave * 32 + r32;
            bf16x8 qf[2][8];
#pragma unroll
            for (int f = 0; f < 2; ++f)
#pragma unroll
                for (int ks = 0; ks < 8; ++ks) qf[f][ks] = *(const bf16x8*)(QP + (size_t)tok * DM + h * 256 + f * 128 + 16 * ks + 8 * hi);
            float tot = 0.f;
#pragma unroll
            for (int i = 0; i < 8; ++i) { const f32x4 v = *(const f32x4*)(SSQ + (size_t)tok * 32 + 4 * i); tot += (v[0] + v[1]) + (v[2] + v[3]); }
            const float rstd = rsqrtf(tot * (1.f / DM) + EPS);
            float KL[2][16];
#pragma unroll
            for (int f = 0; f < 2; ++f) {
                float L[16];
#pragma unroll
                for (int i = 0; i < 16; ++i) L[i] = NEGINF;
#pragma unroll
                for (int tile = 0; tile < 4; ++tile) {
                    peer::f32x16 acc = {};
#pragma unroll
                    for (int ks = 0; ks < 8; ++ks) acc = __builtin_amdgcn_mfma_f32_32x32x16_bf16(*(const LAS bf16x8*)(lds + (((f * 4 + tile) * 8 + ks) * 64 + lane) * 16), qf[f][ks], acc, 0, 0, 0);
                    float Sk[16];
#pragma unroll
                    for (int r = 0; r < 16; ++r) { const unsigned cp = (unsigned)(127 - 32 * tile - (r & 3) - 8 * (r >> 2) - 4);
                        Sk[r] = __uint_as_float(((__float_as_uint(acc[r]) & 0xffffff80u) | nh4) | cp); }
                    peer::sort16_desc(Sk);
                    if (tile == 0) {
#pragma unroll
                        for (int i = 0; i < 16; ++i) L[i] = Sk[i]; }
                    else peer::merge16(L, Sk);
                }
                peer::merge_partner(L, hi == 0);
#pragma unroll
                for (int i = 0; i < 16; ++i) KL[f][i] = L[i];
            }
            float Tt[16];
#pragma unroll
            for (int i = 0; i < 16; ++i) Tt[i] = NEGINF;
#pragma unroll
            for (int i = 0; i < 16; ++i)
#pragma unroll
                for (int j = 0; j < 16; ++j) if ((i + 1) * (j + 1) <= 16) {
                    const float sm = __uint_as_float(__float_as_uint(KL[0][i]) & 0xffffff80u) + __uint_as_float(__float_as_uint(KL[1][j]) & 0xffffff80u);
                    peer::insert16(Tt, __uint_as_float((__float_as_uint(sm) & 0xffffff00u) | (unsigned)(255 - (16 * i + j)))); }
#pragma unroll
            for (int k = 0; k < 16; ++k) { scr[k * 64] = __float_as_uint(KL[0][k]); scr[(16 + k) * 64] = __float_as_uint(KL[1][k]); }
            LDS_WAIT();
            int ex[16]; float gt[16]; float gs = 0.f;
            const float s0 = __uint_as_float(__float_as_uint(Tt[0]) & 0xffffff00u) * rstd;
#pragma unroll
            for (int r = 0; r < 16; ++r) { const unsigned tb = __float_as_uint(Tt[r]), pos = 255u - (tb & 255u), ci = pos >> 4, cj = pos & 15u;
                const unsigned a = scr[ci * 64], b = scr[(16 + cj) * 64];
                ex[r] = (int)((127u - (a & 127u)) * 128u + (127u - (b & 127u)));
                gt[r] = __expf(__uint_as_float(tb & 0xffffff00u) * rstd - s0); gs += gt[r]; }
            const float ginv = 1.f / gs;
            if (hi == 0) { int* o = IDX + (size_t)tok * 128 + h * 16;
#pragma unroll
                for (int q4 = 0; q4 < 4; ++q4) *(int4*)(o + 4 * q4) = make_int4(ex[4 * q4], ex[4 * q4 + 1], ex[4 * q4 + 2], ex[4 * q4 + 3]); }
            else { float* o = GATE + (size_t)tok * 128 + h * 16;
#pragma unroll
                for (int q4 = 0; q4 < 4; ++q4) *(f32x4*)(o + 4 * q4) = (f32x4){gt[4 * q4] * ginv, gt[4 * q4 + 1] * ginv, gt[4 * q4 + 2] * ginv, gt[4 * q4 + 3] * ginv}; }
            LDS_WAIT();
        }
    }
    SEAM(7);
    bf16_t* PA = (bf16_t*)(ws + WS_MERGED); float* HS = (float*)(ws + WS_QP);
    if (IN(8)) {
        const int lane = lane_now(), l8 = lane & 7, lg = lane >> 3, grp = bx & 7, nwv = (G >> 3) * NWAVES, wg = (bx >> 3) * NWAVES + wave;
        const int* IDX = (const int*)(ws + WS_IDX); const unsigned char* EU8 = (const unsigned char*)(ws + WS_EU);
#define P8_IDX(E, tk) do { const int* ip_ = IDX + (size_t)((tk) < T ? (tk) : T - 1) * 128 + lane; E[0] = ip_[0]; E[1] = ip_[64]; } while (0)
#define P8_ROWS(R, E, XA, XB, tk) do { _Pragma("unroll") for (int i = 0; i < 16; ++i) { const int e_ = __shfl(E[i >> 3], ((8 * i) & 63) + lg); R[i] = *(const u32x4*)(EU8 + (unsigned)(e_ * 128 + coffT)); } \
            const bf16_t* xp_ = XG + (size_t)((tk) < T ? (tk) : T - 1) * DM + coff; XA = *(const u32x4*)xp_; XB = *(const u32x4*)(xp_ + 8); } while (0)
#define P8_DPP(x, ctrl) __uint_as_float(__builtin_amdgcn_update_dpp(0u, __float_as_uint(x), ctrl, 0xf, 0xf, false))
#define P8_COMP(R, XA, XB, tk) do { f32x2 xf[8]; \
            _Pragma("unroll") for (int d = 0; d < 4; ++d) { xf[d] = (f32x2){__uint_as_float(XA[d] << 16), __uint_as_float(XA[d] & 0xffff0000u)}; xf[4 + d] = (f32x2){__uint_as_float(XB[d] << 16), __uint_as_float(XB[d] & 0xffff0000u)}; } \
            float sd[16]; \
            _Pragma("unroll") for (int i = 0; i < 16; ++i) { f32x2 a2 = {0.f, 0.f}; \
                _Pragma("unroll") for (int d = 0; d < 4; ++d) { a2 += __builtin_amdgcn_cvt_pk_f32_fp8((int)R[i][d], false) * xf[2 * d]; a2 += __builtin_amdgcn_cvt_pk_f32_fp8((int)R[i][d], true) * xf[2 * d + 1]; } \
                sd[i] = a2[0] + a2[1]; } \
              \
            float s8[8], s4[4], s2_[2]; \
            _Pragma("unroll") for (int k = 0; k < 8; ++k) { const float keep = q2 ? sd[k + 8] : sd[k], give = q2 ? sd[k] : sd[k + 8]; s8[k] = keep + P8_DPP(give, 0x141); }     \
            _Pragma("unroll") for (int k = 0; k < 4; ++k) { const float keep = q1 ? s8[k + 4] : s8[k], give = q1 ? s8[k] : s8[k + 4]; s4[k] = keep + P8_DPP(give, 0x4E); }      \
            _Pragma("unroll") for (int k = 0; k < 2; ++k) { const float keep = q0 ? s4[k + 2] : s4[k], give = q0 ? s4[k] : s4[k + 2]; s2_[k] = keep + P8_DPP(give, 0xB1); }     \
            if ((tk) < T) *(unsigned*)(PA + ((size_t)(tk) * 16 + c) * 128 + 2 * lane) = cvt_pk_bf16(s2_[0], s2_[1]); } while (0)
        const bool q2 = (lane & 4) != 0, q1 = (lane & 2) != 0, q0 = (lane & 1) != 0;
        LAS unsigned* wq = (LAS unsigned*)(lds + MISC_OFF + 128);
        if (lane == 0 && wave == 0) { wq[0] = 0u; wq[1] = 0u; }
        __syncthreads();
        const int tok0 = (bx >> 3) * NWAVES, npair = (T / nwv) * NWAVES / 2;
#define WQ_NEXT(slot) __builtin_amdgcn_readfirstlane((int)(lane == 0 ? __hip_atomic_fetch_add(wq + (slot), 1u, __ATOMIC_RELAXED, __HIP_MEMORY_SCOPE_WORKGROUP) : 0u))
#define WQ_TOK(p, k) ((p) < npair ? tok0 + ((2 * (p) + (k)) & 7) + nwv * ((2 * (p) + (k)) >> 3) : T)
        for (int c = grp, pass = 0; c < 16; c += 8, ++pass) {
            const int coff = 128 * c + 16 * l8, coffT = c * NEXP * 128 + 16 * l8;
            int eA[2], eB[2]; u32x4 rA[16], rB[16]; u32x4 xA0, xA1, xB0, xB1;
            int p = WQ_NEXT(pass); int ta = WQ_TOK(p, 0), tb = WQ_TOK(p, 1);
            P8_IDX(eA, ta); P8_ROWS(rA, eA, xA0, xA1, ta); P8_IDX(eB, tb);
#pragma unroll 1
            while (p < npair) {
                const int pn = WQ_NEXT(pass); const int na = WQ_TOK(pn, 0), nb = WQ_TOK(pn, 1);
                P8_ROWS(rB, eB, xB0, xB1, tb); P8_IDX(eA, na);
                P8_COMP(rA, xA0, xA1, ta);
                P8_ROWS(rA, eA, xA0, xA1, na); P8_IDX(eB, nb);
                P8_COMP(rB, xB0, xB1, tb);
                p = pn; ta = na; tb = nb;
            }
        }
#undef P8_IDX
#undef P8_ROWS
#undef P8_COMP
#undef P8_DPP
    }
    SEAM(8);
    if (IN(9)) {
        const int lane = lane_now();
        const int* IDX = (const int*)(ws + WS_IDX); const float* GATE = (const float*)(ws + WS_GATE); const float* ESC = (const float*)(ws + WS_EV);
        for (int t = gw; t < T; t += NGW) {
            const float pss = lane < 32 ? SSQ[(size_t)t * 32 + lane] : 0.f;
            const float rstd = rsqrtf(wave_sum(pss) * (1.f / DM) + EPS);
#pragma unroll
            for (int hh = 0; hh < 2; ++hh) { const int j = 64 * hh + lane; float a = 0.f;
#pragma unroll
                for (int c = 0; c < 16; ++c) a += bf2f(PA[((size_t)t * 16 + c) * 128 + (j & 7) * 16 + (j >> 3)]);
                const int e = IDX[(size_t)t * 128 + j];
                a *= ESC[e] * rstd;
                const float ge = 0.5f * a * (1.f + tanhf(0.7978845608028654f * (a + 0.044715f * a * a * a)));
                HS[(size_t)t * 128 + j] = ge * GATE[(size_t)t * 128 + j] * ESC[NEXP + e]; }
        }
    }
    SEAM(9);
    if (IN(10)) {
        const int lane = lane_now(), l8 = lane & 7, lg = lane >> 3, grp = bx & 7, nwv = (G >> 3) * NWAVES, wg = (bx >> 3) * NWAVES + wave;
        const int* IDX = (const int*)(ws + WS_IDX); const unsigned char* EV8 = (const unsigned char*)(ws + WS_EU) + (size_t)NEXP * DM;
        float* outp = args.out;
        const bool b16 = (lane & 16) != 0, b8 = (lane & 8) != 0;
#define P10_LOADE(E, tk) do { const int* ip_ = IDX + (size_t)((tk) < T ? (tk) : T - 1) * 128 + lane; E[0] = ip_[0]; E[1] = ip_[64]; } while (0)
#define P10_LOADH(H, tk) do { const float* hp_ = HS + (size_t)((tk) < T ? (tk) : T - 1) * 128 + lane; H[0] = hp_[0]; H[1] = hp_[64]; } while (0)
#define P10_ROWS(R, E, O, tk) do { _Pragma("unroll") for (int i = 0; i < 16; ++i) { const int e_ = __shfl(E[i >> 3], ((8 * i) & 63) + lg); R[i] = *(const u32x4*)(EV8 + (unsigned)(e_ * 128 + coffT)); } \
            { const unsigned w_ = *(const unsigned*)(XG + (size_t)((tk) < T ? (tk) : T - 1) * DM + coff + 2 * lg); O = (f32x2){__uint_as_float(w_ << 16), __uint_as_float(w_ & 0xffff0000u)}; } } while (0)
#define P10_COMP(R, H, O, tk) do { f32x2 acc[8]; \
            _Pragma("unroll") for (int d = 0; d < 8; ++d) acc[d] = (f32x2){0.f, 0.f}; \
            _Pragma("unroll") for (int i = 0; i < 16; ++i) { const float h_ = __shfl(H[i >> 3], ((8 * i) & 63) + lg); _Pragma("unroll") for (int d = 0; d < 4; ++d) { \
                acc[2 * d] += __builtin_amdgcn_cvt_pk_f32_fp8((int)R[i][d], false) * h_; acc[2 * d + 1] += __builtin_amdgcn_cvt_pk_f32_fp8((int)R[i][d], true) * h_; } } \
              \
            float f8[8], f4[4], f2[2]; \
            _Pragma("unroll") for (int k = 0; k < 8; ++k) { auto r_ = __builtin_amdgcn_permlane32_swap(__float_as_uint(acc[k >> 1][k & 1]), __float_as_uint(acc[(k + 8) >> 1][k & 1]), false, false); f8[k] = __uint_as_float(r_[0]) + __uint_as_float(r_[1]); } \
            _Pragma("unroll") for (int k = 0; k < 4; ++k) { const float keep = b16 ? f8[k + 4] : f8[k], give = b16 ? f8[k] : f8[k + 4]; f4[k] = keep + __shfl_xor(give, 16); } \
            _Pragma("unroll") for (int k = 0; k < 2; ++k) { const float keep = b8 ? f4[k + 2] : f4[k], give = b8 ? f4[k] : f4[k + 2]; f2[k] = keep + __shfl_xor(give, 8); } \
            if ((tk) < T) { f32x2 v_ = O; v_[0] += f2[0]; v_[1] += f2[1]; *(f32x2*)(outp + (size_t)(tk) * DM + coff + 2 * lg) = v_; } } while (0)
        LAS unsigned* wq = (LAS unsigned*)(lds + MISC_OFF + 128);
        if (lane == 0 && wave == 0) { wq[2] = 0u; wq[3] = 0u; }
        __syncthreads();
        const int tok0 = (bx >> 3) * NWAVES, npair = (T / nwv) * NWAVES / 2;
        for (int c = grp, pass = 0; c < 16; c += 8, ++pass) {
            const int coff = 128 * c + 16 * l8, coffT = c * NEXP * 128 + 16 * l8;
            int e[2]; float hA[2], hB[2]; u32x4 rA[16], rB[16]; f32x2 oA, oB;
            int p = WQ_NEXT(2 + pass); int ta = WQ_TOK(p, 0), tb = WQ_TOK(p, 1);
            P10_LOADE(e, ta); P10_ROWS(rA, e, oA, ta); P10_LOADH(hA, ta); P10_LOADE(e, tb);
#pragma unroll 1
            while (p < npair) {
                const int pn = WQ_NEXT(2 + pass); const int na = WQ_TOK(pn, 0), nb = WQ_TOK(pn, 1);
                P10_ROWS(rB, e, oB, tb); P10_LOADH(hB, tb); P10_LOADE(e, na);
                P10_COMP(rA, hA, oA, ta);
                P10_ROWS(rA, e, oA, na); P10_LOADH(hA, na); P10_LOADE(e, nb);
                P10_COMP(rB, hB, oB, tb);
                p = pn; ta = na; tb = nb;
            }
        }
#undef WQ_NEXT
#undef WQ_TOK
#undef P10_LOADE
#undef P10_LOADH
#undef P10_ROWS
#undef P10_COMP
    }
#undef IN
#undef SEAM
}

static int g_grid = 0;
static void launch_mega(const Args& a0, int lo, int hi, hipStream_t stream) {
    Args a = a0; a.ph_lo = lo; a.ph_hi = hi;
    hipLaunchKernelGGL(mega, dim3(g_grid), dim3(NTHR), LDS_BYTES, stream, a);
}

extern "C" void kernel_launch(void* const* d_in, const int* in_sizes, int n_in, void* d_out, int out_size, void* d_ws, size_t ws_size, hipStream_t stream) {
    if (n_in != 17 || out_size != T * DM || ws_size < 512 * MiB) { fprintf(stderr, "kernel_launch: unexpected shapes n_in=%d out=%d ws=%zu\n", n_in, out_size, ws_size); return; }
    if (g_grid == 0) {
        int dev = 0, cus = 0;
        if (hipGetDevice(&dev) != hipSuccess || hipDeviceGetAttribute(&cus, hipDeviceAttributeMultiprocessorCount, dev) != hipSuccess) { fprintf(stderr, "kernel_launch: device query failed\n"); g_grid = -1; return; }
        if (hipFuncSetAttribute((const void*)mega, hipFuncAttributeMaxDynamicSharedMemorySize, LDS_BYTES) != hipSuccess) { fprintf(stderr, "kernel_launch: hipFuncSetAttribute failed\n"); g_grid = -1; return; }
        if (cus < 256) { fprintf(stderr, "kernel_launch: this kernel needs 256 co-resident workgroups (one per CU); the device has %d CUs\n", cus); g_grid = -1; return; }
        g_grid = 256;
    }
    if (g_grid < 0) return;
    char* ws = (char*)d_ws; float* out = (float*)d_out;
    (void)hipMemsetAsync(ws + WS_CTL + CW_BAR * 4, 0, XCD_BAR_WORDS * 4, stream);
    Args a{}; for (int i = 0; i < 17; ++i) a.in[i] = (const float*)d_in[i]; a.out = out; a.ws = (unsigned char*)d_ws;
    launch_mega(a, 0, N_PHASES, stream);
}
```
